# Optimizing an MI355X kernel written in HIP

```python
import math, functools
import jax, jax.numpy as jnp
from jax import lax
import numpy as np

D_MODEL = 1024
BATCH = 8
SEQ = 4096
DEPTH = 2

GRID_W = 64
CTX_LEN = 256
D_FF = 2816
DIFF_HEADS = 4
DIFF_HEAD_DIM = 64
DIFF_V_DIM = 2 * DIFF_HEAD_DIM
WIN_HEADS = 8
WIN_KV_HEADS = 2
WIN_HEAD_DIM = 64
WINDOW = 128
Q_BLOCK = 128
ROPE_BASE = 10000.0
ROPE_FREQS = DIFF_HEAD_DIM // 4
MLSTM_HEADS = 4
MLSTM_HEAD_DIM = 128
RET_HEADS = 4
RET_QK_DIM = 64
RET_V_DIM = 128
CHUNK = 128
ALPHA = (2.0 * DEPTH) ** 0.25
BETA = (8.0 * DEPTH) ** -0.25
N_EVEN = (DEPTH + 1) // 2
N_ODD = DEPTH // 2

ATTN_SIZES = (DIFF_HEADS * 2 * DIFF_HEAD_DIM, DIFF_HEADS * 2 * DIFF_HEAD_DIM, DIFF_HEADS * DIFF_V_DIM,
              WIN_HEADS * WIN_HEAD_DIM, WIN_KV_HEADS * WIN_HEAD_DIM, WIN_KV_HEADS * WIN_HEAD_DIM)
ATTN_IN = sum(ATTN_SIZES)
ATTN_OUT = DIFF_HEADS * DIFF_V_DIM + WIN_HEADS * WIN_HEAD_DIM
REC_SIZES = (MLSTM_HEADS * MLSTM_HEAD_DIM, MLSTM_HEADS * MLSTM_HEAD_DIM, MLSTM_HEADS * MLSTM_HEAD_DIM,
             MLSTM_HEADS * MLSTM_HEAD_DIM, 2 * 2 * MLSTM_HEADS,
             RET_HEADS * RET_QK_DIM, RET_HEADS * RET_QK_DIM, RET_HEADS * RET_V_DIM, RET_HEADS * RET_V_DIM)
REC_IN = sum(REC_SIZES)
REC_OUT = MLSTM_HEADS * MLSTM_HEAD_DIM + RET_HEADS * RET_V_DIM

kernel_name = 'hybrid_diffattn_swa_mlstm_retention_dit'


def layer_norm(x, g, b=None, eps=1e-5):
    xf = x.astype(jnp.float32)
    mu = xf.mean(-1, keepdims=True)
    var = jnp.square(xf - mu).mean(-1, keepdims=True)
    y = (xf - mu) * lax.rsqrt(var + eps) * g
    if b is not None:
        y = y + b
    return y.astype(x.dtype)


def rms_norm(x, g, eps=1e-5):
    xf = x.astype(jnp.float32)
    y = xf * lax.rsqrt(jnp.square(xf).mean(-1, keepdims=True) + eps) * g
    return y.astype(x.dtype)


def split_cols(p, sizes):
    out, start = [], 0
    for s in sizes:
        out.append(p[..., start:start + s])
        start += s
    return out


def modulation(cvec, w, b):
    return jax.nn.silu(cvec) @ w + b


def modulate(x, m, s):
    return x * (1.0 + m[:, :, s, 1]) + m[:, :, s, 0]


def post_norm_residual(x, y, m, s, weight, g, b):
    return layer_norm(ALPHA * x + weight * m[:, :, s, 2] * y, g, b)


def swiglu(h, w_in, w_out):
    gate, up = jnp.split(h @ w_in, 2, axis=-1)
    return (jax.nn.silu(gate) * up) @ w_out


def ffn_sublayer(stream, m, s, w_in, w_out, g, b):
    return post_norm_residual(stream, swiglu(modulate(stream, m, s), w_in, w_out), m, s, 0.5, g, b)


def axial_rope_tables(n_tokens):
    ROWS = n_tokens // GRID_W
    row = jnp.repeat(jnp.arange(ROWS), GRID_W)
    col = jnp.tile(jnp.arange(GRID_W), ROWS)
    inv = ROPE_BASE ** (-jnp.arange(ROPE_FREQS, dtype=jnp.float32) / ROPE_FREQS)
    ang = jnp.stack([row[:, None] * inv, col[:, None] * inv], axis=1)
    return jnp.cos(ang), jnp.sin(ang)


def apply_rope(x, cos, sin):
    mid = x.shape[2:-1]
    xs = x.reshape(*x.shape[:-1], 2, 2, ROPE_FREQS)
    x1, x2 = xs[..., 0, :], xs[..., 1, :]
    c = cos.reshape(cos.shape[0], *([1] * len(mid)), 2, ROPE_FREQS)
    s = sin.reshape(sin.shape[0], *([1] * len(mid)), 2, ROPE_FREQS)
    out = jnp.stack([x1 * c - x2 * s, x2 * c + x1 * s], axis=-2)
    return out.reshape(x.shape)


def to_blocks(a):
    B, T = a.shape[:2]
    return a.reshape(B, T // Q_BLOCK, Q_BLOCK, *a.shape[2:]).swapaxes(0, 1)


def from_blocks(a):
    nb, B, Q = a.shape[:3]
    return a.swapaxes(0, 1).reshape(B, nb * Q, *a.shape[3:])


def to_chunks(a):
    B, T = a.shape[:2]
    return jnp.moveaxis(a.reshape(B, T // CHUNK, CHUNK, *a.shape[2:]), (1, 3), (0, 2))


def from_chunks(y):
    y = jnp.moveaxis(y, (0, 2), (1, 3))
    return y.reshape(y.shape[0], y.shape[1] * y.shape[2], *y.shape[3:])


def diff_attention(q, k, v, lam):
    s = jnp.einsum('bqhid,bkhid->bhiqk', q, k).astype(jnp.float32) * (q.shape[-1] ** -0.5)
    p = jax.nn.softmax(s, axis=-1)
    a = p[:, :, 0] - lam * p[:, :, 1]
    return jnp.einsum('bhqk,bkhv->bqhv', a, v)


def sink_attention(q, keys, values, masks, sink):
    B, Q, H, d = q.shape
    KVH = keys[0].shape[2]
    G = H // KVH
    qg = q.reshape(B, Q, KVH, G, d) * (d ** -0.5)
    scores = []
    for k, m in zip(keys, masks):
        s = jnp.einsum('bqkgd,bskd->bkgqs', qg, k).astype(jnp.float32)
        scores.append(s if m is None else jnp.where(m, s, -jnp.inf))
    sink_col = jnp.broadcast_to(sink.astype(jnp.float32).reshape(1, KVH, G, 1, 1), (B, KVH, G, Q, 1))
    p = jax.nn.softmax(jnp.concatenate(scores + [sink_col], axis=-1), axis=-1)
    out, start = None, 0
    for v in values:
        n = v.shape[1]
        part = jnp.einsum('bkgqs,bskd->bqkgd', p[..., start:start + n], v)
        out = part if out is None else out + part
        start += n
    return out.reshape(B, Q, H, d)


def split_attn(p):
    B, T, _ = p.shape
    aq, ak, av, bq, bk, bv = split_cols(p, ATTN_SIZES)
    return (aq.reshape(B, T, DIFF_HEADS, 2, DIFF_HEAD_DIM), ak.reshape(B, T, DIFF_HEADS, 2, DIFF_HEAD_DIM),
            av.reshape(B, T, DIFF_HEADS, DIFF_V_DIM), bq.reshape(B, T, WIN_HEADS, WIN_HEAD_DIM),
            bk.reshape(B, T, WIN_KV_HEADS, WIN_HEAD_DIM), bv.reshape(B, T, WIN_KV_HEADS, WIN_HEAD_DIM))


def attention_mixer(hx, hc, w_in, w_out, lam_vec, sub_g, sink, lambda_init, need_ctx_out):
    B, T, _ = hx.shape
    cos, sin = axial_rope_tables(T)
    aqx, akx, avx, bqx, bkx, bvx = split_attn(hx @ w_in)
    aqc, akc, avc, bqc, bkc, bvc = split_attn(hc @ w_in)
    lam = (jnp.exp(jnp.sum(lam_vec[0] * lam_vec[1])) - jnp.exp(jnp.sum(lam_vec[2] * lam_vec[3]))
           + lambda_init).astype(jnp.float32)
    k_all = jnp.concatenate([apply_rope(akx, cos, sin), akc], axis=1)
    v_all = jnp.concatenate([avx, avc], axis=1)
    a_x = from_blocks(lax.map(lambda qb: diff_attention(qb, k_all, v_all, lam),
                              to_blocks(apply_rope(aqx, cos, sin))))
    pad = ((0, 0), (WINDOW, WINDOW), (0, 0), (0, 0))
    k_pad = jnp.pad(apply_rope(bkx, cos, sin), pad)
    v_pad = jnp.pad(bvx, pad)
    span = Q_BLOCK + 2 * WINDOW
    q_pos = jnp.arange(Q_BLOCK)
    k_off = jnp.arange(span) - WINDOW

    def window_block(args):
        i, qb = args
        start = i * Q_BLOCK
        kw = lax.dynamic_slice_in_dim(k_pad, start, span, axis=1)
        vw = lax.dynamic_slice_in_dim(v_pad, start, span, axis=1)
        j = start + k_off
        t = start + q_pos
        mask = (j[None, :] >= 0) & (j[None, :] < T) & (jnp.abs(t[:, None] - j[None, :]) <= WINDOW)
        return sink_attention(qb, (kw, bkc), (vw, bvc), (mask, None), sink)

    b_x = from_blocks(lax.map(window_block, (jnp.arange(T // Q_BLOCK), to_blocks(apply_rope(bqx, cos, sin)))))

    def merge(a, b_out):
        Bm, Tm = a.shape[:2]
        a = rms_norm(a, sub_g) * (1.0 - lambda_init)
        return jnp.concatenate([a.reshape(Bm, Tm, -1), b_out.reshape(Bm, Tm, -1)], axis=-1) @ w_out

    y_x = merge(a_x, b_x)
    y_c = None
    if need_ctx_out:
        a_c = diff_attention(aqc, akc, avc, lam)
        b_c = sink_attention(bqc, (bkc,), (bvc,), (None,), sink)
        y_c = merge(a_c, b_c)
    return y_x, y_c


def mlstm_scan(seqs, state, with_output):
    q, k, v, i_pre, log_f = seqs
    tril = jnp.tril(jnp.ones((CHUNK, CHUNK), dtype=bool))

    def step(carry, xs):
        C, n, m = carry
        qc, kc, vc, ic, fc = xs
        b = jnp.cumsum(fc, axis=-1)
        b_end = b[..., -1]
        w_end = b_end[..., None] - b + ic
        m_new = jnp.maximum(b_end + m, w_end.max(-1))
        decay_state = jnp.exp(b_end + m - m_new)
        w = jnp.exp(w_end - m_new[..., None])
        C_new = decay_state[..., None, None] * C + jnp.einsum('bhl,bhlk,bhlv->bhkv', w, kc, vc)
        n_new = decay_state[..., None] * n + jnp.einsum('bhl,bhlk->bhk', w, kc)
        if not with_output:
            return (C_new, n_new, m_new), None
        log_d = jnp.where(tril, b[..., :, None] - b[..., None, :] + ic[..., None, :], -jnp.inf)
        log_inter = b + m[..., None]
        m_t = jnp.maximum(log_inter, log_d.max(-1))
        s = jnp.einsum('bhqd,bhkd->bhqk', qc, kc) * jnp.exp(log_d - m_t[..., None])
        w_inter = jnp.exp(log_inter - m_t)
        num = jnp.einsum('bhqk,bhkv->bhqv', s, vc) + w_inter[..., None] * jnp.einsum('bhqd,bhdv->bhqv', qc, C)
        den = s.sum(-1) + w_inter * jnp.einsum('bhqd,bhd->bhq', qc, n)
        h = num / jnp.maximum(jnp.abs(den), jnp.exp(-m_t))[..., None]
        return (C_new, n_new, m_new), h

    state, ys = lax.scan(step, state, tuple(to_chunks(a) for a in seqs))
    return (from_chunks(ys) if with_output else None), state


def retention_scan(log_gamma, seqs, state, with_output):
    q, k, v = seqs
    pos = jnp.arange(CHUNK, dtype=jnp.float32)
    g = log_gamma[:, None]
    decay_to_end = jnp.exp(g * (CHUNK - 1 - pos))
    decay_chunk = jnp.exp(log_gamma * CHUNK)
    decay_from_start = jnp.exp(g * (pos + 1.0))
    rel = pos[:, None] - pos[None, :]
    decay_intra = jnp.where(rel >= 0, jnp.exp(log_gamma[:, None, None] * jnp.maximum(rel, 0.0)), 0.0)

    def step(S, xs):
        qc, kc, vc = xs
        S_new = decay_chunk[None, :, None, None] * S + jnp.einsum('hl,bhlk,bhlv->bhkv', decay_to_end, kc, vc)
        if not with_output:
            return S_new, None
        s = jnp.einsum('bhqd,bhkd->bhqk', qc, kc) * decay_intra
        o = (jnp.einsum('bhqk,bhkv->bhqv', s, vc)
             + decay_from_start[None, :, :, None] * jnp.einsum('bhqd,bhdv->bhqv', qc, S))
        return S_new, o

    state, ys = lax.scan(step, state, tuple(to_chunks(a) for a in seqs))
    return (from_chunks(ys) if with_output else None), state


def run_bidirectional(scans, lat_seqs, ctx_seqs, state0, need_ctx_out):
    lat_outs, ctx_outs = [], []
    for d in range(2):
        flip = (lambda a: jnp.flip(a, axis=1)) if d == 1 else (lambda a: a)
        ctx_h, ctx_state = scans[d](tuple(flip(a) for a in ctx_seqs[d]), state0, need_ctx_out)
        lat_h, _ = scans[d](tuple(flip(a) for a in lat_seqs[d]), ctx_state, True)
        lat_outs.append(flip(lat_h))
        if need_ctx_out:
            ctx_outs.append(flip(ctx_h))
    ctx_sum = ctx_outs[0] + ctx_outs[1] if need_ctx_out else None
    return lat_outs[0] + lat_outs[1], ctx_sum


def recurrent_mixer(hx, hc, w_in, w_out, gate_b, m_norm_g, ret_logit, ret_g, ret_b, need_ctx_out):
    H, d = MLSTM_HEADS, MLSTM_HEAD_DIM

    def prep(p):
        B, T, _ = p.shape
        mq, mk, mv, mo, mg, rq, rk, rv, rg = split_cols(p, REC_SIZES)
        gates = (mg.reshape(B, T, 2, 2, H) + gate_b).astype(jnp.float32)
        q, k, v = mq.reshape(B, T, H, d), mk.reshape(B, T, H, d) * (d ** -0.5), mv.reshape(B, T, H, d)
        m_seqs = [(q, k, v, gates[:, :, dr, 0], jax.nn.log_sigmoid(gates[:, :, dr, 1])) for dr in range(2)]
        r_qkv = (rq.reshape(B, T, RET_HEADS, RET_QK_DIM),
                 rk.reshape(B, T, RET_HEADS, RET_QK_DIM) * (RET_QK_DIM ** -0.5),
                 rv.reshape(B, T, RET_HEADS, RET_V_DIM))
        return m_seqs, [r_qkv, r_qkv], mo, rg

    m_x, r_x, o_x, g_x = prep(hx @ w_in)
    m_c, r_c, o_c, g_c = prep(hc @ w_in)
    B = hx.shape[0]
    m_state0 = (jnp.zeros((B, H, d, d), jnp.float32), jnp.zeros((B, H, d), jnp.float32),
                jnp.zeros((B, H), jnp.float32))
    r_state0 = jnp.zeros((B, RET_HEADS, RET_QK_DIM, RET_V_DIM), jnp.float32)
    log_gamma = jax.nn.log_sigmoid(ret_logit.astype(jnp.float32))
    m_lat, m_ctx = run_bidirectional([mlstm_scan, mlstm_scan], m_x, m_c, m_state0, need_ctx_out)
    r_scans = [functools.partial(retention_scan, log_gamma[dr]) for dr in range(2)]
    r_lat, r_ctx = run_bidirectional(r_scans, r_x, r_c, r_state0, need_ctx_out)

    def merge(h_m, h_r, o, g):
        Bm, Tm = o.shape[:2]
        hm = layer_norm(h_m, m_norm_g.reshape(H, d)) * jax.nn.sigmoid(o).reshape(Bm, Tm, H, d)
        hr = (layer_norm(h_r, ret_g.reshape(RET_HEADS, RET_V_DIM), ret_b.reshape(RET_HEADS, RET_V_DIM))
              * jax.nn.silu(g).reshape(Bm, Tm, RET_HEADS, RET_V_DIM))
        return jnp.concatenate([hm.reshape(Bm, Tm, -1), hr.reshape(Bm, Tm, -1)], axis=-1) @ w_out

    y_x = merge(m_lat, r_lat, o_x, g_x)
    y_c = merge(m_ctx, r_ctx, o_c, g_c) if need_ctx_out else None
    return y_x, y_c


def setup_inputs(seed: int = 0) -> dict:
    key = jax.random.key(seed)
    ks = jax.random.split(key, 22)
    nrm = lambda k, shape, s: jax.random.normal(k, shape, jnp.float32) * s
    gate_base = jnp.stack([jnp.zeros((MLSTM_HEADS,), jnp.float32), jnp.linspace(3.0, 6.0, MLSTM_HEADS)])
    gamma0 = 1.0 - 2.0 ** (-5.0 - jnp.arange(RET_HEADS, dtype=jnp.float32))
    return {
        'x': nrm(ks[0], (BATCH, SEQ, D_MODEL), 1.0),
        'c': nrm(ks[1], (BATCH, D_MODEL), 1.0),
        'ctx': nrm(ks[2], (BATCH, CTX_LEN, D_MODEL), 1.0),
        'c_ctx': nrm(ks[3], (D_MODEL,), 1.0),
        'ada_w': nrm(ks[4], (DEPTH, D_MODEL, 9 * D_MODEL), D_MODEL ** -0.5),
        'ada_b': nrm(ks[5], (DEPTH, 9 * D_MODEL), 0.02),
        'ln_g': 1.0 + nrm(ks[6], (DEPTH, 3, D_MODEL), 0.02),
        'ln_b': nrm(ks[7], (DEPTH, 3, D_MODEL), 0.02),
        'ffn_w_in': nrm(ks[8], (DEPTH, 2, D_MODEL, 2 * D_FF), D_MODEL ** -0.5),
        'ffn_w_out': nrm(ks[9], (DEPTH, 2, D_FF, D_MODEL), BETA * D_FF ** -0.5),
        'attn_w_in': nrm(ks[10], (N_EVEN, D_MODEL, ATTN_IN), D_MODEL ** -0.5),
        'attn_w_out': nrm(ks[11], (N_EVEN, ATTN_OUT, D_MODEL), BETA * ATTN_OUT ** -0.5),
        'diff_lambda': nrm(ks[12], (N_EVEN, 4, DIFF_HEAD_DIM), 0.1),
        'diff_norm_g': 1.0 + nrm(ks[13], (N_EVEN, DIFF_V_DIM), 0.02),
        'sink_logits': nrm(ks[14], (N_EVEN, WIN_HEADS), 0.5),
        'rec_w_in': nrm(ks[15], (N_ODD, D_MODEL, REC_IN), D_MODEL ** -0.5),
        'rec_w_out': nrm(ks[16], (N_ODD, REC_OUT, D_MODEL), BETA * REC_OUT ** -0.5),
        'mlstm_gate_b': gate_base + nrm(ks[17], (N_ODD, 2, 2, MLSTM_HEADS), 0.1),
        'mlstm_norm_g': 1.0 + nrm(ks[18], (N_ODD, MLSTM_HEADS * MLSTM_HEAD_DIM), 0.02),
        'ret_decay_logit': jnp.log(gamma0 / (1.0 - gamma0)) + nrm(ks[19], (N_ODD, 2, RET_HEADS), 0.1),
        'ret_norm_g': 1.0 + nrm(ks[20], (N_ODD, RET_HEADS * RET_V_DIM), 0.02),
        'ret_norm_b': nrm(ks[21], (N_ODD, RET_HEADS * RET_V_DIM), 0.02),
    }


def reference(x, c, ctx, c_ctx, ada_w, ada_b, ln_g, ln_b, ffn_w_in, ffn_w_out, attn_w_in, attn_w_out,
              diff_lambda, diff_norm_g, sink_logits, rec_w_in, rec_w_out, mlstm_gate_b, mlstm_norm_g,
              ret_decay_logit, ret_norm_g, ret_norm_b):
    out_dtype = x.dtype
    B, D = x.shape[0], x.shape[2]
    for l in range(DEPTH):
        last = l == DEPTH - 1
        mod_x = modulation(c, ada_w[l], ada_b[l]).reshape(B, 1, 3, 3, D)
        mod_c = modulation(c_ctx, ada_w[l], ada_b[l]).reshape(1, 1, 3, 3, D)
        x = ffn_sublayer(x, mod_x, 0, ffn_w_in[l, 0], ffn_w_out[l, 0], ln_g[l, 0], ln_b[l, 0])
        ctx = ffn_sublayer(ctx, mod_c, 0, ffn_w_in[l, 0], ffn_w_out[l, 0], ln_g[l, 0], ln_b[l, 0])
        hx, hc = modulate(x, mod_x, 1), modulate(ctx, mod_c, 1)
        i = l // 2
        if l % 2 == 0:
            lambda_init = 0.8 - 0.6 * math.exp(-0.3 * l)
            y_x, y_c = attention_mixer(hx, hc, attn_w_in[i], attn_w_out[i], diff_lambda[i], diff_norm_g[i],
                                       sink_logits[i], lambda_init, not last)
        else:
            y_x, y_c = recurrent_mixer(hx, hc, rec_w_in[i], rec_w_out[i], mlstm_gate_b[i], mlstm_norm_g[i],
                                       ret_decay_logit[i], ret_norm_g[i], ret_norm_b[i], not last)
        x = post_norm_residual(x, y_x, mod_x, 1, 1.0, ln_g[l, 1], ln_b[l, 1])
        x = ffn_sublayer(x, mod_x, 2, ffn_w_in[l, 1], ffn_w_out[l, 1], ln_g[l, 2], ln_b[l, 2])
        if not last:
            ctx = post_norm_residual(ctx, y_c, mod_c, 1, 1.0, ln_g[l, 1], ln_b[l, 1])
            ctx = ffn_sublayer(ctx, mod_c, 2, ffn_w_in[l, 1], ffn_w_out[l, 1], ln_g[l, 2], ln_b[l, 2])
    return x.astype(out_dtype)
```

```cpp
#include <hip/hip_runtime.h>
#include <cstdio>
#include <cstdint>
namespace pg8 {
#define PG8_LAS __attribute__((address_space(3)))
typedef unsigned short bf16_t;
typedef short bf16x8 __attribute__((ext_vector_type(8)));
typedef float f32x4 __attribute__((ext_vector_type(4)));
typedef unsigned u32x4 __attribute__((ext_vector_type(4)));
constexpr int BM = 256, BK = 64, HALF = 128, HTB = HALF * BK * 2  , STAGE_BYTES = 8 * HTB, NXCD = 8, WGM = 8;

__host__ __device__ __forceinline__ int lds_byte(int r, int c) { const int st = (r >> 4) * 2 + (c >> 5), rr = r & 15, cc = c & 31, ob = rr * 64 + cc * 2; return st * 1024 + (ob ^ (((ob >> 9) & 1) << 5)); }
__host__ __device__ __forceinline__ void stage_rc(int b, int& R, int& C) { const int st = b / 1024, sb = b % 1024, swz = sb ^ (((sb >> 9) & 1) << 5); R = (st >> 1) * 16 + swz / 64; C = (st & 1) * 32 + (swz % 64) / 2; }
__host__ __device__ __forceinline__ int perm32(int rho) { const int n = rho >> 4, i = rho & 15; return 8 * (i >> 2) + 4 * n + (i & 3); }

struct Unit { int pm, pn; };
struct Gemm { const bf16_t* A; const bf16_t* Bt; int M, N, K; };

struct StaticOrder {
    int nM, nN, nwg, G, c;
    __host__ __device__ void init(int M, int N, int G_, int c_) { nM = M / BM; nN = N / BM; nwg = nM * nN; G = G_; c = c_; }
    __host__ __device__ bool next(int i, Unit& u) const {
        const long L = (long)i * G + c; if (L >= nwg) return false;
        int wgid = (int)L; { const int q = nwg / NXCD, r = nwg % NXCD, xcd = wgid % NXCD, off = wgid / NXCD; wgid = (xcd < r ? xcd * (q + 1) : r * (q + 1) + (xcd - r) * q) + off; }
        const int nig = WGM * nN, gid = wgid / nig, fm = gid * WGM, gsz = (nM - fm) < WGM ? (nM - fm) : WGM;
        u.pm = fm + ((wgid % nig) % gsz); u.pn = (wgid % nig) / gsz; return true;
    }
    __device__ __forceinline__ void a_ready(const Unit&) const {}
    __device__ __forceinline__ void done(const Unit&) const {}
};

__device__ __forceinline__ unsigned cvt_pk_bf16(float lo, float hi) { unsigned r; asm volatile("v_cvt_pk_bf16_f32 %0, %1, %2" : "=v"(r) : "v"(lo), "v"(hi)); return r; }
template <class Epi, class Sched, bool ALIGN_EPI = false, bool SP2 = false>
__device__ __forceinline__ void gemm_phase(PG8_LAS unsigned char* lds, const Gemm g, const Sched& S, const Epi& E) {
    int tid_l = threadIdx.x; asm volatile("" : "+v"(tid_l));
    const int tid = tid_l, wid = __builtin_amdgcn_readfirstlane(tid >> 6), lane = tid & 63, wr = wid >> 2, wc = wid & 3, fr = lane & 15, fq = lane >> 4;
    const int K = g.K, nt = K / BK;
    unsigned voffA[2], voffB[2];
#pragma unroll
    for (int i = 0; i < 2; ++i) { int R, C; stage_rc(tid * 16 + i * 8192, R, C); const int Rb = Epi::PERM ? ((R & ~31) + perm32(R & 31)) : R;
        voffA[i] = (unsigned)(R * K + C) * 2u; voffB[i] = (unsigned)(Rb * K + C) * 2u; }
    const size_t kstep = (size_t)(BK * 2);
    const size_t hstep = (size_t)HALF * K * 2;
    const size_t tstep = 2 * hstep;
    const unsigned ldsw = (unsigned)wid * 1024u;
    const int aoff = lds_byte(wr * 64 + fr, fq * 8), boff = lds_byte(wc * 32 + fr, fq * 8);
#define PG8_SA(b, h) (((b) * 2 + (h)) * HTB)
#define PG8_SB(b, h) ((4 + (b) * 2 + (h)) * HTB)
#define PG8_STAGE(bufoff, gbase, voff) do { _Pragma("unroll") for (int _i = 0; _i < 2; ++_i) \
        __builtin_amdgcn_global_load_lds((const unsigned*)((const char*)(gbase) + (voff)[_i]), (PG8_LAS unsigned*)(lds + (bufoff) + ldsw + _i * 8192), 16, 0, 0); } while (0)
#define PG8_LDA(dst, b, h) do { _Pragma("unroll") for (int m = 0; m < 4; ++m) _Pragma("unroll") for (int k = 0; k < 2; ++k) dst[m][k] = *(const PG8_LAS bf16x8*)(lds + PG8_SA(b, h) + aoff + m * 2048 + k * 1024); } while (0)
#define PG8_LDB(dst, b, h) do { _Pragma("unroll") for (int n = 0; n < 2; ++n) _Pragma("unroll") for (int k = 0; k < 2; ++k) dst[n][k] = *(const PG8_LAS bf16x8*)(lds + PG8_SB(b, h) + boff + n * 2048 + k * 1024); } while (0)
#define PG8_MMA(ai, bj, At, Bt) do { __builtin_amdgcn_s_setprio(1); _Pragma("unroll") for (int m = 0; m < 4; ++m) _Pragma("unroll") for (int n = 0; n < 2; ++n) _Pragma("unroll") for (int k = 0; k < 2; ++k) \
        acc[ai][bj][m][n] = __builtin_amdgcn_mfma_f32_16x16x32_bf16(Bt[n][k], At[m][k], acc[ai][bj][m][n], 0, 0, 0); __builtin_amdgcn_s_setprio(0); } while (0)
#define PG8_WAIT_V(n) asm volatile("s_waitcnt vmcnt(" #n ")" ::: "memory")
#define PG8_WAIT_L(n) asm volatile("s_waitcnt lgkmcnt(" #n ")" ::: "memory")
#define PG8_BAR __builtin_amdgcn_s_barrier()
#define PG8_SCHED __builtin_amdgcn_sched_barrier(0)
    Unit cur, nxt; int ui = 0;
    if (!S.next(0, cur)) return;
    f32x4 acc[2][2][4][2];
#pragma unroll
    for (int a = 0; a < 2; ++a)
#pragma unroll
        for (int b = 0; b < 2; ++b)
#pragma unroll
            for (int m = 0; m < 4; ++m)
#pragma unroll
                for (int n = 0; n < 2; ++n) acc[a][b][m][n] = (f32x4){0.f, 0.f, 0.f, 0.f};
    bf16x8 At[4][2], B0[2][2], B1[2][2];
    const char* cA = (const char*)g.A + (size_t)cur.pm * tstep; const char* cB = (const char*)g.Bt + (size_t)cur.pn * tstep;
    S.a_ready(cur);
    if constexpr (SP2) {
        PG8_STAGE(PG8_SB(0, 0), cB, voffB); PG8_STAGE(PG8_SB(0, 1), cB + hstep, voffB); PG8_STAGE(PG8_SA(0, 0), cA, voffA); PG8_STAGE(PG8_SA(0, 1), cA + hstep, voffA);
        if (wr == 1) PG8_BAR;
        PG8_WAIT_V(2); PG8_BAR;
        PG8_STAGE(PG8_SB(1, 0), cB + kstep, voffB); PG8_STAGE(PG8_SA(1, 0), cA + kstep, voffA); PG8_STAGE(PG8_SB(1, 1), cB + hstep + kstep, voffB);
        PG8_WAIT_V(6); PG8_BAR;
    } else {
        PG8_STAGE(PG8_SB(0, 0), cB, voffB); PG8_STAGE(PG8_SA(0, 0), cA, voffA); PG8_STAGE(PG8_SB(0, 1), cB + hstep, voffB); PG8_STAGE(PG8_SA(0, 1), cA + hstep, voffA);
        if (wr == 1) PG8_BAR;
        PG8_WAIT_V(4); PG8_BAR;
        PG8_STAGE(PG8_SB(1, 0), cB + kstep, voffB); PG8_STAGE(PG8_SA(1, 0), cA + kstep, voffA); PG8_STAGE(PG8_SB(1, 1), cB + hstep + kstep, voffB);
        PG8_WAIT_V(6); PG8_BAR;
    }
    for (;;) {
        const bool has_next = S.next(ui + 1, nxt);
        const char* nA = has_next ? (const char*)g.A + (size_t)nxt.pm * tstep : cA; const char* nB = has_next ? (const char*)g.Bt + (size_t)nxt.pn * tstep : cB;
        for (int t = 0; t < nt; t += 2) {
            const bool last = (t == nt - 2);
            const char* a1 = cA + (size_t)(t + 1) * kstep;
            const char* a2 = last ? nA : cA + (size_t)(t + 2) * kstep; const char* b2 = last ? nB : cB + (size_t)(t + 2) * kstep;
            const char* a3 = a2 + kstep; const char* b3 = b2 + kstep;
            if (last && has_next) S.a_ready(nxt);
            if constexpr (SP2) {
            PG8_LDB(B0, 0, 0); PG8_LDB(B1, 0, 1); PG8_SCHED; PG8_LDA(At, 0, 0); PG8_STAGE(PG8_SA(1, 1), a1 + hstep, voffA);
            PG8_WAIT_V(8); PG8_WAIT_L(0); PG8_BAR; PG8_MMA(0, 0, At, B0); PG8_MMA(0, 1, At, B1); PG8_BAR; PG8_SCHED;
            PG8_LDA(At, 0, 1); PG8_STAGE(PG8_SB(0, 0), b2, voffB); PG8_STAGE(PG8_SB(0, 1), b2 + hstep, voffB); PG8_STAGE(PG8_SA(0, 0), a2, voffA);
            PG8_WAIT_V(8); PG8_WAIT_L(0); PG8_BAR; PG8_MMA(1, 0, At, B0); PG8_MMA(1, 1, At, B1); PG8_BAR; PG8_SCHED;
            PG8_LDB(B0, 1, 0); PG8_LDB(B1, 1, 1); PG8_SCHED; PG8_LDA(At, 1, 0); PG8_STAGE(PG8_SA(0, 1), a2 + hstep, voffA);
            PG8_WAIT_V(8); PG8_WAIT_L(0); PG8_BAR; PG8_MMA(0, 0, At, B0); PG8_MMA(0, 1, At, B1); PG8_BAR; PG8_SCHED;
            PG8_LDA(At, 1, 1); PG8_STAGE(PG8_SB(1, 0), b3, voffB); PG8_STAGE(PG8_SB(1, 1), b3 + hstep, voffB); PG8_STAGE(PG8_SA(1, 0), a3, voffA);
            PG8_WAIT_V(8); PG8_WAIT_L(0); PG8_BAR; PG8_MMA(1, 0, At, B0); PG8_MMA(1, 1, At, B1); PG8_BAR; PG8_SCHED;
            } else {
            PG8_LDB(B0, 0, 0); PG8_SCHED; PG8_LDA(At, 0, 0); PG8_STAGE(PG8_SA(1, 1), a1 + hstep, voffA);
            PG8_WAIT_L(8); PG8_BAR; PG8_WAIT_L(0); PG8_MMA(0, 0, At, B0); PG8_BAR; PG8_SCHED;
            PG8_LDB(B1, 0, 1); PG8_STAGE(PG8_SB(0, 0), b2, voffB);
            PG8_BAR; PG8_WAIT_L(0); PG8_MMA(0, 1, At, B1); PG8_BAR;
            PG8_LDA(At, 0, 1); PG8_STAGE(PG8_SA(0, 0), a2, voffA);
            PG8_BAR; PG8_WAIT_L(0); PG8_MMA(1, 0, At, B0); PG8_BAR; PG8_SCHED;
            PG8_STAGE(PG8_SB(0, 1), b2 + hstep, voffB);
            PG8_WAIT_V(6); PG8_BAR; PG8_MMA(1, 1, At, B1); PG8_BAR;
            PG8_LDB(B0, 1, 0); PG8_SCHED; PG8_LDA(At, 1, 0); PG8_STAGE(PG8_SA(0, 1), a2 + hstep, voffA);
            PG8_WAIT_L(8); PG8_BAR; PG8_WAIT_L(0); PG8_MMA(0, 0, At, B0); PG8_BAR; PG8_SCHED;
            PG8_LDB(B1, 1, 1); PG8_STAGE(PG8_SB(1, 0), b3, voffB);
            PG8_BAR; PG8_WAIT_L(0); PG8_MMA(0, 1, At, B1); PG8_BAR;
            PG8_LDA(At, 1, 1); PG8_STAGE(PG8_SA(1, 0), a3, voffA);
            PG8_BAR; PG8_WAIT_L(0); PG8_MMA(1, 0, At, B0); PG8_BAR; PG8_SCHED;
            PG8_STAGE(PG8_SB(1, 1), b3 + hstep, voffB);
            PG8_WAIT_V(6); PG8_BAR; PG8_MMA(1, 1, At, B1); PG8_BAR;
            }
        }
        if constexpr (ALIGN_EPI) { if (wr == 0) PG8_BAR; }
        if constexpr (!Epi::AFTER_DRAIN) { E(acc, cur, wr, wc, fr, fq); S.done(cur); }
        if (!has_next) break;
#pragma unroll
        for (int a = 0; a < 2; ++a)
#pragma unroll
            for (int b = 0; b < 2; ++b)
#pragma unroll
                for (int m = 0; m < 4; ++m)
#pragma unroll
                    for (int n = 0; n < 2; ++n) acc[a][b][m][n] = (f32x4){0.f, 0.f, 0.f, 0.f};
        cur = nxt; cA = nA; cB = nB; ++ui;
        if constexpr (ALIGN_EPI) { if (wr == 1) PG8_BAR; }
    }
    PG8_WAIT_V(0);
    if constexpr (!ALIGN_EPI) { if (wr == 0) PG8_BAR; }
    PG8_BAR;
    if constexpr (Epi::AFTER_DRAIN) { E.fused(acc, cur, wr, wc, fr, fq, lds, wid, lane); S.done(cur); }
#undef PG8_SA
#undef PG8_SB
#undef PG8_STAGE
#undef PG8_LDA
#undef PG8_LDB
#undef PG8_MMA
#undef PG8_WAIT_V
#undef PG8_WAIT_L
#undef PG8_BAR
#undef PG8_SCHED
}
}
#define GAS __attribute__((address_space(1)))
#define LAS __attribute__((address_space(3)))
typedef unsigned short bf16;
typedef unsigned v4u __attribute__((ext_vector_type(4)));
typedef float f32x4 __attribute__((ext_vector_type(4)));
typedef short bf16x8 __attribute__((ext_vector_type(8)));
typedef GAS unsigned gu32;
typedef GAS unsigned long long gu64;
#define RLX_AGENT __ATOMIC_RELAXED, __HIP_MEMORY_SCOPE_AGENT
#define LDS_WAIT() asm volatile("s_waitcnt lgkmcnt(0)" ::: "memory")
#define VM_WAIT() asm volatile("s_waitcnt vmcnt(0)" ::: "memory")
__device__ __forceinline__ unsigned long long rt() { return __builtin_amdgcn_s_memrealtime(); }
__device__ __forceinline__ unsigned f2bf(float f) { unsigned u = __builtin_bit_cast(unsigned, f); return (u + 0x7fffu + ((u >> 16) & 1u)) >> 16; }
__device__ __forceinline__ unsigned pk2(float lo, float hi) { return f2bf(lo) | (f2bf(hi) << 16); }

#define XB_TMO      128
#define XB_XCNT(j)  (256  + 64 * (j))
#define XB_XSUB(j)  (1280 + 64 * (j))
#define XB_XGEN(j)  (2304 + 64 * (j))
#define XB_TOP      3328
#define XB_TOPGEN   3392
#define XCD_BAR_WORDS 3456
#define XB_SPIN_CAP (1u << 18)

__device__ __forceinline__ unsigned xb_ld(unsigned* p)              { return __hip_atomic_load(p, __ATOMIC_RELAXED, __HIP_MEMORY_SCOPE_AGENT); }
__device__ __forceinline__ unsigned xb_add(unsigned* p, unsigned v) { return __hip_atomic_fetch_add(p, v, __ATOMIC_RELAXED, __HIP_MEMORY_SCOPE_AGENT); }
__device__ __forceinline__ unsigned xb_xcc_id() { return (unsigned)__builtin_amdgcn_s_getreg((3 << 11) | 20) & 0xFu; }
#define XB_SPIN(cond, bar) do { unsigned _sp = 0; while (cond) { __builtin_amdgcn_s_sleep(1); \
    if ((++_sp & 255u) == 0u) { if (xb_ld(&(bar)[XB_TMO])) break; if (_sp > XB_SPIN_CAP) { atomicAdd(&(bar)[XB_TMO], 1u); break; } } } } while (0)

struct XcdBarrier {
    unsigned* bar; unsigned x;
    volatile LAS unsigned* st;
};

__device__ __forceinline__ XcdBarrier xcd_barrier_post(unsigned* bar, volatile LAS unsigned* st) {
    XcdBarrier b; b.bar = bar; b.x = xb_xcc_id(); b.st = st;
    if (threadIdx.x == 0) (void)xb_add(&bar[XB_XCNT(b.x)], 1u);
    return b;
}
__device__ __forceinline__ void xcd_barrier_complete(unsigned* bar, unsigned x, unsigned& nloc, unsigned& nx) {
    const unsigned G = gridDim.x * gridDim.y * gridDim.z;
    unsigned sum, cnt, mine, sp = 0u;
    for (;;) {
        sum = 0u; cnt = 0u; mine = 0u;
#pragma unroll
        for (unsigned j = 0; j < 16; ++j) { const unsigned c = xb_ld(&bar[XB_XCNT(j)]); sum += c; cnt += (c > 0u) ? 1u : 0u; mine = (j == x) ? c : mine; }
        if (sum == G) break;
        __builtin_amdgcn_s_sleep(1);
        if ((++sp & 255u) == 0u) { if (xb_ld(&bar[XB_TMO])) break; if (sp > XB_SPIN_CAP) { atomicAdd(&bar[XB_TMO], 1u); break; } }
    }
    nloc = mine > 0u ? mine : 1u; nx = cnt > 0u ? cnt : 1u;
}

__device__ __forceinline__ void xcd_barrier(const XcdBarrier& b) {
    asm volatile("s_waitcnt vmcnt(0)" ::: "memory");
    __syncthreads();
    if (threadIdx.x == 0) {
        unsigned* bar = b.bar;
        __builtin_amdgcn_s_waitcnt(0);
        unsigned nloc = b.st[0], nx = b.st[1];
        if (nloc == 0u) { xcd_barrier_complete(bar, b.x, nloc, nx); b.st[0] = nloc; b.st[1] = nx; }
        const unsigned old = xb_add(&bar[XB_XSUB(b.x)], 1u);
        const unsigned gen = old / nloc;
        if (old + 1u == (gen + 1u) * nloc) {
            __builtin_amdgcn_fence(__ATOMIC_RELEASE, "agent");
            asm volatile("s_waitcnt vmcnt(0)" ::: "memory");
            const unsigned og = xb_add(&bar[XB_TOP], 1u);
            const unsigned tg = og / nx;
            if (og + 1u == (tg + 1u) * nx) xb_add(&bar[XB_TOPGEN], 1u);
            else XB_SPIN(xb_ld(&bar[XB_TOPGEN]) == tg, bar);
            __builtin_amdgcn_fence(__ATOMIC_ACQUIRE, "agent");
            xb_add(&bar[XB_XGEN(b.x)], 1u);
            asm volatile("s_waitcnt vmcnt(0)" ::: "memory");
        } else {
            XB_SPIN(xb_ld(&bar[XB_XGEN(b.x)]) == gen, bar);
            __builtin_amdgcn_fence(__ATOMIC_ACQUIRE, "agent");
            asm volatile("s_waitcnt vmcnt(0)" ::: "memory");
        }
    }
    __syncthreads();
}
constexpr int NB = 8, T = 4096, D = 1024, TC = 256, FF = 2816;
constexpr int ML = NB * T, MC = NB * TC, M = ML + MC;
constexpr int N_FI = 2 * FF, N_AI = 2304, N_RI = 3840, N_RI_SRC = 3600;
constexpr float ALPHA = 1.41421356237309515f;
constexpr float LOG2E = 1.4426950408889634f;
constexpr float QSCALE = 0.125f * LOG2E;
constexpr int NWAVES = 8;
#ifndef MK_PER_PHASE
#define MK_PER_PHASE 1
#endif
constexpr int N_PHASES = 2 + 2 * 11;
#ifndef MK_STOP
#define MK_STOP N_PHASES
#endif

constexpr size_t MiB = 1u << 20;
constexpr size_t WS_CTL = 0, CTL_ZERO_BYTES = 1 * MiB;
constexpr size_t WS_MOD = 1 * MiB;
constexpr size_t WS_ROPE = WS_MOD + 704 * 1024;
constexpr size_t WS_LAM = WS_ROPE + 8192;
constexpr size_t WS_WFI = 2 * MiB;
constexpr size_t WS_WFO = 46 * MiB;
constexpr size_t WS_WAI = 68 * MiB;
constexpr size_t WS_WAO = WS_WAI + 4608 * 1024;
constexpr size_t WS_WRI = WS_WAO + 2 * MiB;
constexpr size_t WS_WRO = WS_WRI + 7680 * 1024;
constexpr size_t WS_XC = 84 * MiB;
constexpr size_t WS_H = 92 * MiB;
constexpr size_t WS_HB = 160 * MiB;
constexpr size_t WS_BIG = 228 * MiB;
constexpr size_t WS_END = 500 * MiB;
static_assert(WS_WRO + 2 * MiB <= WS_XC, "weights");
constexpr size_t WS_ACT = WS_BIG;
constexpr size_t WS_AQ = WS_BIG, WS_AK = WS_BIG + 34 * MiB, WS_BQ = WS_BIG + 68 * MiB, WS_BK = WS_BIG + 102 * MiB;
constexpr size_t WS_VTA_L = WS_BIG + 111 * MiB, WS_VTA_C = WS_BIG + 143 * MiB, WS_VTB_L = WS_BIG + 145 * MiB, WS_VTB_C = WS_BIG + 153 * MiB;
constexpr size_t WS_MQ = WS_BIG, WS_MK = WS_BIG + 34 * MiB, WS_MO = WS_BIG + 68 * MiB, WS_RQ = WS_BIG + 102 * MiB, WS_RK = WS_BIG + 119 * MiB, WS_RG = WS_BIG + 136 * MiB;
constexpr size_t WS_MKT_L = WS_BIG + 170 * MiB, WS_MKT_C = WS_BIG + 202 * MiB, WS_MVT_L = WS_BIG + 204 * MiB, WS_MVT_C = WS_BIG + 236 * MiB;
constexpr size_t WS_RVT_L = WS_BIG + 238 * MiB, WS_RVT_C = WS_BIG + 270 * MiB;
constexpr size_t WS_RKT_L = 2 * MiB, WS_RKT_C = 18 * MiB, WS_GATE = 20 * MiB;
static_assert(WS_RVT_C + 2 * MiB <= WS_END && WS_GATE + (size_t)M * 16 * 4 <= 24 * MiB, "ws map");

constexpr int CW_TMO = 0, CW_CODE = 1, CW_BAR = 4096;
constexpr int RING_BYTES = 131072;
constexpr int LDSCTL_OFF = RING_BYTES, MISC_OFF = LDSCTL_OFF + 320;
constexpr int LDS_BYTES = 147456;
typedef float f32x16 __attribute__((ext_vector_type(16)));
typedef short bf16x4 __attribute__((ext_vector_type(4)));
typedef unsigned u32x2 __attribute__((ext_vector_type(2)));
__device__ __forceinline__ float wave_sum(float v) {
#pragma unroll
    for (int o = 1; o < 64; o <<= 1) v += __shfl_xor(v, o);
    return v;
}
__device__ __forceinline__ float bf2f(unsigned short b) { return __uint_as_float(((unsigned)b) << 16); }
__device__ __forceinline__ float bflo(unsigned w) { return __uint_as_float(w << 16); }
__device__ __forceinline__ float bfhi(unsigned w) { return __uint_as_float(w & 0xffff0000u); }
__device__ __forceinline__ float fexp2(float x) { return __builtin_amdgcn_exp2f(x); }
__device__ __forceinline__ float fexp(float x) { return __builtin_amdgcn_exp2f(x * LOG2E); }
__device__ __forceinline__ float frcp(float x) { return __builtin_amdgcn_rcpf(x); }
__device__ __forceinline__ float silu_f(float x) { return x * frcp(1.0f + fexp(-x)); }
__device__ __forceinline__ float sigmoid_f(float x) { return frcp(1.0f + fexp(-x)); }
__device__ __forceinline__ u32x2 pack4(f32x4 v) { u32x2 w; w.x = pk2(v[0], v[1]); w.y = pk2(v[2], v[3]); return w; }
__device__ __forceinline__ f32x4 mfma16(bf16x8 a, bf16x8 b, f32x4 c) { return __builtin_amdgcn_mfma_f32_16x16x32_bf16(a, b, c, 0, 0, 0); }
__device__ __forceinline__ f32x16 mfma32(bf16x8 a, bf16x8 b, f32x16 c) { return __builtin_amdgcn_mfma_f32_32x32x16_bf16(a, b, c, 0, 0, 0); }
__device__ __forceinline__ int crow(int i, int h) { return (i & 3) + 8 * (i >> 2) + 4 * h; }
__device__ __forceinline__ bf16x8 ldg16(const bf16* p) { return *(const bf16x8*)p; }
__device__ __forceinline__ bf16x8 scale8u(bf16x8 v, float s) {
    const v4u u = __builtin_bit_cast(v4u, v); v4u o;
    o.x = pk2(bflo(u.x) * s, bfhi(u.x) * s); o.y = pk2(bflo(u.y) * s, bfhi(u.y) * s); o.z = pk2(bflo(u.z) * s, bfhi(u.z) * s); o.w = pk2(bflo(u.w) * s, bfhi(u.w) * s);
    return __builtin_bit_cast(bf16x8, o);
}
__device__ __forceinline__ bf16x8 scale8v(bf16x8 v, f32x4 s0, f32x4 s1) {
    const v4u u = __builtin_bit_cast(v4u, v); v4u o;
    o.x = pk2(bflo(u.x) * s0[0], bfhi(u.x) * s0[1]); o.y = pk2(bflo(u.y) * s0[2], bfhi(u.y) * s0[3]); o.z = pk2(bflo(u.z) * s1[0], bfhi(u.z) * s1[1]); o.w = pk2(bflo(u.w) * s1[2], bfhi(u.w) * s1[3]);
    return __builtin_bit_cast(bf16x8, o);
}
typedef __bf16 bf16x2_t __attribute__((ext_vector_type(2)));
typedef float f32x2_t __attribute__((ext_vector_type(2)));
__device__ __forceinline__ unsigned cvtpk(float lo, float hi) { const f32x2_t v = {lo, hi}; const bf16x2_t b = __builtin_convertvector(v, bf16x2_t); return __builtin_bit_cast(unsigned, b); }
__device__ __forceinline__ u32x2 pack4c(f32x4 v) { u32x2 w; w.x = cvtpk(v[0], v[1]); w.y = cvtpk(v[2], v[3]); return w; }

struct EpiSwiglu {
    static constexpr bool PERM = true, AFTER_DRAIN = false;
    bf16* ACT;
    __device__ __forceinline__ void operator()(const f32x4 (&acc)[2][2][4][2], const pg8::Unit& u, int wr, int wc, int fr, int fq) const {
        const int row0 = u.pm * 256 + wr * 64 + fr, col0 = u.pn * 128 + wc * 32 + 8 * fq;
#pragma unroll
        for (int ai = 0; ai < 2; ++ai)
#pragma unroll
            for (int m = 0; m < 4; ++m) {
                bf16* rowp = ACT + (size_t)(row0 + ai * 128 + m * 16) * FF + col0;
                const f32x4 g0 = acc[ai][0][m][0], g1 = acc[ai][0][m][1], u0 = acc[ai][1][m][0], u1 = acc[ai][1][m][1];
                f32x4 a0, a1;
#pragma unroll
                for (int e = 0; e < 4; ++e) { a0[e] = silu_f(g0[e]) * u0[e]; a1[e] = silu_f(g1[e]) * u1[e]; }
                v4u w; w.x = cvtpk(a0[0], a0[1]); w.y = cvtpk(a0[2], a0[3]); w.z = cvtpk(a1[0], a1[1]); w.w = cvtpk(a1[2], a1[3]);
                *(v4u*)rowp = w;
            }
    }
};

struct EpiResid {
    static constexpr bool PERM = false, AFTER_DRAIN = false;
    const float* base_l; const float* base_c; float* out_l; float* out_c; const float* gate; float wgt;
    __device__ __forceinline__ void operator()(const f32x4 (&acc)[2][2][4][2], const pg8::Unit& u, int wr, int wc, int fr, int fq) const {
        const int r0 = u.pm * 256; const bool lat = r0 < ML; const int mr = lat ? (r0 >> 12) : 8;
        const float* bp = lat ? base_l + (size_t)r0 * D : base_c + (size_t)(r0 - ML) * D;
        float* op = lat ? out_l + (size_t)r0 * D : out_c + (size_t)(r0 - ML) * D;
        const float* gp = gate + (size_t)mr * 9216;
        const int col0 = u.pn * 256 + wc * 32 + 4 * fq;
        f32x4 gv[2][2];
#pragma unroll
        for (int bj = 0; bj < 2; ++bj)
#pragma unroll
            for (int n = 0; n < 2; ++n) gv[bj][n] = *(const f32x4*)(gp + col0 + bj * 128 + n * 16) * wgt;
#pragma unroll
        for (int ai = 0; ai < 2; ++ai)
#pragma unroll
            for (int m = 0; m < 4; ++m) {
                const size_t ro = (size_t)(ai * 128 + wr * 64 + m * 16 + fr) * D;
#pragma unroll
                for (int bj = 0; bj < 2; ++bj)
#pragma unroll
                    for (int n = 0; n < 2; ++n) { const int c = col0 + bj * 128 + n * 16; const f32x4 x = *(const f32x4*)(bp + ro + c);
                        *(f32x4*)(op + ro + c) = x * ALPHA + gv[bj][n] * acc[ai][bj][m][n]; }
            }
    }
};

__device__ __forceinline__ void epi_store_T(const f32x4 (&acc)[2][2][4][2], int bj, bf16* tb, int TL, int trow, int t0, float sc, int wr, int wc, int fr, int fq) {
#ifdef NO_T
    return;
#endif
    bf16* p0 = tb + (size_t)(trow + bj * 128 + wc * 32 + 4 * fq) * TL + t0 + wr * 64 + fr;
#pragma unroll
    for (int ai = 0; ai < 2; ++ai)
#pragma unroll
        for (int m = 0; m < 4; ++m) {
#pragma unroll
            for (int n = 0; n < 2; ++n) { const u32x2 w = pack4c(acc[ai][bj][m][n] * sc);
                bf16* p = p0 + (size_t)(16 * n) * TL + ai * 128 + m * 16;
                p[0] = (bf16)(w.x & 0xffffu); p[(size_t)TL] = (bf16)(w.x >> 16); p[(size_t)2 * TL] = (bf16)(w.y & 0xffffu); p[(size_t)3 * TL] = (bf16)(w.y >> 16); }
            asm volatile("" ::: "memory");
        }
}
template <int ACT>
__device__ __forceinline__ void epi_store_P(const f32x4 (&acc)[2][2][4][2], int bj, bf16* dst0, int pitch, int cb, float sc, int wr, int wc, int fr, int fq) {
    bf16* p0 = dst0 + (size_t)(wr * 64 + fr) * pitch + cb + bj * 128 + wc * 32 + 4 * fq;
#pragma unroll
    for (int ai = 0; ai < 2; ++ai)
#pragma unroll
        for (int m = 0; m < 4; ++m) {
#pragma unroll
            for (int n = 0; n < 2; ++n) { f32x4 v = acc[ai][bj][m][n] * sc;
                if (ACT == 1) {
#pragma unroll
                    for (int e = 0; e < 4; ++e) v[e] = sigmoid_f(v[e]); }
                if (ACT == 2) {
#pragma unroll
                    for (int e = 0; e < 4; ++e) v[e] = silu_f(v[e]); }
                *(u32x2*)(p0 + (size_t)(ai * 128 + m * 16) * pitch + 16 * n) = pack4c(v); }
            asm volatile("" ::: "memory");
        }
}
__device__ __forceinline__ void epi_store_R(const f32x4 (&acc)[2][2][4][2], int bj, bf16* dst0, int pitch, int cb, float sc, bool rope, int t0, const float* cosT, const float* sinT, int wr, int wc, int fr, int fq) {
#ifdef NO_R
    return;
#endif
    bf16* p0 = dst0 + (size_t)(wr * 64 + fr) * pitch + cb + bj * 128 + wc * 32 + 4 * fq;
#pragma unroll
    for (int ai = 0; ai < 2; ++ai)
#pragma unroll
        for (int m = 0; m < 4; ++m) { const int rr = ai * 128 + wr * 64 + m * 16 + fr; const int t = t0 + rr;
            const f32x4 x1 = acc[ai][bj][m][0], x2 = acc[ai][bj][m][1]; f32x4 o1 = x1, o2 = x2;
            if (rope) { const int pos = (wc & 1) ? (t & 63) : (t >> 6);
                const f32x4 c4 = *(const f32x4*)(cosT + pos * 16 + 4 * fq), s4 = *(const f32x4*)(sinT + pos * 16 + 4 * fq);
                o1 = x1 * c4 - x2 * s4; o2 = x2 * c4 + x1 * s4; }
            bf16* p = p0 + (size_t)(ai * 128 + m * 16) * pitch;
            *(u32x2*)p = pack4c(o1 * sc); *(u32x2*)(p + 16) = pack4c(o2 * sc);
            asm volatile("" ::: "memory"); }
}

struct EpiAttnIn {
    static constexpr bool PERM = false, AFTER_DRAIN = false;
    unsigned char* ws;
    __device__ __forceinline__ void operator()(const f32x4 (&acc)[2][2][4][2], const pg8::Unit& u, int wr, int wc, int fr, int fq) const {
        asm volatile("" : "+v"(fr), "+v"(fq));
        const int r0 = u.pm * 256; const bool lat = r0 < ML; const int b = lat ? (r0 >> 12) : ((r0 - ML) >> 8); const int t0 = lat ? (r0 & 4095) : 0;
        const int pn = u.pn; const int TL = lat ? T : TC;
        const float* cosT = (const float*)(ws + WS_ROPE); const float* sinT = cosT + 1024;
        if (pn == 4 || pn == 5) {
            bf16* vb = (bf16*)(ws + (lat ? WS_VTA_L : WS_VTA_C)) + (size_t)b * 512 * TL;
            epi_store_T(acc, 0, vb, TL, (pn - 4) * 256, t0, 1.f, wr, wc, fr, fq); epi_store_T(acc, 1, vb, TL, (pn - 4) * 256, t0, 1.f, wr, wc, fr, fq);
        } else if (pn == 8) {
            epi_store_R(acc, 0, (bf16*)(ws + WS_BK) + (size_t)r0 * 128, 128, 0, 1.f, lat, t0, cosT, sinT, wr, wc, fr, fq);
            epi_store_T(acc, 1, (bf16*)(ws + (lat ? WS_VTB_L : WS_VTB_C)) + (size_t)b * 128 * TL, TL, -128, t0, 1.f, wr, wc, fr, fq);
        } else {
            const size_t off = (pn < 2) ? WS_AQ : (pn < 4) ? WS_AK : WS_BQ;
            bf16* dst = (bf16*)(ws + off); const int cb = (pn & 1) * 256; const float sc = (pn < 2 || pn >= 6) ? QSCALE : 1.f;
            epi_store_R(acc, 0, dst + (size_t)r0 * 512, 512, cb, sc, lat, t0, cosT, sinT, wr, wc, fr, fq); epi_store_R(acc, 1, dst + (size_t)r0 * 512, 512, cb, sc, lat, t0, cosT, sinT, wr, wc, fr, fq);
        }
    }
};

struct EpiRecIn {
    static constexpr bool PERM = false, AFTER_DRAIN = false;
    unsigned char* ws; const float* gate_b;
    __device__ __forceinline__ void operator()(const f32x4 (&acc)[2][2][4][2], const pg8::Unit& u, int wr, int wc, int fr, int fq) const {
        asm volatile("" : "+v"(fr), "+v"(fq));
        const int r0 = u.pm * 256; const bool lat = r0 < ML; const int b = lat ? (r0 >> 12) : ((r0 - ML) >> 8); const int t0 = lat ? (r0 & 4095) : 0;
        const int pn = u.pn; const int TL = lat ? T : TC;
        if (pn == 14) {
            if (wc == 0) {
                const f32x4 gb = *(const f32x4*)(gate_b + 4 * fq);
                const bool isf = (fq & 1) != 0;
#pragma unroll
                for (int ai = 0; ai < 2; ++ai)
#pragma unroll
                    for (int m = 0; m < 4; ++m) { const int rr = ai * 128 + wr * 64 + m * 16 + fr; f32x4 v = acc[ai][0][m][0] + gb;
                        if (isf) {
#pragma unroll
                            for (int e = 0; e < 4; ++e) { const float x = v[e]; v[e] = fminf(x, 0.f) - log1pf(__expf(-fabsf(x))); } }
                        *(f32x4*)((float*)(ws + WS_GATE) + (size_t)(r0 + rr) * 16 + 4 * fq) = v; }
            }
        } else if (pn < 2) { bf16* d0 = (bf16*)(ws + WS_MQ) + (size_t)r0 * 512; epi_store_P<0>(acc, 0, d0, 512, pn * 256, 1.f, wr, wc, fr, fq); epi_store_P<0>(acc, 1, d0, 512, pn * 256, 1.f, wr, wc, fr, fq); }
        else if (pn < 4) { const float sc = 0.08838834764831845f; bf16* d0 = (bf16*)(ws + WS_MK) + (size_t)r0 * 512; bf16* tb = (bf16*)(ws + (lat ? WS_MKT_L : WS_MKT_C)) + (size_t)b * 512 * TL;
#pragma unroll
            for (int bj = 0; bj < 2; ++bj) { epi_store_P<0>(acc, bj, d0, 512, (pn - 2) * 256, sc, wr, wc, fr, fq); epi_store_T(acc, bj, tb, TL, (pn - 2) * 256, t0, sc, wr, wc, fr, fq); } }
        else if (pn < 6) { bf16* tb = (bf16*)(ws + (lat ? WS_MVT_L : WS_MVT_C)) + (size_t)b * 512 * TL; epi_store_T(acc, 0, tb, TL, (pn - 4) * 256, t0, 1.f, wr, wc, fr, fq); epi_store_T(acc, 1, tb, TL, (pn - 4) * 256, t0, 1.f, wr, wc, fr, fq); }
        else if (pn < 8) { bf16* d0 = (bf16*)(ws + WS_MO) + (size_t)r0 * 512; epi_store_P<1>(acc, 0, d0, 512, (pn - 6) * 256, 1.f, wr, wc, fr, fq); epi_store_P<1>(acc, 1, d0, 512, (pn - 6) * 256, 1.f, wr, wc, fr, fq); }
        else if (pn == 8) { bf16* d0 = (bf16*)(ws + WS_RQ) + (size_t)r0 * 256; epi_store_P<0>(acc, 0, d0, 256, 0, 1.f, wr, wc, fr, fq); epi_store_P<0>(acc, 1, d0, 256, 0, 1.f, wr, wc, fr, fq); }
        else if (pn == 9) { bf16* d0 = (bf16*)(ws + WS_RK) + (size_t)r0 * 256; bf16* tb = (bf16*)(ws + (lat ? WS_RKT_L : WS_RKT_C)) + (size_t)b * 256 * TL;
#pragma unroll
            for (int bj = 0; bj < 2; ++bj) { epi_store_P<0>(acc, bj, d0, 256, 0, 0.125f, wr, wc, fr, fq); epi_store_T(acc, bj, tb, TL, 0, t0, 0.125f, wr, wc, fr, fq); } }
        else if (pn < 12) { bf16* tb = (bf16*)(ws + (lat ? WS_RVT_L : WS_RVT_C)) + (size_t)b * 512 * TL; epi_store_T(acc, 0, tb, TL, (pn - 10) * 256, t0, 1.f, wr, wc, fr, fq); epi_store_T(acc, 1, tb, TL, (pn - 10) * 256, t0, 1.f, wr, wc, fr, fq); }
        else { bf16* d0 = (bf16*)(ws + WS_RG) + (size_t)r0 * 512; epi_store_P<2>(acc, 0, d0, 512, (pn - 12) * 256, 1.f, wr, wc, fr, fq); epi_store_P<2>(acc, 1, d0, 512, (pn - 12) * 256, 1.f, wr, wc, fr, fq); }
    }
};
struct Args { const float* in[22]; float* out; unsigned char* ws; int ph_lo, ph_hi; };
enum { I_X = 0, I_C, I_CTX, I_CCTX, I_ADAW, I_ADAB, I_LNG, I_LNB, I_FWI, I_FWO, I_AWI, I_AWO, I_DLAM, I_DNG, I_SINK, I_RWI, I_RWO, I_MGB, I_MNG, I_RDL, I_RNG, I_RNB };

__device__ __forceinline__ void tr_item(const float* W, int ldw, int k0, int c0, int nvalid, bf16* WT, int K, int r0, LAS float* scr, int lane) {
    const int col = lane & 31;
#pragma unroll 8
    for (int i = 0; i < 32; ++i) { const int kk = 2 * i + (lane >> 5); scr[kk * 33 + col] = (col < nvalid) ? W[(size_t)(k0 + kk) * ldw + c0 + col] : 0.f; }
    LDS_WAIT(); asm volatile("" ::: "memory");
    const int c = lane & 7;
#pragma unroll
    for (int j = 0; j < 4; ++j) { const int n = (lane >> 3) + 8 * j; const LAS float* s = scr + (8 * c) * 33 + n;
        v4u o; o.x = pk2(s[0 * 33], s[1 * 33]); o.y = pk2(s[2 * 33], s[3 * 33]); o.z = pk2(s[4 * 33], s[5 * 33]); o.w = pk2(s[6 * 33], s[7 * 33]);
        *(v4u*)(WT + (size_t)(r0 + n) * K + k0 + 8 * c) = o; }
    LDS_WAIT(); asm volatile("" ::: "memory");
}

__device__ __forceinline__ void p0a_prologue(const Args& a, LAS unsigned char* lds, int G, int vcu, int tid, int lane, int wave) {
    unsigned char* ws = a.ws;
    LAS float* scr = (LAS float*)(lds + wave * 8448);
    const int gw = vcu * NWAVES + wave, NGW = G * NWAVES;
    constexpr int I_FI = 16 * 176, I_FO = 44 * 32, I_AI = 16 * 72, I_AO = 16 * 32, I_RI = 16 * 120, I_RO = 16 * 32;
    constexpr int NITEMS = 4 * I_FI + 4 * I_FO + I_AI + I_AO + I_RI + I_RO;
    for (int it = gw; it < NITEMS; it += NGW) {
        int r = it;
        if (r < 4 * I_FI) { const int mi = r / I_FI; r -= mi * I_FI; const int kb = r / 176, nb = r % 176, pn = nb >> 3, q = nb & 7;
            const int c0 = (q < 4) ? (128 * pn + 32 * q) : (FF + 128 * pn + 32 * (q - 4));
            tr_item(a.in[I_FWI] + (size_t)mi * D * N_FI, N_FI, 64 * kb, c0, 32, (bf16*)(ws + WS_WFI) + (size_t)mi * N_FI * D, D, 32 * nb, scr, lane); continue; }
        r -= 4 * I_FI;
        if (r < 4 * I_FO) { const int mi = r / I_FO; r -= mi * I_FO; const int kb = r / 32, nb = r % 32;
            tr_item(a.in[I_FWO] + (size_t)mi * FF * D, D, 64 * kb, 32 * nb, 32, (bf16*)(ws + WS_WFO) + (size_t)mi * D * FF, FF, 32 * nb, scr, lane); continue; }
        r -= 4 * I_FO;
        if (r < I_AI) { const int kb = r / 72, nb = r % 72; tr_item(a.in[I_AWI], N_AI, 64 * kb, 32 * nb, 32, (bf16*)(ws + WS_WAI), D, 32 * nb, scr, lane); continue; }
        r -= I_AI;
        if (r < I_AO) { const int kb = r / 32, nb = r % 32; tr_item(a.in[I_AWO], D, 64 * kb, 32 * nb, 32, (bf16*)(ws + WS_WAO), D, 32 * nb, scr, lane); continue; }
        r -= I_AO;
        if (r < I_RI) { const int kb = r / 120, nb = r % 120, n0 = 32 * nb; int c0, nv;
            if (n0 < 2048) { c0 = n0; nv = 32; } else if (n0 < 3584) { c0 = n0 + 16; nv = 32; } else if (n0 == 3584) { c0 = 2048; nv = 16; } else { c0 = 0; nv = 0; }
            tr_item(a.in[I_RWI], N_RI_SRC, 64 * kb, c0, nv, (bf16*)(ws + WS_WRI), D, n0, scr, lane); continue; }
        r -= I_RI;
        { const int kb = r / 32, nb = r % 32; tr_item(a.in[I_RWO], D, 64 * kb, 32 * nb, 32, (bf16*)(ws + WS_WRO), D, 32 * nb, scr, lane); }
    }
    __syncthreads();
    {
        LAS float* sc = (LAS float*)lds;
        LAS float* red = (LAS float*)(lds + 36864);
        float* MOD = (float*)(ws + WS_MOD);
        if (blockIdx.x < 288) {
            for (int idx = tid; idx < 9216; idx += 512) { const int r = idx >> 10, k = idx & 1023; const float cv = (r < 8) ? a.in[I_C][r * 1024 + k] : a.in[I_CCTX][k]; sc[idx] = silu_f(cv); }
        }
        __syncthreads();
        for (int u = blockIdx.x; u < 288; u += G) {
            const int l = u / 144, ng = u % 144, n = 64 * ng + lane;
            const float* W = a.in[I_ADAW] + (size_t)l * D * 9216 + n;
            float acc[9];
#pragma unroll
            for (int r = 0; r < 9; ++r) acc[r] = 0.f;
#pragma unroll 8
            for (int kk = 0; kk < 128; ++kk) { const int k = wave * 128 + kk; const float wv = W[(size_t)k * 9216];
#pragma unroll
                for (int r = 0; r < 9; ++r) acc[r] += sc[r * 1024 + k] * wv; }
#pragma unroll
            for (int r = 0; r < 9; ++r) red[(wave * 9 + r) * 64 + lane] = acc[r];
            __syncthreads();
            for (int idx = tid; idx < 576; idx += 512) { const int r = idx >> 6, ln = idx & 63; float s = 0.f;
#pragma unroll
                for (int w = 0; w < 8; ++w) s += red[(w * 9 + r) * 64 + ln];
                MOD[(size_t)(l * 9 + r) * 9216 + 64 * ng + ln] = s + a.in[I_ADAB][l * 9216 + 64 * ng + ln]; }
            __syncthreads();
        }
    }
    if (blockIdx.x == 0) {
        float* cosT = (float*)(ws + WS_ROPE); float* sinT = cosT + 1024;
        for (int idx = tid; idx < 1024; idx += 512) { const int pos = idx >> 4, f = idx & 15; const float inv = powf(10000.0f, -(float)f / 16.0f); const float ang = (float)pos * inv;
            cosT[idx] = cosf(ang); sinT[idx] = sinf(ang); }
        if (wave == 0) { const float* dl = a.in[I_DLAM]; const float s1 = wave_sum(dl[lane] * dl[64 + lane]), s2 = wave_sum(dl[128 + lane] * dl[192 + lane]);
            if (lane == 0) *(float*)(ws + WS_LAM) = expf(s1) - expf(s2) + 0.2f; }
    }
}

__device__ __forceinline__ void p0b_modulate(const Args& a, int gw, int NGW, int lane) {
    const float* MOD = (const float*)(a.ws + WS_MOD); bf16* H = (bf16*)(a.ws + WS_H);
    for (int r = gw; r < M; r += NGW) {
        const float* xr = (r < ML) ? a.in[I_X] + (size_t)r * D : a.in[I_CTX] + (size_t)(r - ML) * D;
        const float* mp = MOD + (size_t)((r < ML) ? (r >> 12) : 8) * 9216;
#pragma unroll
        for (int j = 0; j < 4; ++j) { const int c = 4 * (lane + 64 * j); const f32x4 x = *(const f32x4*)(xr + c), sh = *(const f32x4*)(mp + c), sc = *(const f32x4*)(mp + 1024 + c);
            *(u32x2*)(H + (size_t)r * D + c) = pack4c(x * (sc + 1.0f) + sh); }
    }
}

__device__ __forceinline__ void ln_phase(float* out_l, float* out_c, const float* g, const float* bt, const float* modn, bf16* H, int nrows, int gw, int NGW, int lane) {
    f32x4 g4[4], b4[4];
#pragma unroll
    for (int j = 0; j < 4; ++j) { g4[j] = *(const f32x4*)(g + 4 * (lane + 64 * j)); b4[j] = *(const f32x4*)(bt + 4 * (lane + 64 * j)); }
    for (int r = gw; r < nrows; r += NGW) {
        float* zr = (r < ML) ? out_l + (size_t)r * D : out_c + (size_t)(r - ML) * D;
        f32x4 v[4]; float s = 0.f;
#pragma unroll
        for (int j = 0; j < 4; ++j) { v[j] = *(const f32x4*)(zr + 4 * (lane + 64 * j)); s += (v[j][0] + v[j][1]) + (v[j][2] + v[j][3]); }
        const float mean = wave_sum(s) * (1.f / D); float s2 = 0.f;
#pragma unroll
        for (int j = 0; j < 4; ++j) { v[j] = v[j] - mean; s2 += (v[j][0] * v[j][0] + v[j][1] * v[j][1]) + (v[j][2] * v[j][2] + v[j][3] * v[j][3]); }
        const float rstd = 1.0f / sqrtf(wave_sum(s2) * (1.f / D) + 1e-5f);
        const float* mp = modn ? modn + (size_t)((r < ML) ? (r >> 12) : 8) * 9216 : nullptr;
#pragma unroll
        for (int j = 0; j < 4; ++j) { const int c = 4 * (lane + 64 * j); const f32x4 y = v[j] * rstd * g4[j] + b4[j]; *(f32x4*)(zr + c) = y;
            if (mp) { const f32x4 sh = *(const f32x4*)(mp + c), sc = *(const f32x4*)(mp + 1024 + c); *(u32x2*)(H + (size_t)r * D + c) = pack4c(y * (sc + 1.0f) + sh); } }
    }
}
template <int NDV> struct AttW { f32x16 o[NDV]; float m, l; };

template <int NDV, bool MASK>
__device__ __forceinline__ void attn_block(AttW<NDV>& S, const bf16x8 (&qf)[4], const bf16* Kp, int kpitch, const bf16* Vp, int vpitch, int r, int h, int qpos, int kpos0) {
    f32x16 st;
#pragma unroll
    for (int i = 0; i < 16; ++i) st[i] = 0.f;
#pragma unroll
    for (int s = 0; s < 4; ++s) { const bf16x8 kf = ldg16(Kp + (size_t)r * kpitch + 16 * s + 8 * h); st = mfma32(kf, qf[s], st); }
    if (MASK) {
#pragma unroll
        for (int i = 0; i < 16; ++i) { const int dlt = qpos - (kpos0 + crow(i, h)); if (dlt > 128 || dlt < -128) st[i] = -INFINITY; }
    }
    float mx = st[0];
#pragma unroll
    for (int i = 1; i < 16; ++i) mx = fmaxf(mx, st[i]);
    mx = fmaxf(mx, __shfl_xor(mx, 32));
    const float mn = fmaxf(S.m, mx), alpha = fexp2(S.m - mn);
    S.m = mn;
    float ps = 0.f;
#pragma unroll
    for (int i = 0; i < 16; ++i) { st[i] = fexp2(st[i] - mn); ps += st[i]; }
    S.l = S.l * alpha + ps;
#pragma unroll
    for (int d = 0; d < NDV; ++d) S.o[d] = S.o[d] * alpha;
    bf16x8 pf[2];
#pragma unroll
    for (int s2 = 0; s2 < 2; ++s2) { v4u w; w.x = cvtpk(st[8 * s2 + 0], st[8 * s2 + 1]); w.y = cvtpk(st[8 * s2 + 2], st[8 * s2 + 3]); w.z = cvtpk(st[8 * s2 + 4], st[8 * s2 + 5]); w.w = cvtpk(st[8 * s2 + 6], st[8 * s2 + 7]);
        pf[s2] = __builtin_bit_cast(bf16x8, w); }
#pragma unroll
    for (int s2 = 0; s2 < 2; ++s2)
#pragma unroll
        for (int d = 0; d < NDV; ++d) { const bf16* vp = Vp + (size_t)(32 * d + r) * vpitch + 16 * s2 + 4 * h;
            const u32x2 lo = *(const u32x2*)vp, hi = *(const u32x2*)(vp + 8); v4u w; w.x = lo.x; w.y = lo.y; w.z = hi.x; w.w = hi.y;
            S.o[d] = mfma32(__builtin_bit_cast(bf16x8, w), pf[s2], S.o[d]); }
}

__device__ __forceinline__ void load_q(bf16x8 (&qf)[4], const bf16* Qp, int pitch, int r, int h) {
#pragma unroll
    for (int s = 0; s < 4; ++s) qf[s] = ldg16(Qp + (size_t)r * pitch + 16 * s + 8 * h);
}

constexpr int ATT_UNITS = 2176;
__device__ __forceinline__ void attn_phase(const Args& a, LAS unsigned char* lds, int G, int vcu, int lane, int wave) {
    unsigned char* ws = a.ws;
    const bf16* AQ = (const bf16*)(ws + WS_AQ); const bf16* AK = (const bf16*)(ws + WS_AK); const bf16* BQ = (const bf16*)(ws + WS_BQ); const bf16* BK = (const bf16*)(ws + WS_BK);
    const bf16* VTA_L = (const bf16*)(ws + WS_VTA_L); const bf16* VTA_C = (const bf16*)(ws + WS_VTA_C); const bf16* VTB_L = (const bf16*)(ws + WS_VTB_L); const bf16* VTB_C = (const bf16*)(ws + WS_VTB_C);
    bf16* O = (bf16*)(ws + WS_H);
    const int r = lane & 31, h = lane >> 5;
    LAS float* X = (LAS float*)lds;
    for (int u = vcu; u < ATT_UNITS; u += G) {
        const bool isdiff = (u < 1024) || (u >= 2048 && u < 2112);
        if (isdiff) {
            const bool lat = u < 1024; const int uu = lat ? u : u - 2048;
            const int bh = lat ? (uu >> 5) : (uu >> 1), qb = lat ? (uu & 31) : (uu & 1), b = bh >> 2, hd = bh & 3;
            const int sub = wave & 1, qs = wave >> 1;
            const int qrow0 = (lat ? b * T : ML + b * TC) + qb * 128 + qs * 32;
            bf16x8 qf[4]; load_q(qf, AQ + (size_t)qrow0 * 512 + hd * 128 + sub * 64, 512, r, h);
            AttW<4> S;
#pragma unroll
            for (int d = 0; d < 4; ++d)
#pragma unroll
                for (int i = 0; i < 16; ++i) S.o[d][i] = 0.f;
            S.m = -1e30f; S.l = 0.f;
            if (lat) {
                const bf16* Kb = AK + (size_t)(b * T) * 512 + hd * 128 + sub * 64; const bf16* Vb = VTA_L + (size_t)(b * 4 + hd) * 128 * T;
                for (int kb = 0; kb < T; kb += 32) attn_block<4, false>(S, qf, Kb + (size_t)kb * 512, 512, Vb + kb, T, r, h, 0, 0);
            }
            { const bf16* Kb = AK + (size_t)(ML + b * TC) * 512 + hd * 128 + sub * 64; const bf16* Vb = VTA_C + (size_t)(b * 4 + hd) * 128 * TC;
                for (int kb = 0; kb < TC; kb += 32) attn_block<4, false>(S, qf, Kb + (size_t)kb * 512, 512, Vb + kb, TC, r, h, 0, 0); }
            const float lt = S.l + __shfl_xor(S.l, 32); const float inv = 1.0f / lt;
            if (sub == 1) { const float lam = *(const float*)(ws + WS_LAM); const float f = inv * lam;
#pragma unroll
                for (int d = 0; d < 4; ++d)
#pragma unroll
                    for (int i = 0; i < 16; ++i) X[(qs * 128 + 32 * d + crow(i, h)) * 32 + r] = S.o[d][i] * f; }
            __syncthreads();
            if (sub == 0) { float ss = 0.f;
#pragma unroll
                for (int d = 0; d < 4; ++d)
#pragma unroll
                    for (int i = 0; i < 16; ++i) { const float v = S.o[d][i] * inv - X[(qs * 128 + 32 * d + crow(i, h)) * 32 + r]; S.o[d][i] = v; ss += v * v; }
                ss += __shfl_xor(ss, 32);
                const float rs = 0.8f / sqrtf(ss * (1.0f / 128.0f) + 1e-5f);
                const float* gn = a.in[I_DNG];
                bf16* op = O + (size_t)(qrow0 + r) * D + hd * 128;
#pragma unroll
                for (int d = 0; d < 4; ++d)
#pragma unroll
                    for (int k4 = 0; k4 < 4; ++k4) { const int dv = 32 * d + 8 * k4 + 4 * h; const f32x4 g4 = *(const f32x4*)(gn + dv);
                        f32x4 v; v[0] = S.o[d][4 * k4] * rs * g4[0]; v[1] = S.o[d][4 * k4 + 1] * rs * g4[1]; v[2] = S.o[d][4 * k4 + 2] * rs * g4[2]; v[3] = S.o[d][4 * k4 + 3] * rs * g4[3];
                        *(u32x2*)(op + dv) = pack4c(v); }
            }
            __syncthreads();
        } else {
            const bool lat = u < 2048; const int uu = lat ? u - 1024 : u - 2112;
            const int bk = lat ? (uu >> 6) : (uu >> 2), qb = lat ? (uu & 63) : (uu & 3), b = bk >> 1, kvh = bk & 1;
            const int g4i = wave >> 1, qs = wave & 1, hd = kvh * 4 + g4i;
            const int t0 = qb * 64 + qs * 32;
            const int qrow0 = (lat ? b * T : ML + b * TC) + t0;
            bf16x8 qf[4]; load_q(qf, BQ + (size_t)qrow0 * 512 + hd * 64, 512, r, h);
            AttW<2> S;
#pragma unroll
            for (int d = 0; d < 2; ++d)
#pragma unroll
                for (int i = 0; i < 16; ++i) S.o[d][i] = 0.f;
            S.m = a.in[I_SINK][hd] * LOG2E; S.l = (h == 0) ? 1.0f : 0.0f;
            if (lat) {
                const int lo = (qb * 64 - 128) < 0 ? 0 : (qb * 64 - 128), hi = (qb * 64 + 192) > T ? T : (qb * 64 + 192);
                const bf16* Kb = BK + (size_t)(b * T) * 128 + kvh * 64; const bf16* Vb = VTB_L + (size_t)(b * 2 + kvh) * 64 * T;
                for (int kb = lo; kb < hi; kb += 32) attn_block<2, true>(S, qf, Kb + (size_t)kb * 128, 128, Vb + kb, T, r, h, t0 + r, kb);
            }
            { const bf16* Kb = BK + (size_t)(ML + b * TC) * 128 + kvh * 64; const bf16* Vb = VTB_C + (size_t)(b * 2 + kvh) * 64 * TC;
                for (int kb = 0; kb < TC; kb += 32) attn_block<2, false>(S, qf, Kb + (size_t)kb * 128, 128, Vb + kb, TC, r, h, 0, 0); }
            const float lt = S.l + __shfl_xor(S.l, 32); const float inv = 1.0f / lt;
            bf16* op = O + (size_t)(qrow0 + r) * D + 512 + hd * 64;
#pragma unroll
            for (int d = 0; d < 2; ++d)
#pragma unroll
                for (int k4 = 0; k4 < 4; ++k4) { const int dv = 32 * d + 8 * k4 + 4 * h;
                    f32x4 v; v[0] = S.o[d][4 * k4] * inv; v[1] = S.o[d][4 * k4 + 1] * inv; v[2] = S.o[d][4 * k4 + 2] * inv; v[3] = S.o[d][4 * k4 + 3] * inv;
                    *(u32x2*)(op + dv) = pack4c(v); }
        }
    }
}
constexpr int SC_CT = 0;
constexpr int SC_S = 39168;
constexpr int SC_SA = SC_S + 8 * 4352;
constexpr int SC_SB = SC_SA + 4352 * 4;
constexpr int SC_SG = SC_SB + 4352 * 4;
constexpr int SC_CH = SC_SG + 4352 * 4;
static_assert(SC_CH + 4 * 128 <= RING_BYTES, "scan LDS");

template <int DK, bool MLSTM>
__device__ __forceinline__ void scan_chain(const Args& a, LAS unsigned char* lds, int b, int hd, int dir, int tid, int lane, int wave) {
    unsigned char* ws = a.ws;
    constexpr int KS = DK / 32, CTP = DK + 8, NDVT = MLSTM ? 9 : 8, NOWN = MLSTM ? 9 : 4;
    const int c = lane & 15, g = lane >> 4;
    const bf16* Qr = MLSTM ? (const bf16*)(ws + WS_MQ) + hd * 128 : (const bf16*)(ws + WS_RQ) + hd * 64;
    const bf16* Kr = MLSTM ? (const bf16*)(ws + WS_MK) + hd * 128 : (const bf16*)(ws + WS_RK) + hd * 64;
    constexpr int RP = MLSTM ? 512 : 256;
    const bf16* KtL = MLSTM ? (const bf16*)(ws + WS_MKT_L) + (size_t)(b * 4 + hd) * 128 * T : (const bf16*)(ws + WS_RKT_L) + (size_t)(b * 4 + hd) * 64 * T;
    const bf16* KtC = MLSTM ? (const bf16*)(ws + WS_MKT_C) + (size_t)(b * 4 + hd) * 128 * TC : (const bf16*)(ws + WS_RKT_C) + (size_t)(b * 4 + hd) * 64 * TC;
    const bf16* VtL = MLSTM ? (const bf16*)(ws + WS_MVT_L) + (size_t)(b * 4 + hd) * 128 * T : (const bf16*)(ws + WS_RVT_L) + (size_t)(b * 4 + hd) * 128 * T;
    const bf16* VtC = MLSTM ? (const bf16*)(ws + WS_MVT_C) + (size_t)(b * 4 + hd) * 128 * TC : (const bf16*)(ws + WS_RVT_C) + (size_t)(b * 4 + hd) * 128 * TC;
    bf16* OUT = (bf16*)(ws + (dir == 0 ? WS_H : WS_HB)) + (MLSTM ? hd * 128 : 512 + hd * 128);
    LAS bf16* CT = (LAS bf16*)(lds + SC_CT);
    LAS bf16* Sw = (LAS bf16*)(lds + SC_S + wave * 4352);
    LAS float* sa = (LAS float*)(lds + SC_SA); LAS float* sb = (LAS float*)(lds + SC_SB); LAS float* sg = (LAS float*)(lds + SC_SG);
    LAS float* mch = (LAS float*)(lds + SC_CH); LAS float* bend = mch + 36; LAS float* gend = bend + 34;
    const bool fwd = dir == 0;
    for (int i = tid; i < 144 * CTP / 2; i += 512) ((LAS unsigned*)CT)[i] = 0u;
    float lg = 0.f;
    if (MLSTM) {
        const float* GATE = (const float*)(ws + WS_GATE);
        for (int ci = wave; ci < 34; ci += 8) {
            const int rowb = (ci < 2) ? (ML + b * TC + ci * 128) : (b * T + (ci - 2) * 128), pb = ci * 128;
            const int u0 = 2 * lane, u1 = 2 * lane + 1, i0 = fwd ? u0 : 127 - u0, i1 = fwd ? u1 : 127 - u1;
            const float f0 = GATE[(size_t)(rowb + i0) * 16 + dir * 8 + 4 + hd], f1 = GATE[(size_t)(rowb + i1) * 16 + dir * 8 + 4 + hd];
            const float p0 = GATE[(size_t)(rowb + i0) * 16 + dir * 8 + hd], p1 = GATE[(size_t)(rowb + i1) * 16 + dir * 8 + hd];
            float s = f0 + f1;
#pragma unroll
            for (int o = 1; o < 64; o <<= 1) { const float t = __shfl_up(s, o); if (lane >= o) s += t; }
            const float b1 = s, b0 = s - f1, a0 = p0 - b0, a1 = p1 - b1;
            float pm = fmaxf(a0, a1);
#pragma unroll
            for (int o = 1; o < 64; o <<= 1) { const float t = __shfl_up(pm, o); if (lane >= o) pm = fmaxf(pm, t); }
            float ex = __shfl_up(pm, 1); if (lane == 0) ex = -INFINITY;
            const float g0 = fmaxf(ex, a0), g1 = pm;
            sa[pb + i0] = a0; sa[pb + i1] = a1; sb[pb + i0] = b0; sb[pb + i1] = b1; sg[pb + i0] = g0; sg[pb + i1] = g1;
            if (lane == 63) { bend[ci] = b1; gend[ci] = g1; }
        }
        __syncthreads();
        if (tid == 0) { float m = 0.f;
            for (int s = 0; s < 34; ++s) { const int ci = fwd ? s : (s < 2 ? 1 - s : 35 - s); mch[s] = m; m = bend[ci] + fmaxf(m, gend[ci]); }
            mch[34] = m; }
    } else {
        const float x = a.in[I_RDL][dir * 4 + hd]; lg = fminf(x, 0.f) - log1pf(__expf(-fabsf(x)));
    }
    __syncthreads();
    const int dkt = MLSTM ? wave : (wave & 3), dv0 = MLSTM ? 0 : 4 * (wave >> 2);
    f32x4 ct[NOWN];
#pragma unroll
    for (int t = 0; t < NOWN; ++t) ct[t] = (f32x4){0.f, 0.f, 0.f, 0.f};
    bf16x8 ones; { const short o1 = (c == 0) ? (short)0x3F80 : (short)0; ones = (bf16x8){o1, o1, o1, o1, o1, o1, o1, o1}; }

    for (int s = 0; s < 34; ++s) {
        const int ci = fwd ? s : (s < 2 ? 1 - s : 35 - s);
        const bool isctx = ci < 2;
        const int rowb = isctx ? (ML + b * TC + ci * 128) : (b * T + (ci - 2) * 128);
        const int pb = ci * 128;
        const int tp = isctx ? TC : T;
        const bf16* Kt = isctx ? KtC + ci * 128 : KtL + (ci - 2) * 128;
        const bf16* Vt = isctx ? VtC + ci * 128 : VtL + (ci - 2) * 128;
        float m_c = 0.f, m_new = 0.f, b_end = 0.f;
        if (MLSTM) { m_c = mch[s]; m_new = mch[s + 1]; b_end = bend[ci]; }
        if (!isctx) {
            const int q = 16 * wave + c;
            bf16x8 qf[KS];
#pragma unroll
            for (int ks = 0; ks < KS; ++ks) qf[ks] = ldg16(Qr + (size_t)(rowb + q) * RP + 32 * ks + 8 * g);
            float gq = 0.f; if (MLSTM) gq = fmaxf(m_c, sg[pb + q]);
#pragma unroll 1
            for (int jt = 0; jt < 8; ++jt) {
                f32x4 acc = (f32x4){0.f, 0.f, 0.f, 0.f};
#pragma unroll
                for (int ks = 0; ks < KS; ++ks) acc = mfma16(ldg16(Kr + (size_t)(rowb + 16 * jt + c) * RP + 32 * ks + 8 * g), qf[ks], acc);
                f32x4 v;
#pragma unroll
                for (int e = 0; e < 4; ++e) { const int j = 16 * jt + 4 * g + e; const bool ok = fwd ? (j <= q) : (j >= q);
                    float dm;
                    if (MLSTM) dm = fexp(sa[pb + j] - gq); else dm = fexp(lg * (float)(fwd ? (q - j) : (j - q)));
                    v[e] = ok ? acc[e] * dm : 0.f; }
                *(LAS u32x2*)(Sw + c * 136 + 16 * jt + 4 * g) = pack4c(v);
            }
            LDS_WAIT();
            f32x4 nt[NDVT];
#pragma unroll
            for (int t = 0; t < NDVT; ++t) nt[t] = (f32x4){0.f, 0.f, 0.f, 0.f};
#pragma unroll 1
            for (int ks2 = 0; ks2 < 4; ++ks2) {
                const bf16x8 sf = *(const LAS bf16x8*)(Sw + c * 136 + 32 * ks2 + 8 * g);
#pragma unroll
                for (int t = 0; t < 8; ++t) nt[t] = mfma16(ldg16(Vt + (size_t)(16 * t + c) * tp + 32 * ks2 + 8 * g), sf, nt[t]);
                if (MLSTM) nt[NDVT - 1] = mfma16(ones, sf, nt[NDVT - 1]);
            }
            const float wi = MLSTM ? fexp(m_c - gq) : fexp(lg * (float)(fwd ? (q + 1) : (128 - q)));
#pragma unroll
            for (int ks = 0; ks < KS; ++ks) {
                const bf16x8 qs = scale8u(qf[ks], wi);
#pragma unroll
                for (int t = 0; t < NDVT; ++t) nt[t] = mfma16(*(const LAS bf16x8*)(CT + (16 * t + c) * CTP + 32 * ks + 8 * g), qs, nt[t]);
            }
            float inv = 1.f;
            if (MLSTM) { const float den = __shfl(nt[NDVT - 1][0], c); const float fl = fexp(-(sb[pb + q] + gq)); inv = 1.0f / fmaxf(fabsf(den), fl); }
            bf16* op = OUT + (size_t)(rowb + q) * D + 4 * g;
#pragma unroll
            for (int t = 0; t < 8; ++t) *(u32x2*)(op + 16 * t) = pack4c(nt[t] * inv);
            __syncthreads();
        }
#if !defined(DBG_NO3)
        const float decay = MLSTM ? fexp(b_end + m_c - m_new) : fexp(lg * 128.0f);
#pragma unroll
        for (int t = 0; t < NOWN; ++t) ct[t] = ct[t] * decay;
#pragma unroll 1
        for (int ks2 = 0; ks2 < 4; ++ks2) {
            f32x4 w0, w1;
#pragma unroll
            for (int e = 0; e < 4; ++e) { const int j0 = 32 * ks2 + 8 * g + e, j1 = j0 + 4;
                if (MLSTM) { w0[e] = fexp(sa[pb + j0] + b_end - m_new); w1[e] = fexp(sa[pb + j1] + b_end - m_new); }
                else { w0[e] = fexp(lg * (float)(fwd ? (127 - j0) : j0)); w1[e] = fexp(lg * (float)(fwd ? (127 - j1) : j1)); } }
            const bf16x8 kf = scale8v(ldg16(Kt + (size_t)(16 * dkt + c) * tp + 32 * ks2 + 8 * g), w0, w1);
#pragma unroll
            for (int t = 0; t < NOWN; ++t) {
                const bool ext = MLSTM && (t == 8);
                const bf16x8 vf = ext ? ones : ldg16(Vt + (size_t)(16 * (dv0 + t) + c) * tp + 32 * ks2 + 8 * g);
                ct[t] = mfma16(kf, vf, ct[t]);
            }
        }
#pragma unroll
        for (int t = 0; t < NOWN; ++t) *(LAS u32x2*)(CT + (16 * (dv0 + t) + c) * CTP + 16 * dkt + 4 * g) = pack4c(ct[t]);
        __syncthreads();
#endif
    }
}

constexpr int SCAN_UNITS = 128;
__device__ __forceinline__ void scan_phase(const Args& a, LAS unsigned char* lds, int G, int tid, int lane, int wave) {
#ifndef DBG_SCAN
#define DBG_SCAN 0
#endif
    for (int u = blockIdx.x; u < SCAN_UNITS; u += G) {
        const int uu = u & 63, b = uu >> 3, hd = (uu >> 1) & 3, dir = uu & 1;
        const bool zero = (DBG_SCAN == 1) || (DBG_SCAN == 2 && u >= 64) || (DBG_SCAN == 3 && u < 64);
        if (zero) { bf16* OUT = (bf16*)(a.ws + (dir == 0 ? WS_H : WS_HB)) + (u < 64 ? hd * 128 : 512 + hd * 128);
            for (int i = tid; i < T * 16; i += 512) { const int row = i >> 4, c8 = (i & 15) * 8; *(v4u*)(OUT + (size_t)(b * T + row) * D + c8) = (v4u){0u, 0u, 0u, 0u}; } }
        else if (u < 64) scan_chain<128, true>(a, lds, b, hd, dir, tid, lane, wave);
        else scan_chain<64, false>(a, lds, b, hd, dir, tid, lane, wave);
        __syncthreads();
    }
}

__device__ __forceinline__ void rec_merge_phase(const Args& a, int gw, int NGW, int lane) {
    unsigned char* ws = a.ws;
    bf16* HF = (bf16*)(ws + WS_H); const bf16* HB = (const bf16*)(ws + WS_HB); const bf16* MO = (const bf16*)(ws + WS_MO); const bf16* RG = (const bf16*)(ws + WS_RG);
    const int col = 16 * lane; const bool ism = lane < 32;
    for (int r = gw; r < ML; r += NGW) {
        const v4u f0 = *(const v4u*)(HF + (size_t)r * D + col), f1 = *(const v4u*)(HF + (size_t)r * D + col + 8), b0 = *(const v4u*)(HB + (size_t)r * D + col), b1 = *(const v4u*)(HB + (size_t)r * D + col + 8);
        const bf16* gp = ism ? MO + (size_t)r * 512 + col : RG + (size_t)r * 512 + (col - 512);
        const v4u g0 = *(const v4u*)gp, g1 = *(const v4u*)(gp + 8);
        float v[16], gt[16];
#pragma unroll
        for (int k = 0; k < 4; ++k) { v[2 * k] = bflo(f0[k]) + bflo(b0[k]); v[2 * k + 1] = bfhi(f0[k]) + bfhi(b0[k]); v[8 + 2 * k] = bflo(f1[k]) + bflo(b1[k]); v[8 + 2 * k + 1] = bfhi(f1[k]) + bfhi(b1[k]);
            gt[2 * k] = bflo(g0[k]); gt[2 * k + 1] = bfhi(g0[k]); gt[8 + 2 * k] = bflo(g1[k]); gt[8 + 2 * k + 1] = bfhi(g1[k]); }
        float s = 0.f;
#pragma unroll
        for (int k = 0; k < 16; ++k) s += v[k];
        s += __shfl_xor(s, 1); s += __shfl_xor(s, 2); s += __shfl_xor(s, 4);
        const float mean = s * (1.0f / 128.0f); float q = 0.f;
#pragma unroll
        for (int k = 0; k < 16; ++k) { v[k] -= mean; q += v[k] * v[k]; }
        q += __shfl_xor(q, 1); q += __shfl_xor(q, 2); q += __shfl_xor(q, 4);
        const float rstd = 1.0f / sqrtf(q * (1.0f / 128.0f) + 1e-5f);
        const float* gn = ism ? a.in[I_MNG] + col : a.in[I_RNG] + (col - 512);
        const float* bn = a.in[I_RNB] + (ism ? 0 : col - 512);
        float o[16];
#pragma unroll
        for (int k = 0; k < 16; ++k) { float y = v[k] * rstd * gn[k]; if (!ism) y += bn[k]; o[k] = y * gt[k]; }
        v4u w0, w1;
#pragma unroll
        for (int k = 0; k < 4; ++k) { w0[k] = cvtpk(o[2 * k], o[2 * k + 1]); w1[k] = cvtpk(o[8 + 2 * k], o[8 + 2 * k + 1]); }
        *(v4u*)(HF + (size_t)r * D + col) = w0; *(v4u*)(HF + (size_t)r * D + col + 8) = w1;
    }
}
typedef const __attribute__((address_space(4))) Args* kargp;
__device__ __forceinline__ Args phase_args() {
    kargp p = (kargp)__builtin_amdgcn_kernarg_segment_ptr(); asm volatile("" : "+s"(p));
    Args la;
#pragma unroll
    for (int i = 0; i < 22; ++i) la.in[i] = p->in[i];
    la.out = p->out; la.ws = p->ws; la.ph_lo = p->ph_lo; la.ph_hi = p->ph_hi; return la;
}
#ifndef PH_MASK
#define PH_MASK 0x7ff
#endif
#define EN(k) (((PH_MASK) >> (k)) & 1)
#define PH_LANE() int ptid = threadIdx.x; asm volatile("" : "+v"(ptid)); const int tid = ptid, lane = ptid & 63, wave = __builtin_amdgcn_readfirstlane(ptid >> 6); const int gw = vcu * NWAVES + wave; (void)tid; (void)lane; (void)gw

__global__ void __launch_bounds__(NWAVES * 64, 2) mk_fwd(Args a_unused) {
    extern __shared__ __attribute__((aligned(16))) unsigned char lds_raw[];
    LAS unsigned char* lds = (LAS unsigned char*)lds_raw;
    volatile LAS unsigned* MISC = (volatile LAS unsigned*)(lds + MISC_OFF);
    const int tid = threadIdx.x, lane = tid & 63, wave = __builtin_amdgcn_readfirstlane(tid >> 6);
    const int G = gridDim.x; int vcu; { const int bx = blockIdx.x; vcu = (G % 8 == 0) ? (bx % 8) * (G / 8) + bx / 8 : bx; }
    const int NGW = G * NWAVES;
    for (int u = tid; u < (LDS_BYTES - LDSCTL_OFF) / 4; u += NWAVES * 64) ((LAS unsigned*)(lds + LDSCTL_OFF))[u] = 0u;
    __syncthreads();
    int lo, hi; XcdBarrier bar;
    { const Args pa = phase_args(); PH_LANE(); lo = pa.ph_lo; hi = pa.ph_hi; gu32* ctl = (gu32*)(pa.ws + WS_CTL);
      bar.bar = (unsigned*)(ctl + CW_BAR); bar.x = 0; bar.st = nullptr;
      if (!MK_PER_PHASE) bar = xcd_barrier_post((unsigned*)(ctl + CW_BAR), MISC + 8); }
#define IN(k) (lo <= (k) && (k) < hi)
#define SEAM(k) do { if (IN(k) && IN((k) + 1)) { if (MK_PER_PHASE) { if (tid == 0) __hip_atomic_store((gu32*)bar.bar - CW_BAR + CW_TMO, 0xBADBA0u, RLX_AGENT); } else xcd_barrier(bar); } } while (0)
    int kD = D, kFF = FF; asm volatile("" : "+s"(kD), "+s"(kFF));

    if (EN(0) && IN(0)) { const Args pa = phase_args(); PH_LANE(); p0a_prologue(pa, lds, G, vcu, tid, lane, wave); } SEAM(0);
    if (EN(1) && IN(1)) { const Args pa = phase_args(); PH_LANE(); p0b_modulate(pa, gw, NGW, lane); } SEAM(1);

    for (int l = 0; l < 2; ++l) {
        const int pb = 2 + 11 * l;
        const int rows_post = (l == 0) ? M : ML;
#pragma unroll
        for (int j = 0; j < 2; ++j) {
            const int p0 = pb + (j == 0 ? 0 : 8);
            const int rows = (j == 0) ? M : rows_post;
            if (EN(2) && IN(p0)) {
                const Args pa = phase_args(); PH_LANE(); unsigned char* ws = pa.ws;
                pg8::Gemm g{(const bf16*)(ws + WS_H), (const bf16*)(ws + WS_WFI) + (size_t)(l * 2 + j) * N_FI * D, rows, N_FI, kD}; pg8::StaticOrder S; S.init(rows, N_FI, G, (int)blockIdx.x);
                EpiSwiglu E{(bf16*)(ws + WS_ACT)};
                pg8::gemm_phase<EpiSwiglu, pg8::StaticOrder, true, true>(lds, g, S, E);
            }
            SEAM(p0);
            if (EN(3) && IN(p0 + 1)) {
                const Args pa = phase_args(); PH_LANE(); unsigned char* ws = pa.ws;
                const int s = (j == 0) ? 0 : 2;
                pg8::Gemm g{(const bf16*)(ws + WS_ACT), (const bf16*)(ws + WS_WFO) + (size_t)(l * 2 + j) * D * FF, rows, D, kFF}; pg8::StaticOrder S; S.init(rows, D, G, (int)blockIdx.x);
                const bool first = (l == 0 && j == 0);
                float* XC = (float*)(ws + WS_XC);
                EpiResid E{first ? pa.in[I_X] : pa.out, first ? pa.in[I_CTX] : XC, pa.out, XC, (const float*)(ws + WS_MOD) + (size_t)l * 9 * 9216 + (s * 3 + 2) * 1024, 0.5f};
                pg8::gemm_phase<EpiResid, pg8::StaticOrder, true, true>(lds, g, S, E);
            }
            SEAM(p0 + 1);
            if (EN(4) && IN(p0 + 2)) {
                const Args pa = phase_args(); PH_LANE(); unsigned char* ws = pa.ws;
                const int s = (j == 0) ? 0 : 2;
                const float* MOD = (const float*)(ws + WS_MOD);
                const float* modn = nullptr;
                if (j == 0) modn = MOD + (size_t)l * 9 * 9216 + (1 * 3) * 1024; else if (l == 0) modn = MOD + (size_t)1 * 9 * 9216;
                ln_phase(pa.out, (float*)(ws + WS_XC), pa.in[I_LNG] + (l * 3 + s) * D, pa.in[I_LNB] + (l * 3 + s) * D, modn, (bf16*)(ws + WS_H), rows, gw, NGW, lane);
            }
            if (!(l == 1 && j == 1)) SEAM(p0 + 2);
            if (j == 0) {
                if (IN(pb + 3)) {
                    if (EN(5) && l == 0) {
                        const Args pa = phase_args(); PH_LANE(); unsigned char* ws = pa.ws;
                        pg8::Gemm g{(const bf16*)(ws + WS_H), (const bf16*)(ws + WS_WAI), M, N_AI, kD}; pg8::StaticOrder S; S.init(M, N_AI, G, (int)blockIdx.x);
                        EpiAttnIn E{ws};
                        pg8::gemm_phase<EpiAttnIn, pg8::StaticOrder, true, true>(lds, g, S, E);
                    }
                    if (EN(6) && l == 1) {
                        const Args pa = phase_args(); PH_LANE(); unsigned char* ws = pa.ws;
                        pg8::Gemm g{(const bf16*)(ws + WS_H), (const bf16*)(ws + WS_WRI), M, N_RI, kD}; pg8::StaticOrder S; S.init(M, N_RI, G, (int)blockIdx.x);
                        EpiRecIn E{ws, pa.in[I_MGB]};
                        pg8::gemm_phase<EpiRecIn, pg8::StaticOrder, true, true>(lds, g, S, E);
                    }
                }
                SEAM(pb + 3);
                if (IN(pb + 4)) {
                    if (EN(7) && l == 0) { const Args pa = phase_args(); PH_LANE(); attn_phase(pa, lds, G, vcu, lane, wave); }
                    if (EN(8) && l == 1) { const Args pa = phase_args(); PH_LANE(); scan_phase(pa, lds, G, tid, lane, wave); }
                }
                SEAM(pb + 4);
                if (EN(9) && IN(pb + 5)) { if (l == 1) { const Args pa = phase_args(); PH_LANE(); rec_merge_phase(pa, gw, NGW, lane); } }
                SEAM(pb + 5);
                if (EN(10) && IN(pb + 6)) {
                    const Args pa = phase_args(); PH_LANE(); unsigned char* ws = pa.ws;
                    pg8::Gemm g{(const bf16*)(ws + WS_H), (const bf16*)(ws + (l == 0 ? WS_WAO : WS_WRO)), rows_post, D, kD}; pg8::StaticOrder S; S.init(rows_post, D, G, (int)blockIdx.x);
                    float* XC = (float*)(ws + WS_XC);
                    EpiResid E{pa.out, XC, pa.out, XC, (const float*)(ws + WS_MOD) + (size_t)l * 9 * 9216 + (1 * 3 + 2) * 1024, 1.0f};
                    pg8::gemm_phase<EpiResid, pg8::StaticOrder, true, true>(lds, g, S, E);
                }
                SEAM(pb + 6);
                if (EN(4) && IN(pb + 7)) {
                    const Args pa = phase_args(); PH_LANE(); unsigned char* ws = pa.ws;
                    ln_phase(pa.out, (float*)(ws + WS_XC), pa.in[I_LNG] + (l * 3 + 1) * D, pa.in[I_LNB] + (l * 3 + 1) * D, (const float*)(ws + WS_MOD) + (size_t)l * 9 * 9216 + (2 * 3) * 1024, (bf16*)(ws + WS_H), rows_post, gw, NGW, lane);
                }
                SEAM(pb + 7);
            }
        }
    }
#undef IN
#undef SEAM
}

#ifdef DBG_DUMP
__global__ void dbg_dump(const unsigned short* A, const unsigned short* B, const unsigned short* C, size_t n, float* out) {
    const size_t i = (size_t)blockIdx.x * 256 + threadIdx.x;
    float v = 0.f;
    if (i < n) { if (A) v += __uint_as_float(((unsigned)A[i]) << 16); if (B) v += 2.0f * __uint_as_float(((unsigned)B[i]) << 16); if (C) v += 4.0f * __uint_as_float(((unsigned)C[i]) << 16); }
    out[i] = v;
}
#endif
extern "C" void kernel_launch(void* const* d_in, const int* in_sizes, int n_in, void* d_out, int out_size, void* d_ws, size_t ws_size, hipStream_t stream) {
    static int grid = 0;
    if (grid == 0) {
        if (n_in != 22 || in_sizes[0] != ML * D || out_size != ML * D || ws_size < WS_END) { fprintf(stderr, "kernel_launch: unexpected shapes (n_in %d, in0 %d, out %d, ws %zu)\n", n_in, n_in > 0 ? in_sizes[0] : -1, out_size, ws_size); grid = -1; return; }
        int dev = 0, cus = 0, per_cu = 0;
        if (hipGetDevice(&dev) != hipSuccess || hipDeviceGetAttribute(&cus, hipDeviceAttributeMultiprocessorCount, dev) != hipSuccess) { grid = -1; return; }
        if (hipFuncSetAttribute((const void*)mk_fwd, hipFuncAttributeMaxDynamicSharedMemorySize, LDS_BYTES) != hipSuccess) { fprintf(stderr, "kernel_launch: hipFuncSetAttribute failed\n"); grid = -1; return; }
        if (hipOccupancyMaxActiveBlocksPerMultiprocessor(&per_cu, (const void*)mk_fwd, NWAVES * 64, LDS_BYTES) != hipSuccess || per_cu < 1) fprintf(stderr, "kernel_launch: occupancy query reports %d\n", per_cu);
        (void)hipGetLastError();
        grid = cus;
    }
    if (grid < 0) return;
    if (hipMemsetAsync((char*)d_ws + WS_CTL, 0, CTL_ZERO_BYTES, stream) != hipSuccess) return;
    Args a{};
    for (int i = 0; i < 22; ++i) a.in[i] = (const float*)d_in[i];
    a.out = (float*)d_out; a.ws = (unsigned char*)d_ws;
#if MK_PER_PHASE
    for (int p = 0; p < MK_STOP; ++p) { a.ph_lo = p; a.ph_hi = p + 1; hipLaunchKernelGGL(mk_fwd, dim3(grid), dim3(NWAVES * 64), LDS_BYTES, stream, a); }
#ifdef DBG_DUMP
    hipLaunchKernelGGL(dbg_dump, dim3(ML * D / 256), dim3(256), 0, stream, DBG_A ? (const unsigned short*)((char*)d_ws + DBG_A) : nullptr, DBG_B ? (const unsigned short*)((char*)d_ws + DBG_B) : nullptr, DBG_C ? (const unsigned short*)((char*)d_ws + DBG_C) : nullptr, (size_t)DBG_N, (float*)d_out);
#endif
#else
    a.ph_lo = 0; a.ph_hi = MK_STOP;
    hipLaunchKernelGGL(mk_fwd, dim3(grid), dim3(NWAVES * 64), LDS_BYTES, stream, a);
#endif
}
```

```cpp
#include <hip/hip_runtime.h>
#include <cstdio>
#include <cstdint>
namespace pg8 {
#define PG8_LAS __attribute__((address_space(3)))
typedef unsigned short bf16_t;
typedef short bf16x8 __attribute__((ext_vector_type(8)));
typedef float f32x4 __attribute__((ext_vector_type(4)));
typedef unsigned u32x4 __attribute__((ext_vector_type(4)));
constexpr int BM = 256, BK = 64, HALF = 128, HTB = HALF * BK * 2  , STAGE_BYTES = 8 * HTB, NXCD = 8, WGM = 8;

__host__ __device__ __forceinline__ int lds_byte(int r, int c) { const int st = (r >> 4) * 2 + (c >> 5), rr = r & 15, cc = c & 31, ob = rr * 64 + cc * 2; return st * 1024 + (ob ^ (((ob >> 9) & 1) << 5)); }
__host__ __device__ __forceinline__ void stage_rc(int b, int& R, int& C) { const int st = b / 1024, sb = b % 1024, swz = sb ^ (((sb >> 9) & 1) << 5); R = (st >> 1) * 16 + swz / 64; C = (st & 1) * 32 + (swz % 64) / 2; }
__host__ __device__ __forceinline__ int perm32(int rho) { const int n = rho >> 4, i = rho & 15; return 8 * (i >> 2) + 4 * n + (i & 3); }

struct Unit { int pm, pn; };
struct Gemm { const bf16_t* A; const bf16_t* Bt; int M, N, K; };

struct StaticOrder {
    int nM, nN, nwg, G, c;
    __host__ __device__ void init(int M, int N, int G_, int c_) { nM = M / BM; nN = N / BM; nwg = nM * nN; G = G_; c = c_; }
    __host__ __device__ bool next(int i, Unit& u) const {
        const long L = (long)i * G + c; if (L >= nwg) return false;
        int wgid = (int)L; { const int q = nwg / NXCD, r = nwg % NXCD, xcd = wgid % NXCD, off = wgid / NXCD; wgid = (xcd < r ? xcd * (q + 1) : r * (q + 1) + (xcd - r) * q) + off; }
        const int nig = WGM * nN, gid = wgid / nig, fm = gid * WGM, gsz = (nM - fm) < WGM ? (nM - fm) : WGM;
        u.pm = fm + ((wgid % nig) % gsz); u.pn = (wgid % nig) / gsz; return true;
    }
    __device__ __forceinline__ void a_ready(const Unit&) const {}
    __device__ __forceinline__ void done(const Unit&) const {}
};

__device__ __forceinline__ unsigned cvt_pk_bf16(float lo, float hi) { unsigned r; asm volatile("v_cvt_pk_bf16_f32 %0, %1, %2" : "=v"(r) : "v"(lo), "v"(hi)); return r; }
template <class Epi, class Sched, bool ALIGN_EPI = false, bool SP2 = false>
__device__ __forceinline__ void gemm_phase(PG8_LAS unsigned char* lds, const Gemm g, const Sched& S, const Epi& E) {
    int tid_l = threadIdx.x; asm volatile("" : "+v"(tid_l));
    const int tid = tid_l, wid = __builtin_amdgcn_readfirstlane(tid >> 6), lane = tid & 63, wr = wid >> 2, wc = wid & 3, fr = lane & 15, fq = lane >> 4;
    const int K = g.K, nt = K / BK;
    unsigned voffA[2], voffB[2];
#pragma unroll
    for (int i = 0; i < 2; ++i) { int R, C; stage_rc(tid * 16 + i * 8192, R, C); const int Rb = Epi::PERM ? ((R & ~31) + perm32(R & 31)) : R;
        voffA[i] = (unsigned)(R * K + C) * 2u; voffB[i] = (unsigned)(Rb * K + C) * 2u; }
    const size_t kstep = (size_t)(BK * 2);
    const size_t hstep = (size_t)HALF * K * 2;
    const size_t tstep = 2 * hstep;
    const unsigned ldsw = (unsigned)wid * 1024u;
    const int aoff = lds_byte(wr * 64 + fr, fq * 8), boff = lds_byte(wc * 32 + fr, fq * 8);
#define PG8_SA(b, h) (((b) * 2 + (h)) * HTB)
#define PG8_SB(b, h) ((4 + (b) * 2 + (h)) * HTB)
#define PG8_STAGE(bufoff, gbase, voff) do { _Pragma("unroll") for (int _i = 0; _i < 2; ++_i) \
        __builtin_amdgcn_global_load_lds((const unsigned*)((const char*)(gbase) + (voff)[_i]), (PG8_LAS unsigned*)(lds + (bufoff) + ldsw + _i * 8192), 16, 0, 0); } while (0)
#define PG8_LDA(dst, b, h) do { _Pragma("unroll") for (int m = 0; m < 4; ++m) _Pragma("unroll") for (int k = 0; k < 2; ++k) dst[m][k] = *(const PG8_LAS bf16x8*)(lds + PG8_SA(b, h) + aoff + m * 2048 + k * 1024); } while (0)
#define PG8_LDB(dst, b, h) do { _Pragma("unroll") for (int n = 0; n < 2; ++n) _Pragma("unroll") for (int k = 0; k < 2; ++k) dst[n][k] = *(const PG8_LAS bf16x8*)(lds + PG8_SB(b, h) + boff + n * 2048 + k * 1024); } while (0)
#define PG8_MMA(ai, bj, At, Bt) do { __builtin_amdgcn_s_setprio(1); _Pragma("unroll") for (int m = 0; m < 4; ++m) _Pragma("unroll") for (int n = 0; n < 2; ++n) _Pragma("unroll") for (int k = 0; k < 2; ++k) \
        acc[ai][bj][m][n] = __builtin_amdgcn_mfma_f32_16x16x32_bf16(Bt[n][k], At[m][k], acc[ai][bj][m][n], 0, 0, 0); __builtin_amdgcn_s_setprio(0); } while (0)
#define PG8_WAIT_V(n) asm volatile("s_waitcnt vmcnt(" #n ")" ::: "memory")
#define PG8_WAIT_L(n) asm volatile("s_waitcnt lgkmcnt(" #n ")" ::: "memory")
#define PG8_BAR __builtin_amdgcn_s_barrier()
#define PG8_SCHED __builtin_amdgcn_sched_barrier(0)
    Unit cur, nxt; int ui = 0;
    if (!S.next(0, cur)) return;
    f32x4 acc[2][2][4][2];
#pragma unroll
    for (int a = 0; a < 2; ++a)
#pragma unroll
        for (int b = 0; b < 2; ++b)
#pragma unroll
            for (int m = 0; m < 4; ++m)
#pragma unroll
                for (int n = 0; n < 2; ++n) acc[a][b][m][n] = (f32x4){0.f, 0.f, 0.f, 0.f};
    bf16x8 At[4][2], B0[2][2], B1[2][2];
    const char* cA = (const char*)g.A + (size_t)cur.pm * tstep; const char* cB = (const char*)g.Bt + (size_t)cur.pn * tstep;
    S.a_ready(cur);
    if constexpr (SP2) {
        PG8_STAGE(PG8_SB(0, 0), cB, voffB); PG8_STAGE(PG8_SB(0, 1), cB + hstep, voffB); PG8_STAGE(PG8_SA(0, 0), cA, voffA); PG8_STAGE(PG8_SA(0, 1), cA + hstep, voffA);
        if (wr == 1) PG8_BAR;
        PG8_WAIT_V(2); PG8_BAR;
        PG8_STAGE(PG8_SB(1, 0), cB + kstep, voffB); PG8_STAGE(PG8_SA(1, 0), cA + kstep, voffA); PG8_STAGE(PG8_SB(1, 1), cB + hstep + kstep, voffB);
        PG8_WAIT_V(6); PG8_BAR;
    } else {
        PG8_STAGE(PG8_SB(0, 0), cB, voffB); PG8_STAGE(PG8_SA(0, 0), cA, voffA); PG8_STAGE(PG8_SB(0, 1), cB + hstep, voffB); PG8_STAGE(PG8_SA(0, 1), cA + hstep, voffA);
        if (wr == 1) PG8_BAR;
        PG8_WAIT_V(4); PG8_BAR;
        PG8_STAGE(PG8_SB(1, 0), cB + kstep, voffB); PG8_STAGE(PG8_SA(1, 0), cA + kstep, voffA); PG8_STAGE(PG8_SB(1, 1), cB + hstep + kstep, voffB);
        PG8_WAIT_V(6); PG8_BAR;
    }
    for (;;) {
        const bool has_next = S.next(ui + 1, nxt);
        const char* nA = has_next ? (const char*)g.A + (size_t)nxt.pm * tstep : cA; const char* nB = has_next ? (const char*)g.Bt + (size_t)nxt.pn * tstep : cB;
        for (int t = 0; t < nt; t += 2) {
            const bool last = (t == nt - 2);
            const char* a1 = cA + (size_t)(t + 1) * kstep;
            const char* a2 = last ? nA : cA + (size_t)(t + 2) * kstep; const char* b2 = last ? nB : cB + (size_t)(t + 2) * kstep;
            const char* a3 = a2 + kstep; const char* b3 = b2 + kstep;
            if (last && has_next) S.a_ready(nxt);
            if constexpr (SP2) {
            PG8_LDB(B0, 0, 0); PG8_LDB(B1, 0, 1); PG8_SCHED; PG8_LDA(At, 0, 0); PG8_STAGE(PG8_SA(1, 1), a1 + hstep, voffA);
            PG8_WAIT_V(8); PG8_WAIT_L(0); PG8_BAR; PG8_MMA(0, 0, At, B0); PG8_MMA(0, 1, At, B1); PG8_BAR; PG8_SCHED;
            PG8_LDA(At, 0, 1); PG8_STAGE(PG8_SB(0, 0), b2, voffB); PG8_STAGE(PG8_SB(0, 1), b2 + hstep, voffB); PG8_STAGE(PG8_SA(0, 0), a2, voffA);
            PG8_WAIT_V(8); PG8_WAIT_L(0); PG8_BAR; PG8_MMA(1, 0, At, B0); PG8_MMA(1, 1, At, B1); PG8_BAR; PG8_SCHED;
            PG8_LDB(B0, 1, 0); PG8_LDB(B1, 1, 1); PG8_SCHED; PG8_LDA(At, 1, 0); PG8_STAGE(PG8_SA(0, 1), a2 + hstep, voffA);
            PG8_WAIT_V(8); PG8_WAIT_L(0); PG8_BAR; PG8_MMA(0, 0, At, B0); PG8_MMA(0, 1, At, B1); PG8_BAR; PG8_SCHED;
            PG8_LDA(At, 1, 1); PG8_STAGE(PG8_SB(1, 0), b3, voffB); PG8_STAGE(PG8_SB(1, 1), b3 + hstep, voffB); PG8_STAGE(PG8_SA(1, 0), a3, voffA);
            PG8_WAIT_V(8); PG8_WAIT_L(0); PG8_BAR; PG8_MMA(1, 0, At, B0); PG8_MMA(1, 1, At, B1); PG8_BAR; PG8_SCHED;
            } else {
            PG8_LDB(B0, 0, 0); PG8_SCHED; PG8_LDA(At, 0, 0); PG8_STAGE(PG8_SA(1, 1), a1 + hstep, voffA);
            PG8_WAIT_L(8); PG8_BAR; PG8_WAIT_L(0); PG8_MMA(0, 0, At, B0); PG8_BAR; PG8_SCHED;
            PG8_LDB(B1, 0, 1); PG8_STAGE(PG8_SB(0, 0), b2, voffB);
            PG8_BAR; PG8_WAIT_L(0); PG8_MMA(0, 1, At, B1); PG8_BAR;
            PG8_LDA(At, 0, 1); PG8_STAGE(PG8_SA(0, 0), a2, voffA);
            PG8_BAR; PG8_WAIT_L(0); PG8_MMA(1, 0, At, B0); PG8_BAR; PG8_SCHED;
            PG8_STAGE(PG8_SB(0, 1), b2 + hstep, voffB);
            PG8_WAIT_V(6); PG8_BAR; PG8_MMA(1, 1, At, B1); PG8_BAR;
            PG8_LDB(B0, 1, 0); PG8_SCHED; PG8_LDA(At, 1, 0); PG8_STAGE(PG8_SA(0, 1), a2 + hstep, voffA);
            PG8_WAIT_L(8); PG8_BAR; PG8_WAIT_L(0); PG8_MMA(0, 0, At, B0); PG8_BAR; PG8_SCHED;
            PG8_LDB(B1, 1, 1); PG8_STAGE(PG8_SB(1, 0), b3, voffB);
            PG8_BAR; PG8_WAIT_L(0); PG8_MMA(0, 1, At, B1); PG8_BAR;
            PG8_LDA(At, 1, 1); PG8_STAGE(PG8_SA(1, 0), a3, voffA);
            PG8_BAR; PG8_WAIT_L(0); PG8_MMA(1, 0, At, B0); PG8_BAR; PG8_SCHED;
            PG8_STAGE(PG8_SB(1, 1), b3 + hstep, voffB);
            PG8_WAIT_V(6); PG8_BAR; PG8_MMA(1, 1, At, B1); PG8_BAR;
            }
        }
        if constexpr (ALIGN_EPI) { if (wr == 0) PG8_BAR; }
        if constexpr (!Epi::AFTER_DRAIN) { E(acc, cur, wr, wc, fr, fq); S.done(cur); }
        if (!has_next) break;
#pragma unroll
        for (int a = 0; a < 2; ++a)
#pragma unroll
            for (int b = 0; b < 2; ++b)
#pragma unroll
                for (int m = 0; m < 4; ++m)
#pragma unroll
                    for (int n = 0; n < 2; ++n) acc[a][b][m][n] = (f32x4){0.f, 0.f, 0.f, 0.f};
        cur = nxt; cA = nA; cB = nB; ++ui;
        if constexpr (ALIGN_EPI) { if (wr == 1) PG8_BAR; }
    }
    PG8_WAIT_V(0);
    if constexpr (!ALIGN_EPI) { if (wr == 0) PG8_BAR; }
    PG8_BAR;
    if constexpr (Epi::AFTER_DRAIN) { E.fused(acc, cur, wr, wc, fr, fq, lds, wid, lane); S.done(cur); }
#undef PG8_SA
#undef PG8_SB
#undef PG8_STAGE
#undef PG8_LDA
#undef PG8_LDB
#undef PG8_MMA
#undef PG8_WAIT_V
#undef PG8_WAIT_L
#undef PG8_BAR
#undef PG8_SCHED
}
}
#define GAS __attribute__((address_space(1)))
#define LAS __attribute__((address_space(3)))
typedef unsigned short bf16;
typedef unsigned v4u __attribute__((ext_vector_type(4)));
typedef float f32x4 __attribute__((ext_vector_type(4)));
typedef short bf16x8 __attribute__((ext_vector_type(8)));
typedef GAS unsigned gu32;
typedef GAS unsigned long long gu64;
#define RLX_AGENT __ATOMIC_RELAXED, __HIP_MEMORY_SCOPE_AGENT
#define LDS_WAIT() asm volatile("s_waitcnt lgkmcnt(0)" ::: "memory")
#define VM_WAIT() asm volatile("s_waitcnt vmcnt(0)" ::: "memory")
__device__ __forceinline__ unsigned long long rt() { return __builtin_amdgcn_s_memrealtime(); }
__device__ __forceinline__ unsigned f2bf(float f) { unsigned u = __builtin_bit_cast(unsigned, f); return (u + 0x7fffu + ((u >> 16) & 1u)) >> 16; }
__device__ __forceinline__ unsigned pk2(float lo, float hi) { return f2bf(lo) | (f2bf(hi) << 16); }

#define XB_TMO      128
#define XB_XCNT(j)  (256  + 64 * (j))
#define XB_XSUB(j)  (1280 + 64 * (j))
#define XB_XGEN(j)  (2304 + 64 * (j))
#define XB_TOP      3328
#define XB_TOPGEN   3392
#define XCD_BAR_WORDS 3456
#define XB_SPIN_CAP (1u << 18)

__device__ __forceinline__ unsigned xb_ld(unsigned* p)              { return __hip_atomic_load(p, __ATOMIC_RELAXED, __HIP_MEMORY_SCOPE_AGENT); }
__device__ __forceinline__ unsigned xb_add(unsigned* p, unsigned v) { return __hip_atomic_fetch_add(p, v, __ATOMIC_RELAXED, __HIP_MEMORY_SCOPE_AGENT); }
__device__ __forceinline__ unsigned xb_xcc_id() { return (unsigned)__builtin_amdgcn_s_getreg((3 << 11) | 20) & 0xFu; }
#define XB_SPIN(cond, bar) do { unsigned _sp = 0; while (cond) { __builtin_amdgcn_s_sleep(1); \
    if ((++_sp & 255u) == 0u) { if (xb_ld(&(bar)[XB_TMO])) break; if (_sp > XB_SPIN_CAP) { atomicAdd(&(bar)[XB_TMO], 1u); break; } } } } while (0)

struct XcdBarrier {
    unsigned* bar; unsigned x;
    volatile LAS unsigned* st;
};

__device__ __forceinline__ XcdBarrier xcd_barrier_post(unsigned* bar, volatile LAS unsigned* st) {
    XcdBarrier b; b.bar = bar; b.x = xb_xcc_id(); b.st = st;
    if (threadIdx.x == 0) (void)xb_add(&bar[XB_XCNT(b.x)], 1u);
    return b;
}
__device__ __forceinline__ void xcd_barrier_complete(unsigned* bar, unsigned x, unsigned& nloc, unsigned& nx) {
    const unsigned G = gridDim.x * gridDim.y * gridDim.z;
    unsigned sum, cnt, mine, sp = 0u;
    for (;;) {
        sum = 0u; cnt = 0u; mine = 0u;
#pragma unroll
        for (unsigned j = 0; j < 16; ++j) { const unsigned c = xb_ld(&bar[XB_XCNT(j)]); sum += c; cnt += (c > 0u) ? 1u : 0u; mine = (j == x) ? c : mine; }
        if (sum == G) break;
        __builtin_amdgcn_s_sleep(1);
        if ((++sp & 255u) == 0u) { if (xb_ld(&bar[XB_TMO])) break; if (sp > XB_SPIN_CAP) { atomicAdd(&bar[XB_TMO], 1u); break; } }
    }
    nloc = mine > 0u ? mine : 1u; nx = cnt > 0u ? cnt : 1u;
}

__device__ __forceinline__ void xcd_barrier(const XcdBarrier& b) {
    asm volatile("s_waitcnt vmcnt(0)" ::: "memory");
    __syncthreads();
    if (threadIdx.x == 0) {
        unsigned* bar = b.bar;
        __builtin_amdgcn_s_waitcnt(0);
        unsigned nloc = b.st[0], nx = b.st[1];
        if (nloc == 0u) { xcd_barrier_complete(bar, b.x, nloc, nx); b.st[0] = nloc; b.st[1] = nx; }
        const unsigned old = xb_add(&bar[XB_XSUB(b.x)], 1u);
        const unsigned gen = old / nloc;
        if (old + 1u == (gen + 1u) * nloc) {
            __builtin_amdgcn_fence(__ATOMIC_RELEASE, "agent");
            asm volatile("s_waitcnt vmcnt(0)" ::: "memory");
            const unsigned og = xb_add(&bar[XB_TOP], 1u);
            const unsigned tg = og / nx;
            if (og + 1u == (tg + 1u) * nx) xb_add(&bar[XB_TOPGEN], 1u);
            else XB_SPIN(xb_ld(&bar[XB_TOPGEN]) == tg, bar);
            __builtin_amdgcn_fence(__ATOMIC_ACQUIRE, "agent");
            xb_add(&bar[XB_XGEN(b.x)], 1u);
            asm volatile("s_waitcnt vmcnt(0)" ::: "memory");
        } else {
            XB_SPIN(xb_ld(&bar[XB_XGEN(b.x)]) == gen, bar);
            __builtin_amdgcn_fence(__ATOMIC_ACQUIRE, "agent");
            asm volatile("s_waitcnt vmcnt(0)" ::: "memory");
        }
    }
    __syncthreads();
}
constexpr int NB = 8, T = 4096, D = 1024, TC = 256, FF = 2816;
constexpr int ML = NB * T, MC = NB * TC, M = ML + MC;
constexpr int N_FI = 2 * FF, N_AI = 2304, N_RI = 3840, N_RI_SRC = 3600;
constexpr float ALPHA = 1.41421356237309515f;
constexpr float LOG2E = 1.4426950408889634f;
constexpr float QSCALE = 0.125f * LOG2E;
constexpr int NWAVES = 8;
#ifndef MK_PER_PHASE
#define MK_PER_PHASE 0
#endif
constexpr int N_PHASES = 2 + 2 * 11;
#ifndef MK_STOP
#define MK_STOP N_PHASES
#endif

constexpr size_t MiB = 1u << 20;
constexpr size_t WS_CTL = 0, CTL_ZERO_BYTES = 1 * MiB;
constexpr size_t WS_MOD = 1 * MiB;
constexpr size_t WS_ROPE = WS_MOD + 704 * 1024;
constexpr size_t WS_LAM = WS_ROPE + 8192;
constexpr size_t WS_WFI = 2 * MiB;
constexpr size_t WS_WFO = 46 * MiB;
constexpr size_t WS_WAI = 68 * MiB;
constexpr size_t WS_WAO = WS_WAI + 4608 * 1024;
constexpr size_t WS_WRI = WS_WAO + 2 * MiB;
constexpr size_t WS_WRO = WS_WRI + 7680 * 1024;
constexpr size_t WS_XC = 84 * MiB;
constexpr size_t WS_H = 92 * MiB;
constexpr size_t WS_HB = 160 * MiB;
constexpr size_t WS_BIG = 228 * MiB;
constexpr size_t WS_END = 500 * MiB;
static_assert(WS_WRO + 2 * MiB <= WS_XC, "weights");
constexpr size_t WS_ACT = WS_BIG;
constexpr size_t WS_AQ = WS_BIG, WS_AK = WS_BIG + 34 * MiB, WS_BQ = WS_BIG + 68 * MiB, WS_BK = WS_BIG + 102 * MiB;
constexpr size_t WS_VTA_L = WS_BIG + 111 * MiB, WS_VTA_C = WS_BIG + 143 * MiB, WS_VTB_L = WS_BIG + 145 * MiB, WS_VTB_C = WS_BIG + 153 * MiB;
constexpr size_t WS_MQ = WS_BIG, WS_MK = WS_BIG + 34 * MiB, WS_MO = WS_BIG + 68 * MiB, WS_RQ = WS_BIG + 102 * MiB, WS_RK = WS_BIG + 119 * MiB, WS_RG = WS_BIG + 136 * MiB;
constexpr size_t WS_MKT_L = WS_BIG + 170 * MiB, WS_MKT_C = WS_BIG + 202 * MiB, WS_MVT_L = WS_BIG + 204 * MiB, WS_MVT_C = WS_BIG + 236 * MiB;
constexpr size_t WS_RVT_L = WS_BIG + 238 * MiB, WS_RVT_C = WS_BIG + 270 * MiB;
constexpr size_t WS_RKT_L = 2 * MiB, WS_RKT_C = 18 * MiB, WS_GATE = 20 * MiB;
static_assert(WS_RVT_C + 2 * MiB <= WS_END && WS_GATE + (size_t)M * 16 * 4 <= 24 * MiB, "ws map");

constexpr int CW_TMO = 0, CW_CODE = 1, CW_BAR = 4096;
constexpr int RING_BYTES = 131072;
constexpr int LDSCTL_OFF = RING_BYTES, MISC_OFF = LDSCTL_OFF + 320;
constexpr int LDS_BYTES = 147456;
typedef float f32x16 __attribute__((ext_vector_type(16)));
typedef short bf16x4 __attribute__((ext_vector_type(4)));
typedef unsigned u32x2 __attribute__((ext_vector_type(2)));
__device__ __forceinline__ float wave_sum(float v) {
#pragma unroll
    for (int o = 1; o < 64; o <<= 1) v += __shfl_xor(v, o);
    return v;
}
__device__ __forceinline__ float bf2f(unsigned short b) { return __uint_as_float(((unsigned)b) << 16); }
__device__ __forceinline__ float bflo(unsigned w) { return __uint_as_float(w << 16); }
__device__ __forceinline__ float bfhi(unsigned w) { return __uint_as_float(w & 0xffff0000u); }
__device__ __forceinline__ float fexp2(float x) { return __builtin_amdgcn_exp2f(x); }
__device__ __forceinline__ float fexp(float x) { return __builtin_amdgcn_exp2f(x * LOG2E); }
__device__ __forceinline__ float frcp(float x) { return __builtin_amdgcn_rcpf(x); }
__device__ __forceinline__ float silu_f(float x) { return x * frcp(1.0f + fexp(-x)); }
__device__ __forceinline__ float sigmoid_f(float x) { return frcp(1.0f + fexp(-x)); }
__device__ __forceinline__ u32x2 pack4(f32x4 v) { u32x2 w; w.x = pk2(v[0], v[1]); w.y = pk2(v[2], v[3]); return w; }
__device__ __forceinline__ f32x4 mfma16(bf16x8 a, bf16x8 b, f32x4 c) { return __builtin_amdgcn_mfma_f32_16x16x32_bf16(a, b, c, 0, 0, 0); }
__device__ __forceinline__ f32x16 mfma32(bf16x8 a, bf16x8 b, f32x16 c) { return __builtin_amdgcn_mfma_f32_32x32x16_bf16(a, b, c, 0, 0, 0); }
__device__ __forceinline__ int crow(int i, int h) { return (i & 3) + 8 * (i >> 2) + 4 * h; }
__device__ __forceinline__ bf16x8 ldg16(const bf16* p) { return *(const bf16x8*)p; }
__device__ __forceinline__ bf16x8 scale8u(bf16x8 v, float s) {
    const v4u u = __builtin_bit_cast(v4u, v); v4u o;
    o.x = pk2(bflo(u.x) * s, bfhi(u.x) * s); o.y = pk2(bflo(u.y) * s, bfhi(u.y) * s); o.z = pk2(bflo(u.z) * s, bfhi(u.z) * s); o.w = pk2(bflo(u.w) * s, bfhi(u.w) * s);
    return __builtin_bit_cast(bf16x8, o);
}
__device__ __forceinline__ bf16x8 scale8v(bf16x8 v, f32x4 s0, f32x4 s1) {
    const v4u u = __builtin_bit_cast(v4u, v); v4u o;
    o.x = pk2(bflo(u.x) * s0[0], bfhi(u.x) * s0[1]); o.y = pk2(bflo(u.y) * s0[2], bfhi(u.y) * s0[3]); o.z = pk2(bflo(u.z) * s1[0], bfhi(u.z) * s1[1]); o.w = pk2(bflo(u.w) * s1[2], bfhi(u.w) * s1[3]);
    return __builtin_bit_cast(bf16x8, o);
}
typedef __bf16 bf16x2_t __attribute__((ext_vector_type(2)));
typedef float f32x2_t __attribute__((ext_vector_type(2)));
__device__ __forceinline__ unsigned cvtpk(float lo, float hi) { const f32x2_t v = {lo, hi}; const bf16x2_t b = __builtin_convertvector(v, bf16x2_t); return __builtin_bit_cast(unsigned, b); }
__device__ __forceinline__ u32x2 pack4c(f32x4 v) { u32x2 w; w.x = cvtpk(v[0], v[1]); w.y = cvtpk(v[2], v[3]); return w; }

struct EpiSwiglu {
    static constexpr bool PERM = true, AFTER_DRAIN = false;
    bf16* ACT;
    __device__ __forceinline__ void operator()(const f32x4 (&acc)[2][2][4][2], const pg8::Unit& u, int wr, int wc, int fr, int fq) const {
        const int row0 = u.pm * 256 + wr * 64 + fr, col0 = u.pn * 128 + wc * 32 + 8 * fq;
#pragma unroll
        for (int ai = 0; ai < 2; ++ai)
#pragma unroll
            for (int m = 0; m < 4; ++m) {
                bf16* rowp = ACT + (size_t)(row0 + ai * 128 + m * 16) * FF + col0;
                const f32x4 g0 = acc[ai][0][m][0], g1 = acc[ai][0][m][1], u0 = acc[ai][1][m][0], u1 = acc[ai][1][m][1];
                f32x4 a0, a1;
#pragma unroll
                for (int e = 0; e < 4; ++e) { a0[e] = silu_f(g0[e]) * u0[e]; a1[e] = silu_f(g1[e]) * u1[e]; }
                v4u w; w.x = cvtpk(a0[0], a0[1]); w.y = cvtpk(a0[2], a0[3]); w.z = cvtpk(a1[0], a1[1]); w.w = cvtpk(a1[2], a1[3]);
                *(v4u*)rowp = w;
            }
    }
};

struct EpiResid {
    static constexpr bool PERM = false, AFTER_DRAIN = false;
    const float* base_l; const float* base_c; float* out_l; float* out_c; const float* gate; float wgt;
    __device__ __forceinline__ void operator()(const f32x4 (&acc)[2][2][4][2], const pg8::Unit& u, int wr, int wc, int fr, int fq) const {
        const int r0 = u.pm * 256; const bool lat = r0 < ML; const int mr = lat ? (r0 >> 12) : 8;
        const float* bp = lat ? base_l + (size_t)r0 * D : base_c + (size_t)(r0 - ML) * D;
        float* op = lat ? out_l + (size_t)r0 * D : out_c + (size_t)(r0 - ML) * D;
        const float* gp = gate + (size_t)mr * 9216;
        const int col0 = u.pn * 256 + wc * 32 + 4 * fq;
        f32x4 gv[2][2];
#pragma unroll
        for (int bj = 0; bj < 2; ++bj)
#pragma unroll
            for (int n = 0; n < 2; ++n) gv[bj][n] = *(const f32x4*)(gp + col0 + bj * 128 + n * 16) * wgt;
#pragma unroll
        for (int ai = 0; ai < 2; ++ai)
#pragma unroll
            for (int m = 0; m < 4; ++m) {
                const size_t ro = (size_t)(ai * 128 + wr * 64 + m * 16 + fr) * D;
#pragma unroll
                for (int bj = 0; bj < 2; ++bj)
#pragma unroll
                    for (int n = 0; n < 2; ++n) { const int c = col0 + bj * 128 + n * 16; const f32x4 x = *(const f32x4*)(bp + ro + c);
                        *(f32x4*)(op + ro + c) = x * ALPHA + gv[bj][n] * acc[ai][bj][m][n]; }
            }
    }
};

__device__ __forceinline__ void epi_store_T(const f32x4 (&acc)[2][2][4][2], int bj, bf16* tb, int TL, int trow, int t0, float sc, int wr, int wc, int fr, int fq) {
#ifdef NO_T
    return;
#endif
    bf16* p0 = tb + (size_t)(trow + bj * 128 + wc * 32 + 4 * fq) * TL + t0 + wr * 64 + fr;
#pragma unroll
    for (int ai = 0; ai < 2; ++ai)
#pragma unroll
        for (int m = 0; m < 4; ++m) {
#pragma unroll
            for (int n = 0; n < 2; ++n) { const u32x2 w = pack4c(acc[ai][bj][m][n] * sc);
                bf16* p = p0 + (size_t)(16 * n) * TL + ai * 128 + m * 16;
                p[0] = (bf16)(w.x & 0xffffu); p[(size_t)TL] = (bf16)(w.x >> 16); p[(size_t)2 * TL] = (bf16)(w.y & 0xffffu); p[(size_t)3 * TL] = (bf16)(w.y >> 16); }
            asm volatile("" ::: "memory");
        }
}
template <int ACT>
__device__ __forceinline__ void epi_store_P(const f32x4 (&acc)[2][2][4][2], int bj, bf16* dst0, int pitch, int cb, float sc, int wr, int wc, int fr, int fq) {
    bf16* p0 = dst0 + (size_t)(wr * 64 + fr) * pitch + cb + bj * 128 + wc * 32 + 4 * fq;
#pragma unroll
    for (int ai = 0; ai < 2; ++ai)
#pragma unroll
        for (int m = 0; m < 4; ++m) {
#pragma unroll
            for (int n = 0; n < 2; ++n) { f32x4 v = acc[ai][bj][m][n] * sc;
                if (ACT == 1) {
#pragma unroll
                    for (int e = 0; e < 4; ++e) v[e] = sigmoid_f(v[e]); }
                if (ACT == 2) {
#pragma unroll
                    for (int e = 0; e < 4; ++e) v[e] = silu_f(v[e]); }
                *(u32x2*)(p0 + (size_t)(ai * 128 + m * 16) * pitch + 16 * n) = pack4c(v); }
            asm volatile("" ::: "memory");
        }
}
__device__ __forceinline__ void epi_store_R(const f32x4 (&acc)[2][2][4][2], int bj, bf16* dst0, int pitch, int cb, float sc, bool rope, int t0, const float* cosT, const float* sinT, int wr, int wc, int fr, int fq) {
#ifdef NO_R
    return;
#endif
    bf16* p0 = dst0 + (size_t)(wr * 64 + fr) * pitch + cb + bj * 128 + wc * 32 + 4 * fq;
#pragma unroll
    for (int ai = 0; ai < 2; ++ai)
#pragma unroll
        for (int m = 0; m < 4; ++m) { const int rr = ai * 128 + wr * 64 + m * 16 + fr; const int t = t0 + rr;
            const f32x4 x1 = acc[ai][bj][m][0], x2 = acc[ai][bj][m][1]; f32x4 o1 = x1, o2 = x2;
            if (rope) { const int pos = (wc & 1) ? (t & 63) : (t >> 6);
                const f32x4 c4 = *(const f32x4*)(cosT + pos * 16 + 4 * fq), s4 = *(const f32x4*)(sinT + pos * 16 + 4 * fq);
                o1 = x1 * c4 - x2 * s4; o2 = x2 * c4 + x1 * s4; }
            bf16* p = p0 + (size_t)(ai * 128 + m * 16) * pitch;
            *(u32x2*)p = pack4c(o1 * sc); *(u32x2*)(p + 16) = pack4c(o2 * sc);
            asm volatile("" ::: "memory"); }
}

struct EpiAttnIn {
    static constexpr bool PERM = false, AFTER_DRAIN = false;
    unsigned char* ws;
    __device__ __forceinline__ void operator()(const f32x4 (&acc)[2][2][4][2], const pg8::Unit& u, int wr, int wc, int fr, int fq) const {
        asm volatile("" : "+v"(fr), "+v"(fq));
        const int r0 = u.pm * 256; const bool lat = r0 < ML; const int b = lat ? (r0 >> 12) : ((r0 - ML) >> 8); const int t0 = lat ? (r0 & 4095) : 0;
        const int pn = u.pn; const int TL = lat ? T : TC;
        const float* cosT = (const float*)(ws + WS_ROPE); const float* sinT = cosT + 1024;
        if (pn == 4 || pn == 5) {
            bf16* vb = (bf16*)(ws + (lat ? WS_VTA_L : WS_VTA_C)) + (size_t)b * 512 * TL;
            epi_store_T(acc, 0, vb, TL, (pn - 4) * 256, t0, 1.f, wr, wc, fr, fq); epi_store_T(acc, 1, vb, TL, (pn - 4) * 256, t0, 1.f, wr, wc, fr, fq);
        } else if (pn == 8) {
            epi_store_R(acc, 0, (bf16*)(ws + WS_BK) + (size_t)r0 * 128, 128, 0, 1.f, lat, t0, cosT, sinT, wr, wc, fr, fq);
            epi_store_T(acc, 1, (bf16*)(ws + (lat ? WS_VTB_L : WS_VTB_C)) + (size_t)b * 128 * TL, TL, -128, t0, 1.f, wr, wc, fr, fq);
        } else {
            const size_t off = (pn < 2) ? WS_AQ : (pn < 4) ? WS_AK : WS_BQ;
            bf16* dst = (bf16*)(ws + off); const int cb = (pn & 1) * 256; const float sc = (pn < 2 || pn >= 6) ? QSCALE : 1.f;
            epi_store_R(acc, 0, dst + (size_t)r0 * 512, 512, cb, sc, lat, t0, cosT, sinT, wr, wc, fr, fq); epi_store_R(acc, 1, dst + (size_t)r0 * 512, 512, cb, sc, lat, t0, cosT, sinT, wr, wc, fr, fq);
        }
    }
};

struct EpiRecIn {
    static constexpr bool PERM = false, AFTER_DRAIN = false;
    unsigned char* ws; const float* gate_b;
    __device__ __forceinline__ void operator()(const f32x4 (&acc)[2][2][4][2], const pg8::Unit& u, int wr, int wc, int fr, int fq) const {
        asm volatile("" : "+v"(fr), "+v"(fq));
        const int r0 = u.pm * 256; const bool lat = r0 < ML; const int b = lat ? (r0 >> 12) : ((r0 - ML) >> 8); const int t0 = lat ? (r0 & 4095) : 0;
        const int pn = u.pn; const int TL = lat ? T : TC;
        if (pn == 14) {
            if (wc == 0) {
                const f32x4 gb = *(const f32x4*)(gate_b + 4 * fq);
                const bool isf = (fq & 1) != 0;
#pragma unroll
                for (int ai = 0; ai < 2; ++ai)
#pragma unroll
                    for (int m = 0; m < 4; ++m) { const int rr = ai * 128 + wr * 64 + m * 16 + fr; f32x4 v = acc[ai][0][m][0] + gb;
                        if (isf) {
#pragma unroll
                            for (int e = 0; e < 4; ++e) { const float x = v[e]; v[e] = fminf(x, 0.f) - log1pf(__expf(-fabsf(x))); } }
                        *(f32x4*)((float*)(ws + WS_GATE) + (size_t)(r0 + rr) * 16 + 4 * fq) = v; }
            }
        } else if (pn < 2) { bf16* d0 = (bf16*)(ws + WS_MQ) + (size_t)r0 * 512; epi_store_P<0>(acc, 0, d0, 512, pn * 256, 1.f, wr, wc, fr, fq); epi_store_P<0>(acc, 1, d0, 512, pn * 256, 1.f, wr, wc, fr, fq); }
        else if (pn < 4) { const float sc = 0.08838834764831845f; bf16* d0 = (bf16*)(ws + WS_MK) + (size_t)r0 * 512; bf16* tb = (bf16*)(ws + (lat ? WS_MKT_L : WS_MKT_C)) + (size_t)b * 512 * TL;
#pragma unroll
            for (int bj = 0; bj < 2; ++bj) { epi_store_P<0>(acc, bj, d0, 512, (pn - 2) * 256, sc, wr, wc, fr, fq); epi_store_T(acc, bj, tb, TL, (pn - 2) * 256, t0, sc, wr, wc, fr, fq); } }
        else if (pn < 6) { bf16* tb = (bf16*)(ws + (lat ? WS_MVT_L : WS_MVT_C)) + (size_t)b * 512 * TL; epi_store_T(acc, 0, tb, TL, (pn - 4) * 256, t0, 1.f, wr, wc, fr, fq); epi_store_T(acc, 1, tb, TL, (pn - 4) * 256, t0, 1.f, wr, wc, fr, fq); }
        else if (pn < 8) { bf16* d0 = (bf16*)(ws + WS_MO) + (size_t)r0 * 512; epi_store_P<1>(acc, 0, d0, 512, (pn - 6) * 256, 1.f, wr, wc, fr, fq); epi_store_P<1>(acc, 1, d0, 512, (pn - 6) * 256, 1.f, wr, wc, fr, fq); }
        else if (pn == 8) { bf16* d0 = (bf16*)(ws + WS_RQ) + (size_t)r0 * 256; epi_store_P<0>(acc, 0, d0, 256, 0, 1.f, wr, wc, fr, fq); epi_store_P<0>(acc, 1, d0, 256, 0, 1.f, wr, wc, fr, fq); }
        else if (pn == 9) { bf16* d0 = (bf16*)(ws + WS_RK) + (size_t)r0 * 256; bf16* tb = (bf16*)(ws + (lat ? WS_RKT_L : WS_RKT_C)) + (size_t)b * 256 * TL;
#pragma unroll
            for (int bj = 0; bj < 2; ++bj) { epi_store_P<0>(acc, bj, d0, 256, 0, 0.125f, wr, wc, fr, fq); epi_store_T(acc, bj, tb, TL, 0, t0, 0.125f, wr, wc, fr, fq); } }
        else if (pn < 12) { bf16* tb = (bf16*)(ws + (lat ? WS_RVT_L : WS_RVT_C)) + (size_t)b * 512 * TL; epi_store_T(acc, 0, tb, TL, (pn - 10) * 256, t0, 1.f, wr, wc, fr, fq); epi_store_T(acc, 1, tb, TL, (pn - 10) * 256, t0, 1.f, wr, wc, fr, fq); }
        else { bf16* d0 = (bf16*)(ws + WS_RG) + (size_t)r0 * 512; epi_store_P<2>(acc, 0, d0, 512, (pn - 12) * 256, 1.f, wr, wc, fr, fq); epi_store_P<2>(acc, 1, d0, 512, (pn - 12) * 256, 1.f, wr, wc, fr, fq); }
    }
};
struct Args { const float* in[22]; float* out; unsigned char* ws; int ph_lo, ph_hi; };
enum { I_X = 0, I_C, I_CTX, I_CCTX, I_ADAW, I_ADAB, I_LNG, I_LNB, I_FWI, I_FWO, I_AWI, I_AWO, I_DLAM, I_DNG, I_SINK, I_RWI, I_RWO, I_MGB, I_MNG, I_RDL, I_RNG, I_RNB };

__device__ __forceinline__ void tr_item(const float* W, int ldw, int k0, int c0, int nvalid, bf16* WT, int K, int r0, LAS float* scr, int lane) {
    const int col = lane & 31;
#pragma unroll 8
    for (int i = 0; i < 32; ++i) { const int kk = 2 * i + (lane >> 5); scr[kk * 33 + col] = (col < nvalid) ? W[(size_t)(k0 + kk) * ldw + c0 + col] : 0.f; }
    LDS_WAIT(); asm volatile("" ::: "memory");
    const int c = lane & 7;
#pragma unroll
    for (int j = 0; j < 4; ++j) { const int n = (lane >> 3) + 8 * j; const LAS float* s = scr + (8 * c) * 33 + n;
        v4u o; o.x = pk2(s[0 * 33], s[1 * 33]); o.y = pk2(s[2 * 33], s[3 * 33]); o.z = pk2(s[4 * 33], s[5 * 33]); o.w = pk2(s[6 * 33], s[7 * 33]);
        *(v4u*)(WT + (size_t)(r0 + n) * K + k0 + 8 * c) = o; }
    LDS_WAIT(); asm volatile("" ::: "memory");
}

__device__ __forceinline__ void p0a_prologue(const Args& a, LAS unsigned char* lds, int G, int vcu, int tid, int lane, int wave) {
    unsigned char* ws = a.ws;
    LAS float* scr = (LAS float*)(lds + wave * 8448);
    const int gw = vcu * NWAVES + wave, NGW = G * NWAVES;
    constexpr int I_FI = 16 * 176, I_FO = 44 * 32, I_AI = 16 * 72, I_AO = 16 * 32, I_RI = 16 * 120, I_RO = 16 * 32;
    constexpr int NITEMS = 4 * I_FI + 4 * I_FO + I_AI + I_AO + I_RI + I_RO;
    for (int it = gw; it < NITEMS; it += NGW) {
        int r = it;
        if (r < 4 * I_FI) { const int mi = r / I_FI; r -= mi * I_FI; const int kb = r / 176, nb = r % 176, pn = nb >> 3, q = nb & 7;
            const int c0 = (q < 4) ? (128 * pn + 32 * q) : (FF + 128 * pn + 32 * (q - 4));
            tr_item(a.in[I_FWI] + (size_t)mi * D * N_FI, N_FI, 64 * kb, c0, 32, (bf16*)(ws + WS_WFI) + (size_t)mi * N_FI * D, D, 32 * nb, scr, lane); continue; }
        r -= 4 * I_FI;
        if (r < 4 * I_FO) { const int mi = r / I_FO; r -= mi * I_FO; const int kb = r / 32, nb = r % 32;
            tr_item(a.in[I_FWO] + (size_t)mi * FF * D, D, 64 * kb, 32 * nb, 32, (bf16*)(ws + WS_WFO) + (size_t)mi * D * FF, FF, 32 * nb, scr, lane); continue; }
        r -= 4 * I_FO;
        if (r < I_AI) { const int kb = r / 72, nb = r % 72; tr_item(a.in[I_AWI], N_AI, 64 * kb, 32 * nb, 32, (bf16*)(ws + WS_WAI), D, 32 * nb, scr, lane); continue; }
        r -= I_AI;
        if (r < I_AO) { const int kb = r / 32, nb = r % 32; tr_item(a.in[I_AWO], D, 64 * kb, 32 * nb, 32, (bf16*)(ws + WS_WAO), D, 32 * nb, scr, lane); continue; }
        r -= I_AO;
        if (r < I_RI) { const int kb = r / 120, nb = r % 120, n0 = 32 * nb; int c0, nv;
            if (n0 < 2048) { c0 = n0; nv = 32; } else if (n0 < 3584) { c0 = n0 + 16; nv = 32; } else if (n0 == 3584) { c0 = 2048; nv = 16; } else { c0 = 0; nv = 0; }
            tr_item(a.in[I_RWI], N_RI_SRC, 64 * kb, c0, nv, (bf16*)(ws + WS_WRI), D, n0, scr, lane); continue; }
        r -= I_RI;
        { const int kb = r / 32, nb = r % 32; tr_item(a.in[I_RWO], D, 64 * kb, 32 * nb, 32, (bf16*)(ws + WS_WRO), D, 32 * nb, scr, lane); }
    }
    __syncthreads();
    {
        LAS float* sc = (LAS float*)lds;
        LAS float* red = (LAS float*)(lds + 36864);
        float* MOD = (float*)(ws + WS_MOD);
        if (blockIdx.x < 288) {
            for (int idx = tid; idx < 9216; idx += 512) { const int r = idx >> 10, k = idx & 1023; const float cv = (r < 8) ? a.in[I_C][r * 1024 + k] : a.in[I_CCTX][k]; sc[idx] = silu_f(cv); }
        }
        __syncthreads();
        for (int u = blockIdx.x; u < 288; u += G) {
            const int l = u / 144, ng = u % 144, n = 64 * ng + lane;
            const float* W = a.in[I_ADAW] + (size_t)l * D * 9216 + n;
            float acc[9];
#pragma unroll
            for (int r = 0; r < 9; ++r) acc[r] = 0.f;
#pragma unroll 8
            for (int kk = 0; kk < 128; ++kk) { const int k = wave * 128 + kk; const float wv = W[(size_t)k * 9216];
#pragma unroll
                for (int r = 0; r < 9; ++r) acc[r] += sc[r * 1024 + k] * wv; }
#pragma unroll
            for (int r = 0; r < 9; ++r) red[(wave * 9 + r) * 64 + lane] = acc[r];
            __syncthreads();
            for (int idx = tid; idx < 576; idx += 512) { const int r = idx >> 6, ln = idx & 63; float s = 0.f;
#pragma unroll
                for (int w = 0; w < 8; ++w) s += red[(w * 9 + r) * 64 + ln];
                MOD[(size_t)(l * 9 + r) * 9216 + 64 * ng + ln] = s + a.in[I_ADAB][l * 9216 + 64 * ng + ln]; }
            __syncthreads();
        }
    }
    if (blockIdx.x == 0) {
        float* cosT = (float*)(ws + WS_ROPE); float* sinT = cosT + 1024;
        for (int idx = tid; idx < 1024; idx += 512) { const int pos = idx >> 4, f = idx & 15; const float inv = powf(10000.0f, -(float)f / 16.0f); const float ang = (float)pos * inv;
            cosT[idx] = cosf(ang); sinT[idx] = sinf(ang); }
        if (wave == 0) { const float* dl = a.in[I_DLAM]; const float s1 = wave_sum(dl[lane] * dl[64 + lane]), s2 = wave_sum(dl[128 + lane] * dl[192 + lane]);
            if (lane == 0) *(float*)(ws + WS_LAM) = expf(s1) - expf(s2) + 0.2f; }
    }
}

__device__ __forceinline__ void p0b_modulate(const Args& a, int gw, int NGW, int lane) {
    const float* MOD = (const float*)(a.ws + WS_MOD); bf16* H = (bf16*)(a.ws + WS_H);
    for (int r = gw; r < M; r += NGW) {
        const float* xr = (r < ML) ? a.in[I_X] + (size_t)r * D : a.in[I_CTX] + (size_t)(r - ML) * D;
        const float* mp = MOD + (size_t)((r < ML) ? (r >> 12) : 8) * 9216;
#pragma unroll
        for (int j = 0; j < 4; ++j) { const int c = 4 * (lane + 64 * j); const f32x4 x = *(const f32x4*)(xr + c), sh = *(const f32x4*)(mp + c), sc = *(const f32x4*)(mp + 1024 + c);
            *(u32x2*)(H + (size_t)r * D + c) = pack4c(x * (sc + 1.0f) + sh); }
    }
}

__device__ __forceinline__ void ln_phase(float* out_l, float* out_c, const float* g, const float* bt, const float* modn, bf16* H, int nrows, int gw, int NGW, int lane) {
    f32x4 g4[4], b4[4];
#pragma unroll
    for (int j = 0; j < 4; ++j) { g4[j] = *(const f32x4*)(g + 4 * (lane + 64 * j)); b4[j] = *(const f32x4*)(bt + 4 * (lane + 64 * j)); }
    for (int r = gw; r < nrows; r += NGW) {
        float* zr = (r < ML) ? out_l + (size_t)r * D : out_c + (size_t)(r - ML) * D;
        f32x4 v[4]; float s = 0.f;
#pragma unroll
        for (int j = 0; j < 4; ++j) { v[j] = *(const f32x4*)(zr + 4 * (lane + 64 * j)); s += (v[j][0] + v[j][1]) + (v[j][2] + v[j][3]); }
        const float mean = wave_sum(s) * (1.f / D); float s2 = 0.f;
#pragma unroll
        for (int j = 0; j < 4; ++j) { v[j] = v[j] - mean; s2 += (v[j][0] * v[j][0] + v[j][1] * v[j][1]) + (v[j][2] * v[j][2] + v[j][3] * v[j][3]); }
        const float rstd = 1.0f / sqrtf(wave_sum(s2) * (1.f / D) + 1e-5f);
        const float* mp = modn ? modn + (size_t)((r < ML) ? (r >> 12) : 8) * 9216 : nullptr;
#pragma unroll
        for (int j = 0; j < 4; ++j) { const int c = 4 * (lane + 64 * j); const f32x4 y = v[j] * rstd * g4[j] + b4[j]; *(f32x4*)(zr + c) = y;
            if (mp) { const f32x4 sh = *(const f32x4*)(mp + c), sc = *(const f32x4*)(mp + 1024 + c); *(u32x2*)(H + (size_t)r * D + c) = pack4c(y * (sc + 1.0f) + sh); } }
    }
}
template <int NDV> struct AttW { f32x16 o[NDV]; float m, l; };

template <int NDV, bool MASK>
__device__ __forceinline__ void attn_block(AttW<NDV>& S, const bf16x8 (&qf)[4], const bf16* Kp, int kpitch, const bf16* Vp, int vpitch, int r, int h, int qpos, int kpos0) {
    f32x16 st;
#pragma unroll
    for (int i = 0; i < 16; ++i) st[i] = 0.f;
#pragma unroll
    for (int s = 0; s < 4; ++s) { const bf16x8 kf = ldg16(Kp + (size_t)r * kpitch + 16 * s + 8 * h); st = mfma32(kf, qf[s], st); }
    if (MASK) {
#pragma unroll
        for (int i = 0; i < 16; ++i) { const int dlt = qpos - (kpos0 + crow(i, h)); if (dlt > 128 || dlt < -128) st[i] = -INFINITY; }
    }
    float mx = st[0];
#pragma unroll
    for (int i = 1; i < 16; ++i) mx = fmaxf(mx, st[i]);
    mx = fmaxf(mx, __shfl_xor(mx, 32));
    const float mn = fmaxf(S.m, mx), alpha = fexp2(S.m - mn);
    S.m = mn;
    float ps = 0.f;
#pragma unroll
    for (int i = 0; i < 16; ++i) { st[i] = fexp2(st[i] - mn); ps += st[i]; }
    S.l = S.l * alpha + ps;
#pragma unroll
    for (int d = 0; d < NDV; ++d) S.o[d] = S.o[d] * alpha;
    bf16x8 pf[2];
#pragma unroll
    for (int s2 = 0; s2 < 2; ++s2) { v4u w; w.x = cvtpk(st[8 * s2 + 0], st[8 * s2 + 1]); w.y = cvtpk(st[8 * s2 + 2], st[8 * s2 + 3]); w.z = cvtpk(st[8 * s2 + 4], st[8 * s2 + 5]); w.w = cvtpk(st[8 * s2 + 6], st[8 * s2 + 7]);
        pf[s2] = __builtin_bit_cast(bf16x8, w); }
#pragma unroll
    for (int s2 = 0; s2 < 2; ++s2)
#pragma unroll
        for (int d = 0; d < NDV; ++d) { const bf16* vp = Vp + (size_t)(32 * d + r) * vpitch + 16 * s2 + 4 * h;
            const u32x2 lo = *(const u32x2*)vp, hi = *(const u32x2*)(vp + 8); v4u w; w.x = lo.x; w.y = lo.y; w.z = hi.x; w.w = hi.y;
            S.o[d] = mfma32(__builtin_bit_cast(bf16x8, w), pf[s2], S.o[d]); }
}

__device__ __forceinline__ void load_q(bf16x8 (&qf)[4], const bf16* Qp, int pitch, int r, int h) {
#pragma unroll
    for (int s = 0; s < 4; ++s) qf[s] = ldg16(Qp + (size_t)r * pitch + 16 * s + 8 * h);
}

constexpr int ATT_UNITS = 2176;
__device__ __forceinline__ void attn_phase(const Args& a, LAS unsigned char* lds, int G, int vcu, int lane, int wave) {
    unsigned char* ws = a.ws;
    const bf16* AQ = (const bf16*)(ws + WS_AQ); const bf16* AK = (const bf16*)(ws + WS_AK); const bf16* BQ = (const bf16*)(ws + WS_BQ); const bf16* BK = (const bf16*)(ws + WS_BK);
    const bf16* VTA_L = (const bf16*)(ws + WS_VTA_L); const bf16* VTA_C = (const bf16*)(ws + WS_VTA_C); const bf16* VTB_L = (const bf16*)(ws + WS_VTB_L); const bf16* VTB_C = (const bf16*)(ws + WS_VTB_C);
    bf16* O = (bf16*)(ws + WS_H);
    const int r = lane & 31, h = lane >> 5;
    LAS float* X = (LAS float*)lds;
    for (int u = vcu; u < ATT_UNITS; u += G) {
        const bool isdiff = (u < 1024) || (u >= 2048 && u < 2112);
        if (isdiff) {
            const bool lat = u < 1024; const int uu = lat ? u : u - 2048;
            const int bh = lat ? (uu >> 5) : (uu >> 1), qb = lat ? (uu & 31) : (uu & 1), b = bh >> 2, hd = bh & 3;
            const int sub = wave & 1, qs = wave >> 1;
            const int qrow0 = (lat ? b * T : ML + b * TC) + qb * 128 + qs * 32;
            bf16x8 qf[4]; load_q(qf, AQ + (size_t)qrow0 * 512 + hd * 128 + sub * 64, 512, r, h);
            AttW<4> S;
#pragma unroll
            for (int d = 0; d < 4; ++d)
#pragma unroll
                for (int i = 0; i < 16; ++i) S.o[d][i] = 0.f;
            S.m = -1e30f; S.l = 0.f;
            if (lat) {
                const bf16* Kb = AK + (size_t)(b * T) * 512 + hd * 128 + sub * 64; const bf16* Vb = VTA_L + (size_t)(b * 4 + hd) * 128 * T;
                for (int kb = 0; kb < T; kb += 32) attn_block<4, false>(S, qf, Kb + (size_t)kb * 512, 512, Vb + kb, T, r, h, 0, 0);
            }
            { const bf16* Kb = AK + (size_t)(ML + b * TC) * 512 + hd * 128 + sub * 64; const bf16* Vb = VTA_C + (size_t)(b * 4 + hd) * 128 * TC;
                for (int kb = 0; kb < TC; kb += 32) attn_block<4, false>(S, qf, Kb + (size_t)kb * 512, 512, Vb + kb, TC, r, h, 0, 0); }
            const float lt = S.l + __shfl_xor(S.l, 32); const float inv = 1.0f / lt;
            if (sub == 1) { const float lam = *(const float*)(ws + WS_LAM); const float f = inv * lam;
#pragma unroll
                for (int d = 0; d < 4; ++d)
#pragma unroll
                    for (int i = 0; i < 16; ++i) X[(qs * 128 + 32 * d + crow(i, h)) * 32 + r] = S.o[d][i] * f; }
            __syncthreads();
            if (sub == 0) { float ss = 0.f;
#pragma unroll
                for (int d = 0; d < 4; ++d)
#pragma unroll
                    for (int i = 0; i < 16; ++i) { const float v = S.o[d][i] * inv - X[(qs * 128 + 32 * d + crow(i, h)) * 32 + r]; S.o[d][i] = v; ss += v * v; }
                ss += __shfl_xor(ss, 32);
                const float rs = 0.8f / sqrtf(ss * (1.0f / 128.0f) + 1e-5f);
                const float* gn = a.in[I_DNG];
                bf16* op = O + (size_t)(qrow0 + r) * D + hd * 128;
#pragma unroll
                for (int d = 0; d < 4; ++d)
#pragma unroll
                    for (int k4 = 0; k4 < 4; ++k4) { const int dv = 32 * d + 8 * k4 + 4 * h; const f32x4 g4 = *(const f32x4*)(gn + dv);
                        f32x4 v; v[0] = S.o[d][4 * k4] * rs * g4[0]; v[1] = S.o[d][4 * k4 + 1] * rs * g4[1]; v[2] = S.o[d][4 * k4 + 2] * rs * g4[2]; v[3] = S.o[d][4 * k4 + 3] * rs * g4[3];
                        *(u32x2*)(op + dv) = pack4c(v); }
            }
            __syncthreads();
        } else {
            const bool lat = u < 2048; const int uu = lat ? u - 1024 : u - 2112;
            const int bk = lat ? (uu >> 6) : (uu >> 2), qb = lat ? (uu & 63) : (uu & 3), b = bk >> 1, kvh = bk & 1;
            const int g4i = wave >> 1, qs = wave & 1, hd = kvh * 4 + g4i;
            const int t0 = qb * 64 + qs * 32;
            const int qrow0 = (lat ? b * T : ML + b * TC) + t0;
            bf16x8 qf[4]; load_q(qf, BQ + (size_t)qrow0 * 512 + hd * 64, 512, r, h);
            AttW<2> S;
#pragma unroll
            for (int d = 0; d < 2; ++d)
#pragma unroll
                for (int i = 0; i < 16; ++i) S.o[d][i] = 0.f;
            S.m = a.in[I_SINK][hd] * LOG2E; S.l = (h == 0) ? 1.0f : 0.0f;
            if (lat) {
                const int lo = (qb * 64 - 128) < 0 ? 0 : (qb * 64 - 128), hi = (qb * 64 + 192) > T ? T : (qb * 64 + 192);
                const bf16* Kb = BK + (size_t)(b * T) * 128 + kvh * 64; const bf16* Vb = VTB_L + (size_t)(b * 2 + kvh) * 64 * T;
                for (int kb = lo; kb < hi; kb += 32) attn_block<2, true>(S, qf, Kb + (size_t)kb * 128, 128, Vb + kb, T, r, h, t0 + r, kb);
            }
            { const bf16* Kb = BK + (size_t)(ML + b * TC) * 128 + kvh * 64; const bf16* Vb = VTB_C + (size_t)(b * 2 + kvh) * 64 * TC;
                for (int kb = 0; kb < TC; kb += 32) attn_block<2, false>(S, qf, Kb + (size_t)kb * 128, 128, Vb + kb, TC, r, h, 0, 0); }
            const float lt = S.l + __shfl_xor(S.l, 32); const float inv = 1.0f / lt;
            bf16* op = O + (size_t)(qrow0 + r) * D + 512 + hd * 64;
#pragma unroll
            for (int d = 0; d < 2; ++d)
#pragma unroll
                for (int k4 = 0; k4 < 4; ++k4) { const int dv = 32 * d + 8 * k4 + 4 * h;
                    f32x4 v; v[0] = S.o[d][4 * k4] * inv; v[1] = S.o[d][4 * k4 + 1] * inv; v[2] = S.o[d][4 * k4 + 2] * inv; v[3] = S.o[d][4 * k4 + 3] * inv;
                    *(u32x2*)(op + dv) = pack4c(v); }
        }
    }
}
constexpr int SC_CT = 0;
constexpr int SC_S = 39168;
constexpr int SC_SA = SC_S + 8 * 4352;
constexpr int SC_SB = SC_SA + 4352 * 4;
constexpr int SC_SG = SC_SB + 4352 * 4;
constexpr int SC_CH = SC_SG + 4352 * 4;
static_assert(SC_CH + 4 * 128 <= RING_BYTES, "scan LDS");

template <int DK, bool MLSTM>
__device__ __forceinline__ void scan_chain(const Args& a, LAS unsigned char* lds, int b, int hd, int dir, int tid, int lane, int wave) {
    unsigned char* ws = a.ws;
    constexpr int KS = DK / 32, CTP = DK + 8, NDVT = MLSTM ? 9 : 8, NOWN = MLSTM ? 9 : 4;
    const int c = lane & 15, g = lane >> 4;
    const bf16* Qr = MLSTM ? (const bf16*)(ws + WS_MQ) + hd * 128 : (const bf16*)(ws + WS_RQ) + hd * 64;
    const bf16* Kr = MLSTM ? (const bf16*)(ws + WS_MK) + hd * 128 : (const bf16*)(ws + WS_RK) + hd * 64;
    constexpr int RP = MLSTM ? 512 : 256;
    const bf16* KtL = MLSTM ? (const bf16*)(ws + WS_MKT_L) + (size_t)(b * 4 + hd) * 128 * T : (const bf16*)(ws + WS_RKT_L) + (size_t)(b * 4 + hd) * 64 * T;
    const bf16* KtC = MLSTM ? (const bf16*)(ws + WS_MKT_C) + (size_t)(b * 4 + hd) * 128 * TC : (const bf16*)(ws + WS_RKT_C) + (size_t)(b * 4 + hd) * 64 * TC;
    const bf16* VtL = MLSTM ? (const bf16*)(ws + WS_MVT_L) + (size_t)(b * 4 + hd) * 128 * T : (const bf16*)(ws + WS_RVT_L) + (size_t)(b * 4 + hd) * 128 * T;
    const bf16* VtC = MLSTM ? (const bf16*)(ws + WS_MVT_C) + (size_t)(b * 4 + hd) * 128 * TC : (const bf16*)(ws + WS_RVT_C) + (size_t)(b * 4 + hd) * 128 * TC;
    bf16* OUT = (bf16*)(ws + (dir == 0 ? WS_H : WS_HB)) + (MLSTM ? hd * 128 : 512 + hd * 128);
    LAS bf16* CT = (LAS bf16*)(lds + SC_CT);
    LAS bf16* Sw = (LAS bf16*)(lds + SC_S + wave * 4352);
    LAS float* sa = (LAS float*)(lds + SC_SA); LAS float* sb = (LAS float*)(lds + SC_SB); LAS float* sg = (LAS float*)(lds + SC_SG);
    LAS float* mch = (LAS float*)(lds + SC_CH); LAS float* bend = mch + 36; LAS float* gend = bend + 34;
    const bool fwd = dir == 0;
    for (int i = tid; i < 144 * CTP / 2; i += 512) ((LAS unsigned*)CT)[i] = 0u;
    float lg = 0.f;
    if (MLSTM) {
        const float* GATE = (const float*)(ws + WS_GATE);
        for (int ci = wave; ci < 34; ci += 8) {
            const int rowb = (ci < 2) ? (ML + b * TC + ci * 128) : (b * T + (ci - 2) * 128), pb = ci * 128;
            const int u0 = 2 * lane, u1 = 2 * lane + 1, i0 = fwd ? u0 : 127 - u0, i1 = fwd ? u1 : 127 - u1;
            const float f0 = GATE[(size_t)(rowb + i0) * 16 + dir * 8 + 4 + hd], f1 = GATE[(size_t)(rowb + i1) * 16 + dir * 8 + 4 + hd];
            const float p0 = GATE[(size_t)(rowb + i0) * 16 + dir * 8 + hd], p1 = GATE[(size_t)(rowb + i1) * 16 + dir * 8 + hd];
            float s = f0 + f1;
#pragma unroll
            for (int o = 1; o < 64; o <<= 1) { const float t = __shfl_up(s, o); if (lane >= o) s += t; }
            const float b1 = s, b0 = s - f1, a0 = p0 - b0, a1 = p1 - b1;
            float pm = fmaxf(a0, a1);
#pragma unroll
            for (int o = 1; o < 64; o <<= 1) { const float t = __shfl_up(pm, o); if (lane >= o) pm = fmaxf(pm, t); }
            float ex = __shfl_up(pm, 1); if (lane == 0) ex = -INFINITY;
            const float g0 = fmaxf(ex, a0), g1 = pm;
            sa[pb + i0] = a0; sa[pb + i1] = a1; sb[pb + i0] = b0; sb[pb + i1] = b1; sg[pb + i0] = g0; sg[pb + i1] = g1;
            if (lane == 63) { bend[ci] = b1; gend[ci] = g1; }
        }
        __syncthreads();
        if (tid == 0) { float m = 0.f;
            for (int s = 0; s < 34; ++s) { const int ci = fwd ? s : (s < 2 ? 1 - s : 35 - s); mch[s] = m; m = bend[ci] + fmaxf(m, gend[ci]); }
            mch[34] = m; }
    } else {
        const float x = a.in[I_RDL][dir * 4 + hd]; lg = fminf(x, 0.f) - log1pf(__expf(-fabsf(x)));
    }
    __syncthreads();
    const int dkt = MLSTM ? wave : (wave & 3), dv0 = MLSTM ? 0 : 4 * (wave >> 2);
    f32x4 ct[NOWN];
#pragma unroll
    for (int t = 0; t < NOWN; ++t) ct[t] = (f32x4){0.f, 0.f, 0.f, 0.f};
    bf16x8 ones; { const short o1 = (c == 0) ? (short)0x3F80 : (short)0; ones = (bf16x8){o1, o1, o1, o1, o1, o1, o1, o1}; }

    for (int s = 0; s < 34; ++s) {
        const int ci = fwd ? s : (s < 2 ? 1 - s : 35 - s);
        const bool isctx = ci < 2;
        const int rowb = isctx ? (ML + b * TC + ci * 128) : (b * T + (ci - 2) * 128);
        const int pb = ci * 128;
        const int tp = isctx ? TC : T;
        const bf16* Kt = isctx ? KtC + ci * 128 : KtL + (ci - 2) * 128;
        const bf16* Vt = isctx ? VtC + ci * 128 : VtL + (ci - 2) * 128;
        float m_c = 0.f, m_new = 0.f, b_end = 0.f;
        if (MLSTM) { m_c = mch[s]; m_new = mch[s + 1]; b_end = bend[ci]; }
        if (!isctx) {
            const int q = 16 * wave + c;
            bf16x8 qf[KS];
#pragma unroll
            for (int ks = 0; ks < KS; ++ks) qf[ks] = ldg16(Qr + (size_t)(rowb + q) * RP + 32 * ks + 8 * g);
            float gq = 0.f; if (MLSTM) gq = fmaxf(m_c, sg[pb + q]);
#pragma unroll 1
            for (int jt = 0; jt < 8; ++jt) {
                f32x4 acc = (f32x4){0.f, 0.f, 0.f, 0.f};
#pragma unroll
                for (int ks = 0; ks < KS; ++ks) acc = mfma16(ldg16(Kr + (size_t)(rowb + 16 * jt + c) * RP + 32 * ks + 8 * g), qf[ks], acc);
                f32x4 v;
#pragma unroll
                for (int e = 0; e < 4; ++e) { const int j = 16 * jt + 4 * g + e; const bool ok = fwd ? (j <= q) : (j >= q);
                    float dm;
                    if (MLSTM) dm = fexp(sa[pb + j] - gq); else dm = fexp(lg * (float)(fwd ? (q - j) : (j - q)));
                    v[e] = ok ? acc[e] * dm : 0.f; }
                *(LAS u32x2*)(Sw + c * 136 + 16 * jt + 4 * g) = pack4c(v);
            }
            LDS_WAIT();
            f32x4 nt[NDVT];
#pragma unroll
            for (int t = 0; t < NDVT; ++t) nt[t] = (f32x4){0.f, 0.f, 0.f, 0.f};
#pragma unroll 1
            for (int ks2 = 0; ks2 < 4; ++ks2) {
                const bf16x8 sf = *(const LAS bf16x8*)(Sw + c * 136 + 32 * ks2 + 8 * g);
#pragma unroll
                for (int t = 0; t < 8; ++t) nt[t] = mfma16(ldg16(Vt + (size_t)(16 * t + c) * tp + 32 * ks2 + 8 * g), sf, nt[t]);
                if (MLSTM) nt[NDVT - 1] = mfma16(ones, sf, nt[NDVT - 1]);
            }
            const float wi = MLSTM ? fexp(m_c - gq) : fexp(lg * (float)(fwd ? (q + 1) : (128 - q)));
#pragma unroll
            for (int ks = 0; ks < KS; ++ks) {
                const bf16x8 qs = scale8u(qf[ks], wi);
#pragma unroll
                for (int t = 0; t < NDVT; ++t) nt[t] = mfma16(*(const LAS bf16x8*)(CT + (16 * t + c) * CTP + 32 * ks + 8 * g), qs, nt[t]);
            }
            float inv = 1.f;
            if (MLSTM) { const float den = __shfl(nt[NDVT - 1][0], c); const float fl = fexp(-(sb[pb + q] + gq)); inv = 1.0f / fmaxf(fabsf(den), fl); }
            bf16* op = OUT + (size_t)(rowb + q) * D + 4 * g;
#pragma unroll
            for (int t = 0; t < 8; ++t) *(u32x2*)(op + 16 * t) = pack4c(nt[t] * inv);
            __syncthreads();
        }
#if !defined(DBG_NO3)
        const float decay = MLSTM ? fexp(b_end + m_c - m_new) : fexp(lg * 128.0f);
#pragma unroll
        for (int t = 0; t < NOWN; ++t) ct[t] = ct[t] * decay;
#pragma unroll 1
        for (int ks2 = 0; ks2 < 4; ++ks2) {
            f32x4 w0, w1;
#pragma unroll
            for (int e = 0; e < 4; ++e) { const int j0 = 32 * ks2 + 8 * g + e, j1 = j0 + 4;
                if (MLSTM) { w0[e] = fexp(sa[pb + j0] + b_end - m_new); w1[e] = fexp(sa[pb + j1] + b_end - m_new); }
                else { w0[e] = fexp(lg * (float)(fwd ? (127 - j0) : j0)); w1[e] = fexp(lg * (float)(fwd ? (127 - j1) : j1)); } }
            const bf16x8 kf = scale8v(ldg16(Kt + (size_t)(16 * dkt + c) * tp + 32 * ks2 + 8 * g), w0, w1);
#pragma unroll
            for (int t = 0; t < NOWN; ++t) {
                const bool ext = MLSTM && (t == 8);
                const bf16x8 vf = ext ? ones : ldg16(Vt + (size_t)(16 * (dv0 + t) + c) * tp + 32 * ks2 + 8 * g);
                ct[t] = mfma16(kf, vf, ct[t]);
            }
        }
#pragma unroll
        for (int t = 0; t < NOWN; ++t) *(LAS u32x2*)(CT + (16 * (dv0 + t) + c) * CTP + 16 * dkt + 4 * g) = pack4c(ct[t]);
        __syncthreads();
#endif
    }
}

constexpr int SCAN_UNITS = 128;
__device__ __forceinline__ void scan_phase(const Args& a, LAS unsigned char* lds, int G, int tid, int lane, int wave) {
#ifndef DBG_SCAN
#define DBG_SCAN 0
#endif
    for (int u = blockIdx.x; u < SCAN_UNITS; u += G) {
        const int uu = u & 63, b = uu >> 3, hd = (uu >> 1) & 3, dir = uu & 1;
        const bool zero = (DBG_SCAN == 1) || (DBG_SCAN == 2 && u >= 64) || (DBG_SCAN == 3 && u < 64);
        if (zero) { bf16* OUT = (bf16*)(a.ws + (dir == 0 ? WS_H : WS_HB)) + (u < 64 ? hd * 128 : 512 + hd * 128);
            for (int i = tid; i < T * 16; i += 512) { const int row = i >> 4, c8 = (i & 15) * 8; *(v4u*)(OUT + (size_t)(b * T + row) * D + c8) = (v4u){0u, 0u, 0u, 0u}; } }
        else if (u < 64) scan_chain<128, true>(a, lds, b, hd, dir, tid, lane, wave);
        else scan_chain<64, false>(a, lds, b, hd, dir, tid, lane, wave);
        __syncthreads();
    }
}

__device__ __forceinline__ void rec_merge_phase(const Args& a, int gw, int NGW, int lane) {
    unsigned char* ws = a.ws;
    bf16* HF = (bf16*)(ws + WS_H); const bf16* HB = (const bf16*)(ws + WS_HB); const bf16* MO = (const bf16*)(ws + WS_MO); const bf16* RG = (const bf16*)(ws + WS_RG);
    const int col = 16 * lane; const bool ism = lane < 32;
    for (int r = gw; r < ML; r += NGW) {
        const v4u f0 = *(const v4u*)(HF + (size_t)r * D + col), f1 = *(const v4u*)(HF + (size_t)r * D + col + 8), b0 = *(const v4u*)(HB + (size_t)r * D + col), b1 = *(const v4u*)(HB + (size_t)r * D + col + 8);
        const bf16* gp = ism ? MO + (size_t)r * 512 + col : RG + (size_t)r * 512 + (col - 512);
        const v4u g0 = *(const v4u*)gp, g1 = *(const v4u*)(gp + 8);
        float v[16], gt[16];
#pragma unroll
        for (int k = 0; k < 4; ++k) { v[2 * k] = bflo(f0[k]) + bflo(b0[k]); v[2 * k + 1] = bfhi(f0[k]) + bfhi(b0[k]); v[8 + 2 * k] = bflo(f1[k]) + bflo(b1[k]); v[8 + 2 * k + 1] = bfhi(f1[k]) + bfhi(b1[k]);
            gt[2 * k] = bflo(g0[k]); gt[2 * k + 1] = bfhi(g0[k]); gt[8 + 2 * k] = bflo(g1[k]); gt[8 + 2 * k + 1] = bfhi(g1[k]); }
        float s = 0.f;
#pragma unroll
        for (int k = 0; k < 16; ++k) s += v[k];
        s += __shfl_xor(s, 1); s += __shfl_xor(s, 2); s += __shfl_xor(s, 4);
        const float mean = s * (1.0f / 128.0f); float q = 0.f;
#pragma unroll
        for (int k = 0; k < 16; ++k) { v[k] -= mean; q += v[k] * v[k]; }
        q += __shfl_xor(q, 1); q += __shfl_xor(q, 2); q += __shfl_xor(q, 4);
        const float rstd = 1.0f / sqrtf(q * (1.0f / 128.0f) + 1e-5f);
        const float* gn = ism ? a.in[I_MNG] + col : a.in[I_RNG] + (col - 512);
        const float* bn = a.in[I_RNB] + (ism ? 0 : col - 512);
        float o[16];
#pragma unroll
        for (int k = 0; k < 16; ++k) { float y = v[k] * rstd * gn[k]; if (!ism) y += bn[k]; o[k] = y * gt[k]; }
        v4u w0, w1;
#pragma unroll
        for (int k = 0; k < 4; ++k) { w0[k] = cvtpk(o[2 * k], o[2 * k + 1]); w1[k] = cvtpk(o[8 + 2 * k], o[8 + 2 * k + 1]); }
        *(v4u*)(HF + (size_t)r * D + col) = w0; *(v4u*)(HF + (size_t)r * D + col + 8) = w1;
    }
}
typedef const __attribute__((address_space(4))) Args* kargp;
__device__ __forceinline__ Args phase_args() {
    kargp p = (kargp)__builtin_amdgcn_kernarg_segment_ptr(); asm volatile("" : "+s"(p));
    Args la;
#pragma unroll
    for (int i = 0; i < 22; ++i) la.in[i] = p->in[i];
    la.out = p->out; la.ws = p->ws; la.ph_lo = p->ph_lo; la.ph_hi = p->ph_hi; return la;
}
#ifndef PH_MASK
#define PH_MASK 0x7ff
#endif
#define EN(k) (((PH_MASK) >> (k)) & 1)
#define PH_LANE() int ptid = threadIdx.x; asm volatile("" : "+v"(ptid)); const int tid = ptid, lane = ptid & 63, wave = __builtin_amdgcn_readfirstlane(ptid >> 6); const int gw = vcu * NWAVES + wave; (void)tid; (void)lane; (void)gw

__global__ void __launch_bounds__(NWAVES * 64, 2) mk_fwd(Args a_unused) {
    extern __shared__ __attribute__((aligned(16))) unsigned char lds_raw[];
    LAS unsigned char* lds = (LAS unsigned char*)lds_raw;
    volatile LAS unsigned* MISC = (volatile LAS unsigned*)(lds + MISC_OFF);
    const int tid = threadIdx.x, lane = tid & 63, wave = __builtin_amdgcn_readfirstlane(tid >> 6);
    const int G = gridDim.x; int vcu; { const int bx = blockIdx.x; vcu = (G % 8 == 0) ? (bx % 8) * (G / 8) + bx / 8 : bx; }
    const int NGW = G * NWAVES;
    for (int u = tid; u < (LDS_BYTES - LDSCTL_OFF) / 4; u += NWAVES * 64) ((LAS unsigned*)(lds + LDSCTL_OFF))[u] = 0u;
    __syncthreads();
    int lo, hi; XcdBarrier bar;
    { const Args pa = phase_args(); PH_LANE(); lo = pa.ph_lo; hi = pa.ph_hi; gu32* ctl = (gu32*)(pa.ws + WS_CTL);
      bar.bar = (unsigned*)(ctl + CW_BAR); bar.x = 0; bar.st = nullptr;
      if (!MK_PER_PHASE) bar = xcd_barrier_post((unsigned*)(ctl + CW_BAR), MISC + 8); }
#define IN(k) (lo <= (k) && (k) < hi)
#define SEAM(k) do { if (IN(k) && IN((k) + 1)) { if (MK_PER_PHASE) { if (tid == 0) __hip_atomic_store((gu32*)bar.bar - CW_BAR + CW_TMO, 0xBADBA0u, RLX_AGENT); } else xcd_barrier(bar); } } while (0)
    int kD = D, kFF = FF; asm volatile("" : "+s"(kD), "+s"(kFF));

    if (EN(0) && IN(0)) { const Args pa = phase_args(); PH_LANE(); p0a_prologue(pa, lds, G, vcu, tid, lane, wave); } SEAM(0);
    if (EN(1) && IN(1)) { const Args pa = phase_args(); PH_LANE(); p0b_modulate(pa, gw, NGW, lane); } SEAM(1);

    for (int l = 0; l < 2; ++l) {
        const int pb = 2 + 11 * l;
        const int rows_post = (l == 0) ? M : ML;
#pragma unroll
        for (int j = 0; j < 2; ++j) {
            const int p0 = pb + (j == 0 ? 0 : 8);
            const int rows = (j == 0) ? M : rows_post;
            if (EN(2) && IN(p0)) {
                const Args pa = phase_args(); PH_LANE(); unsigned char* ws = pa.ws;
                pg8::Gemm g{(const bf16*)(ws + WS_H), (const bf16*)(ws + WS_WFI) + (size_t)(l * 2 + j) * N_FI * D, rows, N_FI, kD}; pg8::StaticOrder S; S.init(rows, N_FI, G, (int)blockIdx.x);
                EpiSwiglu E{(bf16*)(ws + WS_ACT)};
                pg8::gemm_phase<EpiSwiglu, pg8::StaticOrder, true, true>(lds, g, S, E);
            }
            SEAM(p0);
            if (EN(3) && IN(p0 + 1)) {
                const Args pa = phase_args(); PH_LANE(); unsigned char* ws = pa.ws;
                const int s = (j == 0) ? 0 : 2;
                pg8::Gemm g{(const bf16*)(ws + WS_ACT), (const bf16*)(ws + WS_WFO) + (size_t)(l * 2 + j) * D * FF, rows, D, kFF}; pg8::StaticOrder S; S.init(rows, D, G, (int)blockIdx.x);
                const bool first = (l == 0 && j == 0);
                float* XC = (float*)(ws + WS_XC);
                EpiResid E{first ? pa.in[I_X] : pa.out, first ? pa.in[I_CTX] : XC, pa.out, XC, (const float*)(ws + WS_MOD) + (size_t)l * 9 * 9216 + (s * 3 + 2) * 1024, 0.5f};
                pg8::gemm_phase<EpiResid, pg8::StaticOrder, true, true>(lds, g, S, E);
            }
            SEAM(p0 + 1);
            if (EN(4) && IN(p0 + 2)) {
                const Args pa = phase_args(); PH_LANE(); unsigned char* ws = pa.ws;
                const int s = (j == 0) ? 0 : 2;
                const float* MOD = (const float*)(ws + WS_MOD);
                const float* modn = nullptr;
                if (j == 0) modn = MOD + (size_t)l * 9 * 9216 + (1 * 3) * 1024; else if (l == 0) modn = MOD + (size_t)1 * 9 * 9216;
                ln_phase(pa.out, (float*)(ws + WS_XC), pa.in[I_LNG] + (l * 3 + s) * D, pa.in[I_LNB] + (l * 3 + s) * D, modn, (bf16*)(ws + WS_H), rows, gw, NGW, lane);
            }
            if (!(l == 1 && j == 1)) SEAM(p0 + 2);
            if (j == 0) {
                if (IN(pb + 3)) {
                    if (EN(5) && l == 0) {
                        const Args pa = phase_args(); PH_LANE(); unsigned char* ws = pa.ws;
                        pg8::Gemm g{(const bf16*)(ws + WS_H), (const bf16*)(ws + WS_WAI), M, N_AI, kD}; pg8::StaticOrder S; S.init(M, N_AI, G, (int)blockIdx.x);
                        EpiAttnIn E{ws};
                        pg8::gemm_phase<EpiAttnIn, pg8::StaticOrder, true, true>(lds, g, S, E);
                    }
                    if (EN(6) && l == 1) {
                        const Args pa = phase_args(); PH_LANE(); unsigned char* ws = pa.ws;
                        pg8::Gemm g{(const bf16*)(ws + WS_H), (const bf16*)(ws + WS_WRI), M, N_RI, kD}; pg8::StaticOrder S; S.init(M, N_RI, G, (int)blockIdx.x);
                        EpiRecIn E{ws, pa.in[I_MGB]};
                        pg8::gemm_phase<EpiRecIn, pg8::StaticOrder, true, true>(lds, g, S, E);
                    }
                }
                SEAM(pb + 3);
                if (IN(pb + 4)) {
                    if (EN(7) && l == 0) { const Args pa = phase_args(); PH_LANE(); attn_phase(pa, lds, G, vcu, lane, wave); }
                    if (EN(8) && l == 1) { const Args pa = phase_args(); PH_LANE(); scan_phase(pa, lds, G, tid, lane, wave); }
                }
                SEAM(pb + 4);
                if (EN(9) && IN(pb + 5)) { if (l == 1) { const Args pa = phase_args(); PH_LANE(); rec_merge_phase(pa, gw, NGW, lane); } }
                SEAM(pb + 5);
                if (EN(10) && IN(pb + 6)) {
                    const Args pa = phase_args(); PH_LANE(); unsigned char* ws = pa.ws;
                    pg8::Gemm g{(const bf16*)(ws + WS_H), (const bf16*)(ws + (l == 0 ? WS_WAO : WS_WRO)), rows_post, D, kD}; pg8::StaticOrder S; S.init(rows_post, D, G, (int)blockIdx.x);
                    float* XC = (float*)(ws + WS_XC);
                    EpiResid E{pa.out, XC, pa.out, XC, (const float*)(ws + WS_MOD) + (size_t)l * 9 * 9216 + (1 * 3 + 2) * 1024, 1.0f};
                    pg8::gemm_phase<EpiResid, pg8::StaticOrder, true, true>(lds, g, S, E);
                }
                SEAM(pb + 6);
                if (EN(4) && IN(pb + 7)) {
                    const Args pa = phase_args(); PH_LANE(); unsigned char* ws = pa.ws;
                    ln_phase(pa.out, (float*)(ws + WS_XC), pa.in[I_LNG] + (l * 3 + 1) * D, pa.in[I_LNB] + (l * 3 + 1) * D, (const float*)(ws + WS_MOD) + (size_t)l * 9 * 9216 + (2 * 3) * 1024, (bf16*)(ws + WS_H), rows_post, gw, NGW, lane);
                }
                SEAM(pb + 7);
            }
        }
    }
#undef IN
#undef SEAM
}

#ifdef DBG_DUMP
__global__ void dbg_dump(const unsigned short* A, const unsigned short* B, const unsigned short* C, size_t n, float* out) {
    const size_t i = (size_t)blockIdx.x * 256 + threadIdx.x;
    float v = 0.f;
    if (i < n) { if (A) v += __uint_as_float(((unsigned)A[i]) << 16); if (B) v += 2.0f * __uint_as_float(((unsigned)B[i]) << 16); if (C) v += 4.0f * __uint_as_float(((unsigned)C[i]) << 16); }
    out[i] = v;
}
#endif
extern "C" void kernel_launch(void* const* d_in, const int* in_sizes, int n_in, void* d_out, int out_size, void* d_ws, size_t ws_size, hipStream_t stream) {
    static int grid = 0;
    if (grid == 0) {
        if (n_in != 22 || in_sizes[0] != ML * D || out_size != ML * D || ws_size < WS_END) { fprintf(stderr, "kernel_launch: unexpected shapes (n_in %d, in0 %d, out %d, ws %zu)\n", n_in, n_in > 0 ? in_sizes[0] : -1, out_size, ws_size); grid = -1; return; }
        int dev = 0, cus = 0, per_cu = 0;
        if (hipGetDevice(&dev) != hipSuccess || hipDeviceGetAttribute(&cus, hipDeviceAttributeMultiprocessorCount, dev) != hipSuccess) { grid = -1; return; }
        if (hipFuncSetAttribute((const void*)mk_fwd, hipFuncAttributeMaxDynamicSharedMemorySize, LDS_BYTES) != hipSuccess) { fprintf(stderr, "kernel_launch: hipFuncSetAttribute failed\n"); grid = -1; return; }
        if (hipOccupancyMaxActiveBlocksPerMultiprocessor(&per_cu, (const void*)mk_fwd, NWAVES * 64, LDS_BYTES) != hipSuccess || per_cu < 1) fprintf(stderr, "kernel_launch: occupancy query reports %d\n", per_cu);
        (void)hipGetLastError();
        grid = cus;
    }
    if (grid < 0) return;
    if (hipMemsetAsync((char*)d_ws + WS_CTL, 0, CTL_ZERO_BYTES, stream) != hipSuccess) return;
    Args a{};
    for (int i = 0; i < 22; ++i) a.in[i] = (const float*)d_in[i];
    a.out = (float*)d_out; a.ws = (unsigned char*)d_ws;
#if MK_PER_PHASE
    for (int p = 0; p < MK_STOP; ++p) { a.ph_lo = p; a.ph_hi = p + 1; hipLaunchKernelGGL(mk_fwd, dim3(grid), dim3(NWAVES * 64), LDS_BYTES, stream, a); }
#ifdef DBG_DUMP
    hipLaunchKernelGGL(dbg_dump, dim3(ML * D / 256), dim3(256), 0, stream, DBG_A ? (const unsigned short*)((char*)d_ws + DBG_A) : nullptr, DBG_B ? (const unsigned short*)((char*)d_ws + DBG_B) : nullptr, DBG_C ? (const unsigned short*)((char*)d_ws + DBG_C) : nullptr, (size_t)DBG_N, (float*)d_out);
#endif
#else
    a.ph_lo = 0; a.ph_hi = MK_STOP;
    hipLaunchKernelGGL(mk_fwd, dim3(grid), dim3(NWAVES * 64), LDS_BYTES, stream, a);
#endif
}
```

```cpp
#include <hip/hip_runtime.h>
#include <cstdio>
#include <cstdint>
namespace pg8 {
#define PG8_LAS __attribute__((address_space(3)))
typedef unsigned short bf16_t;
typedef short bf16x8 __attribute__((ext_vector_type(8)));
typedef float f32x4 __attribute__((ext_vector_type(4)));
typedef unsigned u32x4 __attribute__((ext_vector_type(4)));
constexpr int BM = 256, BK = 64, HALF = 128, HTB = HALF * BK * 2  , STAGE_BYTES = 8 * HTB, NXCD = 8, WGM = 8;

__host__ __device__ __forceinline__ int lds_byte(int r, int c) { const int st = (r >> 4) * 2 + (c >> 5), rr = r & 15, cc = c & 31, ob = rr * 64 + cc * 2; return st * 1024 + (ob ^ (((ob >> 9) & 1) << 5)); }
__host__ __device__ __forceinline__ void stage_rc(int b, int& R, int& C) { const int st = b / 1024, sb = b % 1024, swz = sb ^ (((sb >> 9) & 1) << 5); R = (st >> 1) * 16 + swz / 64; C = (st & 1) * 32 + (swz % 64) / 2; }
__host__ __device__ __forceinline__ int perm32(int rho) { const int n = rho >> 4, i = rho & 15; return 8 * (i >> 2) + 4 * n + (i & 3); }

struct Unit { int pm, pn; };
struct Gemm { const bf16_t* A; const bf16_t* Bt; int M, N, K; };

struct StaticOrder {
    int nM, nN, nwg, G, c;
    __host__ __device__ void init(int M, int N, int G_, int c_) { nM = M / BM; nN = N / BM; nwg = nM * nN; G = G_; c = c_; }
    __host__ __device__ bool next(int i, Unit& u) const {
        const long L = (long)i * G + c; if (L >= nwg) return false;
        int wgid = (int)L; { const int q = nwg / NXCD, r = nwg % NXCD, xcd = wgid % NXCD, off = wgid / NXCD; wgid = (xcd < r ? xcd * (q + 1) : r * (q + 1) + (xcd - r) * q) + off; }
        const int nig = WGM * nN, gid = wgid / nig, fm = gid * WGM, gsz = (nM - fm) < WGM ? (nM - fm) : WGM;
        u.pm = fm + ((wgid % nig) % gsz); u.pn = (wgid % nig) / gsz; return true;
    }
    __device__ __forceinline__ void a_ready(const Unit&) const {}
    __device__ __forceinline__ void done(const Unit&) const {}
};

__device__ __forceinline__ unsigned cvt_pk_bf16(float lo, float hi) { unsigned r; asm volatile("v_cvt_pk_bf16_f32 %0, %1, %2" : "=v"(r) : "v"(lo), "v"(hi)); return r; }
template <class Epi, class Sched, bool ALIGN_EPI = false, bool SP2 = false>
__device__ __forceinline__ void gemm_phase(PG8_LAS unsigned char* lds, const Gemm g, const Sched& S, const Epi& E) {
    int tid_l = threadIdx.x; asm volatile("" : "+v"(tid_l));
    const int tid = tid_l, wid = __builtin_amdgcn_readfirstlane(tid >> 6), lane = tid & 63, wr = wid >> 2, wc = wid & 3, fr = lane & 15, fq = lane >> 4;
    const int K = g.K, nt = K / BK;
    unsigned voffA[2], voffB[2];
#pragma unroll
    for (int i = 0; i < 2; ++i) { int R, C; stage_rc(tid * 16 + i * 8192, R, C); const int Rb = Epi::PERM ? ((R & ~31) + perm32(R & 31)) : R;
        voffA[i] = (unsigned)(R * K + C) * 2u; voffB[i] = (unsigned)(Rb * K + C) * 2u; }
    const size_t kstep = (size_t)(BK * 2);
    const size_t hstep = (size_t)HALF * K * 2;
    const size_t tstep = 2 * hstep;
    const unsigned ldsw = (unsigned)wid * 1024u;
    const int aoff = lds_byte(wr * 64 + fr, fq * 8), boff = lds_byte(wc * 32 + fr, fq * 8);
#define PG8_SA(b, h) (((b) * 2 + (h)) * HTB)
#define PG8_SB(b, h) ((4 + (b) * 2 + (h)) * HTB)
#define PG8_STAGE(bufoff, gbase, voff) do { _Pragma("unroll") for (int _i = 0; _i < 2; ++_i) \
        __builtin_amdgcn_global_load_lds((const unsigned*)((const char*)(gbase) + (voff)[_i]), (PG8_LAS unsigned*)(lds + (bufoff) + ldsw + _i * 8192), 16, 0, 0); } while (0)
#define PG8_LDA(dst, b, h) do { _Pragma("unroll") for (int m = 0; m < 4; ++m) _Pragma("unroll") for (int k = 0; k < 2; ++k) dst[m][k] = *(const PG8_LAS bf16x8*)(lds + PG8_SA(b, h) + aoff + m * 2048 + k * 1024); } while (0)
#define PG8_LDB(dst, b, h) do { _Pragma("unroll") for (int n = 0; n < 2; ++n) _Pragma("unroll") for (int k = 0; k < 2; ++k) dst[n][k] = *(const PG8_LAS bf16x8*)(lds + PG8_SB(b, h) + boff + n * 2048 + k * 1024); } while (0)
#define PG8_MMA(ai, bj, At, Bt) do { __builtin_amdgcn_s_setprio(1); _Pragma("unroll") for (int m = 0; m < 4; ++m) _Pragma("unroll") for (int n = 0; n < 2; ++n) _Pragma("unroll") for (int k = 0; k < 2; ++k) \
        acc[ai][bj][m][n] = __builtin_amdgcn_mfma_f32_16x16x32_bf16(Bt[n][k], At[m][k], acc[ai][bj][m][n], 0, 0, 0); __builtin_amdgcn_s_setprio(0); } while (0)
#define PG8_WAIT_V(n) asm volatile("s_waitcnt vmcnt(" #n ")" ::: "memory")
#define PG8_WAIT_L(n) asm volatile("s_waitcnt lgkmcnt(" #n ")" ::: "memory")
#define PG8_BAR __builtin_amdgcn_s_barrier()
#define PG8_SCHED __builtin_amdgcn_sched_barrier(0)
    Unit cur, nxt; int ui = 0;
    if (!S.next(0, cur)) return;
    f32x4 acc[2][2][4][2];
#pragma unroll
    for (int a = 0; a < 2; ++a)
#pragma unroll
        for (int b = 0; b < 2; ++b)
#pragma unroll
            for (int m = 0; m < 4; ++m)
#pragma unroll
                for (int n = 0; n < 2; ++n) acc[a][b][m][n] = (f32x4){0.f, 0.f, 0.f, 0.f};
    bf16x8 At[4][2], B0[2][2], B1[2][2];
    const char* cA = (const char*)g.A + (size_t)cur.pm * tstep; const char* cB = (const char*)g.Bt + (size_t)cur.pn * tstep;
    S.a_ready(cur);
    if constexpr (SP2) {
        PG8_STAGE(PG8_SB(0, 0), cB, voffB); PG8_STAGE(PG8_SB(0, 1), cB + hstep, voffB); PG8_STAGE(PG8_SA(0, 0), cA, voffA); PG8_STAGE(PG8_SA(0, 1), cA + hstep, voffA);
        if (wr == 1) PG8_BAR;
        PG8_WAIT_V(2); PG8_BAR;
        PG8_STAGE(PG8_SB(1, 0), cB + kstep, voffB); PG8_STAGE(PG8_SA(1, 0), cA + kstep, voffA); PG8_STAGE(PG8_SB(1, 1), cB + hstep + kstep, voffB);
        PG8_WAIT_V(6); PG8_BAR;
    } else {
        PG8_STAGE(PG8_SB(0, 0), cB, voffB); PG8_STAGE(PG8_SA(0, 0), cA, voffA); PG8_STAGE(PG8_SB(0, 1), cB + hstep, voffB); PG8_STAGE(PG8_SA(0, 1), cA + hstep, voffA);
        if (wr == 1) PG8_BAR;
        PG8_WAIT_V(4); PG8_BAR;
        PG8_STAGE(PG8_SB(1, 0), cB + kstep, voffB); PG8_STAGE(PG8_SA(1, 0), cA + kstep, voffA); PG8_STAGE(PG8_SB(1, 1), cB + hstep + kstep, voffB);
        PG8_WAIT_V(6); PG8_BAR;
    }
    for (;;) {
        const bool has_next = S.next(ui + 1, nxt);
        const char* nA = has_next ? (const char*)g.A + (size_t)nxt.pm * tstep : cA; const char* nB = has_next ? (const char*)g.Bt + (size_t)nxt.pn * tstep : cB;
        for (int t = 0; t < nt; t += 2) {
            const bool last = (t == nt - 2);
            const char* a1 = cA + (size_t)(t + 1) * kstep;
            const char* a2 = last ? nA : cA + (size_t)(t + 2) * kstep; const char* b2 = last ? nB : cB + (size_t)(t + 2) * kstep;
            const char* a3 = a2 + kstep; const char* b3 = b2 + kstep;
            if (last && has_next) S.a_ready(nxt);
            if constexpr (SP2) {
            PG8_LDB(B0, 0, 0); PG8_LDB(B1, 0, 1); PG8_SCHED; PG8_LDA(At, 0, 0); PG8_STAGE(PG8_SA(1, 1), a1 + hstep, voffA);
            PG8_WAIT_V(8); PG8_WAIT_L(0); PG8_BAR; PG8_MMA(0, 0, At, B0); PG8_MMA(0, 1, At, B1); PG8_BAR; PG8_SCHED;
            PG8_LDA(At, 0, 1); PG8_STAGE(PG8_SB(0, 0), b2, voffB); PG8_STAGE(PG8_SB(0, 1), b2 + hstep, voffB); PG8_STAGE(PG8_SA(0, 0), a2, voffA);
            PG8_WAIT_V(8); PG8_WAIT_L(0); PG8_BAR; PG8_MMA(1, 0, At, B0); PG8_MMA(1, 1, At, B1); PG8_BAR; PG8_SCHED;
            PG8_LDB(B0, 1, 0); PG8_LDB(B1, 1, 1); PG8_SCHED; PG8_LDA(At, 1, 0); PG8_STAGE(PG8_SA(0, 1), a2 + hstep, voffA);
            PG8_WAIT_V(8); PG8_WAIT_L(0); PG8_BAR; PG8_MMA(0, 0, At, B0); PG8_MMA(0, 1, At, B1); PG8_BAR; PG8_SCHED;
            PG8_LDA(At, 1, 1); PG8_STAGE(PG8_SB(1, 0), b3, voffB); PG8_STAGE(PG8_SB(1, 1), b3 + hstep, voffB); PG8_STAGE(PG8_SA(1, 0), a3, voffA);
            PG8_WAIT_V(8); PG8_WAIT_L(0); PG8_BAR; PG8_MMA(1, 0, At, B0); PG8_MMA(1, 1, At, B1); PG8_BAR; PG8_SCHED;
            } else {
            PG8_LDB(B0, 0, 0); PG8_SCHED; PG8_LDA(At, 0, 0); PG8_STAGE(PG8_SA(1, 1), a1 + hstep, voffA);
            PG8_WAIT_L(8); PG8_BAR; PG8_WAIT_L(0); PG8_MMA(0, 0, At, B0); PG8_BAR; PG8_SCHED;
            PG8_LDB(B1, 0, 1); PG8_STAGE(PG8_SB(0, 0), b2, voffB);
            PG8_BAR; PG8_WAIT_L(0); PG8_MMA(0, 1, At, B1); PG8_BAR;
            PG8_LDA(At, 0, 1); PG8_STAGE(PG8_SA(0, 0), a2, voffA);
            PG8_BAR; PG8_WAIT_L(0); PG8_MMA(1, 0, At, B0); PG8_BAR; PG8_SCHED;
            PG8_STAGE(PG8_SB(0, 1), b2 + hstep, voffB);
            PG8_WAIT_V(6); PG8_BAR; PG8_MMA(1, 1, At, B1); PG8_BAR;
            PG8_LDB(B0, 1, 0); PG8_SCHED; PG8_LDA(At, 1, 0); PG8_STAGE(PG8_SA(0, 1), a2 + hstep, voffA);
            PG8_WAIT_L(8); PG8_BAR; PG8_WAIT_L(0); PG8_MMA(0, 0, At, B0); PG8_BAR; PG8_SCHED;
            PG8_LDB(B1, 1, 1); PG8_STAGE(PG8_SB(1, 0), b3, voffB);
            PG8_BAR; PG8_WAIT_L(0); PG8_MMA(0, 1, At, B1); PG8_BAR;
            PG8_LDA(At, 1, 1); PG8_STAGE(PG8_SA(1, 0), a3, voffA);
            PG8_BAR; PG8_WAIT_L(0); PG8_MMA(1, 0, At, B0); PG8_BAR; PG8_SCHED;
            PG8_STAGE(PG8_SB(1, 1), b3 + hstep, voffB);
            PG8_WAIT_V(6); PG8_BAR; PG8_MMA(1, 1, At, B1); PG8_BAR;
            }
        }
        if constexpr (ALIGN_EPI) { if (wr == 0) PG8_BAR; }
        if constexpr (!Epi::AFTER_DRAIN) { E(acc, cur, wr, wc, fr, fq); S.done(cur); }
        if (!has_next) break;
#pragma unroll
        for (int a = 0; a < 2; ++a)
#pragma unroll
            for (int b = 0; b < 2; ++b)
#pragma unroll
                for (int m = 0; m < 4; ++m)
#pragma unroll
                    for (int n = 0; n < 2; ++n) acc[a][b][m][n] = (f32x4){0.f, 0.f, 0.f, 0.f};
        cur = nxt; cA = nA; cB = nB; ++ui;
        if constexpr (ALIGN_EPI) { if (wr == 1) PG8_BAR; }
    }
    PG8_WAIT_V(0);
    if constexpr (!ALIGN_EPI) { if (wr == 0) PG8_BAR; }
    PG8_BAR;
    if constexpr (Epi::AFTER_DRAIN) { E.fused(acc, cur, wr, wc, fr, fq, lds, wid, lane); S.done(cur); }
#undef PG8_SA
#undef PG8_SB
#undef PG8_STAGE
#undef PG8_LDA
#undef PG8_LDB
#undef PG8_MMA
#undef PG8_WAIT_V
#undef PG8_WAIT_L
#undef PG8_BAR
#undef PG8_SCHED
}
}
#define GAS __attribute__((address_space(1)))
#define LAS __attribute__((address_space(3)))
typedef unsigned short bf16;
typedef unsigned v4u __attribute__((ext_vector_type(4)));
typedef float f32x4 __attribute__((ext_vector_type(4)));
typedef short bf16x8 __attribute__((ext_vector_type(8)));
typedef GAS unsigned gu32;
typedef GAS unsigned long long gu64;
#define RLX_AGENT __ATOMIC_RELAXED, __HIP_MEMORY_SCOPE_AGENT
#define LDS_WAIT() asm volatile("s_waitcnt lgkmcnt(0)" ::: "memory")
#define VM_WAIT() asm volatile("s_waitcnt vmcnt(0)" ::: "memory")
__device__ __forceinline__ unsigned long long rt() { return __builtin_amdgcn_s_memrealtime(); }
__device__ __forceinline__ unsigned f2bf(float f) { unsigned u = __builtin_bit_cast(unsigned, f); return (u + 0x7fffu + ((u >> 16) & 1u)) >> 16; }
__device__ __forceinline__ unsigned pk2(float lo, float hi) { return f2bf(lo) | (f2bf(hi) << 16); }

#define XB_TMO      128
#define XB_XCNT(j)  (256  + 64 * (j))
#define XB_XSUB(j)  (1280 + 64 * (j))
#define XB_XGEN(j)  (2304 + 64 * (j))
#define XB_TOP      3328
#define XB_TOPGEN   3392
#define XCD_BAR_WORDS 3456
#define XB_SPIN_CAP (1u << 18)

__device__ __forceinline__ unsigned xb_ld(unsigned* p)              { return __hip_atomic_load(p, __ATOMIC_RELAXED, __HIP_MEMORY_SCOPE_AGENT); }
__device__ __forceinline__ unsigned xb_add(unsigned* p, unsigned v) { return __hip_atomic_fetch_add(p, v, __ATOMIC_RELAXED, __HIP_MEMORY_SCOPE_AGENT); }
__device__ __forceinline__ unsigned xb_xcc_id() { return (unsigned)__builtin_amdgcn_s_getreg((3 << 11) | 20) & 0xFu; }
#define XB_SPIN(cond, bar) do { unsigned _sp = 0; while (cond) { __builtin_amdgcn_s_sleep(1); \
    if ((++_sp & 255u) == 0u) { if (xb_ld(&(bar)[XB_TMO])) break; if (_sp > XB_SPIN_CAP) { atomicAdd(&(bar)[XB_TMO], 1u); break; } } } } while (0)

struct XcdBarrier {
    unsigned* bar; unsigned x;
    volatile LAS unsigned* st;
};

__device__ __forceinline__ XcdBarrier xcd_barrier_post(unsigned* bar, volatile LAS unsigned* st) {
    XcdBarrier b; b.bar = bar; b.x = xb_xcc_id(); b.st = st;
    if (threadIdx.x == 0) (void)xb_add(&bar[XB_XCNT(b.x)], 1u);
    return b;
}
__device__ __forceinline__ void xcd_barrier_complete(unsigned* bar, unsigned x, unsigned& nloc, unsigned& nx) {
    const unsigned G = gridDim.x * gridDim.y * gridDim.z;
    unsigned sum, cnt, mine, sp = 0u;
    for (;;) {
        sum = 0u; cnt = 0u; mine = 0u;
#pragma unroll
        for (unsigned j = 0; j < 16; ++j) { const unsigned c = xb_ld(&bar[XB_XCNT(j)]); sum += c; cnt += (c > 0u) ? 1u : 0u; mine = (j == x) ? c : mine; }
        if (sum == G) break;
        __builtin_amdgcn_s_sleep(1);
        if ((++sp & 255u) == 0u) { if (xb_ld(&bar[XB_TMO])) break; if (sp > XB_SPIN_CAP) { atomicAdd(&bar[XB_TMO], 1u); break; } }
    }
    nloc = mine > 0u ? mine : 1u; nx = cnt > 0u ? cnt : 1u;
}

__device__ __forceinline__ void xcd_barrier(const XcdBarrier& b) {
    asm volatile("s_waitcnt vmcnt(0)" ::: "memory");
    __syncthreads();
    if (threadIdx.x == 0) {
        unsigned* bar = b.bar;
        __builtin_amdgcn_s_waitcnt(0);
        unsigned nloc = b.st[0], nx = b.st[1];
        if (nloc == 0u) { xcd_barrier_complete(bar, b.x, nloc, nx); b.st[0] = nloc; b.st[1] = nx; }
        const unsigned old = xb_add(&bar[XB_XSUB(b.x)], 1u);
        const unsigned gen = old / nloc;
        if (old + 1u == (gen + 1u) * nloc) {
            __builtin_amdgcn_fence(__ATOMIC_RELEASE, "agent");
            asm volatile("s_waitcnt vmcnt(0)" ::: "memory");
            const unsigned og = xb_add(&bar[XB_TOP], 1u);
            const unsigned tg = og / nx;
            if (og + 1u == (tg + 1u) * nx) xb_add(&bar[XB_TOPGEN], 1u);
            else XB_SPIN(xb_ld(&bar[XB_TOPGEN]) == tg, bar);
            __builtin_amdgcn_fence(__ATOMIC_ACQUIRE, "agent");
            xb_add(&bar[XB_XGEN(b.x)], 1u);
            asm volatile("s_waitcnt vmcnt(0)" ::: "memory");
        } else {
            XB_SPIN(xb_ld(&bar[XB_XGEN(b.x)]) == gen, bar);
            __builtin_amdgcn_fence(__ATOMIC_ACQUIRE, "agent");
            asm volatile("s_waitcnt vmcnt(0)" ::: "memory");
        }
    }
    __syncthreads();
}
constexpr int NB = 8, T = 4096, D = 1024, TC = 256, FF = 2816;
constexpr int ML = NB * T, MC = NB * TC, M = ML + MC;
constexpr int N_FI = 2 * FF, N_AI = 2304, N_RI = 3840, N_RI_SRC = 3600;
constexpr float ALPHA = 1.41421356237309515f;
constexpr float LOG2E = 1.4426950408889634f;
constexpr float QSCALE = 0.125f * LOG2E;
constexpr int NWAVES = 8;
#ifndef MK_PER_PHASE
#define MK_PER_PHASE 0
#endif
constexpr int N_PHASES = 2 + 2 * 11;
#ifndef MK_STOP
#define MK_STOP N_PHASES
#endif

constexpr size_t MiB = 1u << 20;
constexpr size_t WS_CTL = 0, CTL_ZERO_BYTES = 1 * MiB;
constexpr size_t WS_MOD = 1 * MiB;
constexpr size_t WS_ROPE = WS_MOD + 704 * 1024;
constexpr size_t WS_LAM = WS_ROPE + 8192;
constexpr size_t WS_WFI = 2 * MiB;
constexpr size_t WS_WFO = 46 * MiB;
constexpr size_t WS_WAI = 68 * MiB;
constexpr size_t WS_WAO = WS_WAI + 4608 * 1024;
constexpr size_t WS_WRI = WS_WAO + 2 * MiB;
constexpr size_t WS_WRO = WS_WRI + 7680 * 1024;
constexpr size_t WS_XC = 84 * MiB;
constexpr size_t WS_H = 92 * MiB;
constexpr size_t WS_HB = 160 * MiB;
constexpr size_t WS_BIG = 228 * MiB;
constexpr size_t WS_END = 500 * MiB;
static_assert(WS_WRO + 2 * MiB <= WS_XC, "weights");
constexpr size_t WS_ACT = WS_BIG;
constexpr size_t WS_AQ = WS_BIG, WS_AK = WS_BIG + 34 * MiB, WS_BQ = WS_BIG + 68 * MiB, WS_BK = WS_BIG + 102 * MiB;
constexpr size_t WS_VTA_L = WS_BIG + 111 * MiB, WS_VTA_C = WS_BIG + 143 * MiB, WS_VTB_L = WS_BIG + 145 * MiB, WS_VTB_C = WS_BIG + 153 * MiB;
constexpr size_t WS_MQ = WS_BIG, WS_MK = WS_BIG + 34 * MiB, WS_MO = WS_BIG + 68 * MiB, WS_RQ = WS_BIG + 102 * MiB, WS_RK = WS_BIG + 119 * MiB, WS_RG = WS_BIG + 136 * MiB;
constexpr size_t WS_MKT_L = WS_BIG + 170 * MiB, WS_MKT_C = WS_BIG + 202 * MiB, WS_MVT_L = WS_BIG + 204 * MiB, WS_MVT_C = WS_BIG + 236 * MiB;
constexpr size_t WS_RVT_L = WS_BIG + 238 * MiB, WS_RVT_C = WS_BIG + 270 * MiB;
constexpr size_t WS_RKT_L = 2 * MiB, WS_RKT_C = 18 * MiB, WS_GATE = 20 * MiB;
static_assert(WS_RVT_C + 2 * MiB <= WS_END && WS_GATE + (size_t)M * 16 * 4 <= 24 * MiB, "ws map");

constexpr int CW_TMO = 0, CW_CODE = 1, CW_BAR = 4096;
constexpr int RING_BYTES = 131072;
constexpr int LDSCTL_OFF = RING_BYTES, MISC_OFF = LDSCTL_OFF + 320;
constexpr int LDS_BYTES = 147456;
typedef float f32x16 __attribute__((ext_vector_type(16)));
typedef short bf16x4 __attribute__((ext_vector_type(4)));
typedef unsigned u32x2 __attribute__((ext_vector_type(2)));
__device__ __forceinline__ float wave_sum(float v) {
#pragma unroll
    for (int o = 1; o < 64; o <<= 1) v += __shfl_xor(v, o);
    return v;
}
__device__ __forceinline__ float bf2f(unsigned short b) { return __uint_as_float(((unsigned)b) << 16); }
__device__ __forceinline__ float bflo(unsigned w) { return __uint_as_float(w << 16); }
__device__ __forceinline__ float bfhi(unsigned w) { return __uint_as_float(w & 0xffff0000u); }
__device__ __forceinline__ float fexp2(float x) { return __builtin_amdgcn_exp2f(x); }
__device__ __forceinline__ float fexp(float x) { return __builtin_amdgcn_exp2f(x * LOG2E); }
__device__ __forceinline__ float frcp(float x) { return __builtin_amdgcn_rcpf(x); }
__device__ __forceinline__ float silu_f(float x) { return x * frcp(1.0f + fexp(-x)); }
__device__ __forceinline__ float sigmoid_f(float x) { return frcp(1.0f + fexp(-x)); }
__device__ __forceinline__ u32x2 pack4(f32x4 v) { u32x2 w; w.x = pk2(v[0], v[1]); w.y = pk2(v[2], v[3]); return w; }
__device__ __forceinline__ f32x4 mfma16(bf16x8 a, bf16x8 b, f32x4 c) { return __builtin_amdgcn_mfma_f32_16x16x32_bf16(a, b, c, 0, 0, 0); }
__device__ __forceinline__ f32x16 mfma32(bf16x8 a, bf16x8 b, f32x16 c) { return __builtin_amdgcn_mfma_f32_32x32x16_bf16(a, b, c, 0, 0, 0); }
__device__ __forceinline__ int crow(int i, int h) { return (i & 3) + 8 * (i >> 2) + 4 * h; }
__device__ __forceinline__ bf16x8 ldg16(const bf16* p) { return *(const bf16x8*)p; }
__device__ __forceinline__ bf16x8 scale8u(bf16x8 v, float s) {
    const v4u u = __builtin_bit_cast(v4u, v); v4u o;
    o.x = pk2(bflo(u.x) * s, bfhi(u.x) * s); o.y = pk2(bflo(u.y) * s, bfhi(u.y) * s); o.z = pk2(bflo(u.z) * s, bfhi(u.z) * s); o.w = pk2(bflo(u.w) * s, bfhi(u.w) * s);
    return __builtin_bit_cast(bf16x8, o);
}
__device__ __forceinline__ bf16x8 scale8v(bf16x8 v, f32x4 s0, f32x4 s1) {
    const v4u u = __builtin_bit_cast(v4u, v); v4u o;
    o.x = pk2(bflo(u.x) * s0[0], bfhi(u.x) * s0[1]); o.y = pk2(bflo(u.y) * s0[2], bfhi(u.y) * s0[3]); o.z = pk2(bflo(u.z) * s1[0], bfhi(u.z) * s1[1]); o.w = pk2(bflo(u.w) * s1[2], bfhi(u.w) * s1[3]);
    return __builtin_bit_cast(bf16x8, o);
}
typedef __bf16 bf16x2_t __attribute__((ext_vector_type(2)));
typedef float f32x2_t __attribute__((ext_vector_type(2)));
__device__ __forceinline__ unsigned cvtpk(float lo, float hi) { const f32x2_t v = {lo, hi}; const bf16x2_t b = __builtin_convertvector(v, bf16x2_t); return __builtin_bit_cast(unsigned, b); }
__device__ __forceinline__ u32x2 pack4c(f32x4 v) { u32x2 w; w.x = cvtpk(v[0], v[1]); w.y = cvtpk(v[2], v[3]); return w; }

struct EpiSwiglu {
    static constexpr bool PERM = true, AFTER_DRAIN = false;
    bf16* ACT;
    __device__ __forceinline__ void operator()(const f32x4 (&acc)[2][2][4][2], const pg8::Unit& u, int wr, int wc, int fr, int fq) const {
        const int row0 = u.pm * 256 + wr * 64 + fr, col0 = u.pn * 128 + wc * 32 + 8 * fq;
#pragma unroll
        for (int ai = 0; ai < 2; ++ai)
#pragma unroll
            for (int m = 0; m < 4; ++m) {
                bf16* rowp = ACT + (size_t)(row0 + ai * 128 + m * 16) * FF + col0;
                const f32x4 g0 = acc[ai][0][m][0], g1 = acc[ai][0][m][1], u0 = acc[ai][1][m][0], u1 = acc[ai][1][m][1];
                f32x4 a0, a1;
#pragma unroll
                for (int e = 0; e < 4; ++e) { a0[e] = silu_f(g0[e]) * u0[e]; a1[e] = silu_f(g1[e]) * u1[e]; }
                v4u w; w.x = cvtpk(a0[0], a0[1]); w.y = cvtpk(a0[2], a0[3]); w.z = cvtpk(a1[0], a1[1]); w.w = cvtpk(a1[2], a1[3]);
                *(v4u*)rowp = w;
            }
    }
};

struct EpiResid {
    static constexpr bool PERM = false, AFTER_DRAIN = false;
    const float* base_l; const float* base_c; float* out_l; float* out_c; const float* gate; float wgt;
    __device__ __forceinline__ void operator()(const f32x4 (&acc)[2][2][4][2], const pg8::Unit& u, int wr, int wc, int fr, int fq) const {
        const int r0 = u.pm * 256; const bool lat = r0 < ML; const int mr = lat ? (r0 >> 12) : 8;
        const float* bp = lat ? base_l + (size_t)r0 * D : base_c + (size_t)(r0 - ML) * D;
        float* op = lat ? out_l + (size_t)r0 * D : out_c + (size_t)(r0 - ML) * D;
        const float* gp = gate + (size_t)mr * 9216;
        const int col0 = u.pn * 256 + wc * 32 + 4 * fq;
        f32x4 gv[2][2];
#pragma unroll
        for (int bj = 0; bj < 2; ++bj)
#pragma unroll
            for (int n = 0; n < 2; ++n) gv[bj][n] = *(const f32x4*)(gp + col0 + bj * 128 + n * 16) * wgt;
#pragma unroll
        for (int ai = 0; ai < 2; ++ai)
#pragma unroll
            for (int m = 0; m < 4; ++m) {
                const size_t ro = (size_t)(ai * 128 + wr * 64 + m * 16 + fr) * D;
#pragma unroll
                for (int bj = 0; bj < 2; ++bj)
#pragma unroll
                    for (int n = 0; n < 2; ++n) { const int c = col0 + bj * 128 + n * 16; const f32x4 x = *(const f32x4*)(bp + ro + c);
                        *(f32x4*)(op + ro + c) = x * ALPHA + gv[bj][n] * acc[ai][bj][m][n]; }
            }
    }
};

__device__ __forceinline__ void epi_store_T(const f32x4 (&acc)[2][2][4][2], int bj, bf16* tb, int TL, int trow, int t0, float sc, int wr, int wc, int fr, int fq) {
#ifdef NO_T
    return;
#endif
    bf16* p0 = tb + (size_t)(trow + bj * 128 + wc * 32 + 4 * fq) * TL + t0 + wr * 64 + fr;
#pragma unroll
    for (int ai = 0; ai < 2; ++ai)
#pragma unroll
        for (int m = 0; m < 4; ++m) {
#pragma unroll
            for (int n = 0; n < 2; ++n) { const u32x2 w = pack4c(acc[ai][bj][m][n] * sc);
                bf16* p = p0 + (size_t)(16 * n) * TL + ai * 128 + m * 16;
                p[0] = (bf16)(w.x & 0xffffu); p[(size_t)TL] = (bf16)(w.x >> 16); p[(size_t)2 * TL] = (bf16)(w.y & 0xffffu); p[(size_t)3 * TL] = (bf16)(w.y >> 16); }
            asm volatile("" ::: "memory");
        }
}
template <int ACT>
__device__ __forceinline__ void epi_store_P(const f32x4 (&acc)[2][2][4][2], int bj, bf16* dst0, int pitch, int cb, float sc, int wr, int wc, int fr, int fq) {
    bf16* p0 = dst0 + (size_t)(wr * 64 + fr) * pitch + cb + bj * 128 + wc * 32 + 4 * fq;
#pragma unroll
    for (int ai = 0; ai < 2; ++ai)
#pragma unroll
        for (int m = 0; m < 4; ++m) {
#pragma unroll
            for (int n = 0; n < 2; ++n) { f32x4 v = acc[ai][bj][m][n] * sc;
                if (ACT == 1) {
#pragma unroll
                    for (int e = 0; e < 4; ++e) v[e] = sigmoid_f(v[e]); }
                if (ACT == 2) {
#pragma unroll
                    for (int e = 0; e < 4; ++e) v[e] = silu_f(v[e]); }
                *(u32x2*)(p0 + (size_t)(ai * 128 + m * 16) * pitch + 16 * n) = pack4c(v); }
            asm volatile("" ::: "memory");
        }
}
__device__ __forceinline__ void epi_store_R(const f32x4 (&acc)[2][2][4][2], int bj, bf16* dst0, int pitch, int cb, float sc, bool rope, int t0, const float* cosT, const float* sinT, int wr, int wc, int fr, int fq) {
#ifdef NO_R
    return;
#endif
    bf16* p0 = dst0 + (size_t)(wr * 64 + fr) * pitch + cb + bj * 128 + wc * 32 + 4 * fq;
#pragma unroll
    for (int ai = 0; ai < 2; ++ai)
#pragma unroll
        for (int m = 0; m < 4; ++m) { const int rr = ai * 128 + wr * 64 + m * 16 + fr; const int t = t0 + rr;
            const f32x4 x1 = acc[ai][bj][m][0], x2 = acc[ai][bj][m][1]; f32x4 o1 = x1, o2 = x2;
            if (rope) { const int pos = (wc & 1) ? (t & 63) : (t >> 6);
                const f32x4 c4 = *(const f32x4*)(cosT + pos * 16 + 4 * fq), s4 = *(const f32x4*)(sinT + pos * 16 + 4 * fq);
                o1 = x1 * c4 - x2 * s4; o2 = x2 * c4 + x1 * s4; }
            bf16* p = p0 + (size_t)(ai * 128 + m * 16) * pitch;
            *(u32x2*)p = pack4c(o1 * sc); *(u32x2*)(p + 16) = pack4c(o2 * sc);
            asm volatile("" ::: "memory"); }
}

struct EpiAttnIn {
    static constexpr bool PERM = false, AFTER_DRAIN = false;
    unsigned char* ws;
    __device__ __forceinline__ void operator()(const f32x4 (&acc)[2][2][4][2], const pg8::Unit& u, int wr, int wc, int fr, int fq) const {
        asm volatile("" : "+v"(fr), "+v"(fq));
        const int r0 = u.pm * 256; const bool lat = r0 < ML; const int b = lat ? (r0 >> 12) : ((r0 - ML) >> 8); const int t0 = lat ? (r0 & 4095) : 0;
        const int pn = u.pn; const int TL = lat ? T : TC;
        const float* cosT = (const float*)(ws + WS_ROPE); const float* sinT = cosT + 1024;
        if (pn == 4 || pn == 5) {
            bf16* vb = (bf16*)(ws + (lat ? WS_VTA_L : WS_VTA_C)) + (size_t)b * 512 * TL;
            epi_store_T(acc, 0, vb, TL, (pn - 4) * 256, t0, 1.f, wr, wc, fr, fq); epi_store_T(acc, 1, vb, TL, (pn - 4) * 256, t0, 1.f, wr, wc, fr, fq);
        } else if (pn == 8) {
            epi_store_R(acc, 0, (bf16*)(ws + WS_BK) + (size_t)r0 * 128, 128, 0, 1.f, lat, t0, cosT, sinT, wr, wc, fr, fq);
            epi_store_T(acc, 1, (bf16*)(ws + (lat ? WS_VTB_L : WS_VTB_C)) + (size_t)b * 128 * TL, TL, -128, t0, 1.f, wr, wc, fr, fq);
        } else {
            const size_t off = (pn < 2) ? WS_AQ : (pn < 4) ? WS_AK : WS_BQ;
            bf16* dst = (bf16*)(ws + off); const int cb = (pn & 1) * 256; const float sc = (pn < 2 || pn >= 6) ? QSCALE : 1.f;
            epi_store_R(acc, 0, dst + (size_t)r0 * 512, 512, cb, sc, lat, t0, cosT, sinT, wr, wc, fr, fq); epi_store_R(acc, 1, dst + (size_t)r0 * 512, 512, cb, sc, lat, t0, cosT, sinT, wr, wc, fr, fq);
        }
    }
};

struct EpiRecIn {
    static constexpr bool PERM = false, AFTER_DRAIN = false;
    unsigned char* ws; const float* gate_b;
    __device__ __forceinline__ void operator()(const f32x4 (&acc)[2][2][4][2], const pg8::Unit& u, int wr, int wc, int fr, int fq) const {
        asm volatile("" : "+v"(fr), "+v"(fq));
        const int r0 = u.pm * 256; const bool lat = r0 < ML; const int b = lat ? (r0 >> 12) : ((r0 - ML) >> 8); const int t0 = lat ? (r0 & 4095) : 0;
        const int pn = u.pn; const int TL = lat ? T : TC;
        if (pn == 14) {
            if (wc == 0) {
                const f32x4 gb = *(const f32x4*)(gate_b + 4 * fq);
                const bool isf = (fq & 1) != 0;
#pragma unroll
                for (int ai = 0; ai < 2; ++ai)
#pragma unroll
                    for (int m = 0; m < 4; ++m) { const int rr = ai * 128 + wr * 64 + m * 16 + fr; f32x4 v = acc[ai][0][m][0] + gb;
                        if (isf) {
#pragma unroll
                            for (int e = 0; e < 4; ++e) { const float x = v[e]; v[e] = fminf(x, 0.f) - log1pf(__expf(-fabsf(x))); } }
                        *(f32x4*)((float*)(ws + WS_GATE) + (size_t)(r0 + rr) * 16 + 4 * fq) = v; }
            }
        } else if (pn < 2) { bf16* d0 = (bf16*)(ws + WS_MQ) + (size_t)r0 * 512; epi_store_P<0>(acc, 0, d0, 512, pn * 256, 1.f, wr, wc, fr, fq); epi_store_P<0>(acc, 1, d0, 512, pn * 256, 1.f, wr, wc, fr, fq); }
        else if (pn < 4) { const float sc = 0.08838834764831845f; bf16* d0 = (bf16*)(ws + WS_MK) + (size_t)r0 * 512; bf16* tb = (bf16*)(ws + (lat ? WS_MKT_L : WS_MKT_C)) + (size_t)b * 512 * TL;
#pragma unroll
            for (int bj = 0; bj < 2; ++bj) { epi_store_P<0>(acc, bj, d0, 512, (pn - 2) * 256, sc, wr, wc, fr, fq); epi_store_T(acc, bj, tb, TL, (pn - 2) * 256, t0, sc, wr, wc, fr, fq); } }
        else if (pn < 6) { bf16* tb = (bf16*)(ws + (lat ? WS_MVT_L : WS_MVT_C)) + (size_t)b * 512 * TL; epi_store_T(acc, 0, tb, TL, (pn - 4) * 256, t0, 1.f, wr, wc, fr, fq); epi_store_T(acc, 1, tb, TL, (pn - 4) * 256, t0, 1.f, wr, wc, fr, fq); }
        else if (pn < 8) { bf16* d0 = (bf16*)(ws + WS_MO) + (size_t)r0 * 512; epi_store_P<1>(acc, 0, d0, 512, (pn - 6) * 256, 1.f, wr, wc, fr, fq); epi_store_P<1>(acc, 1, d0, 512, (pn - 6) * 256, 1.f, wr, wc, fr, fq); }
        else if (pn == 8) { bf16* d0 = (bf16*)(ws + WS_RQ) + (size_t)r0 * 256; epi_store_P<0>(acc, 0, d0, 256, 0, 1.f, wr, wc, fr, fq); epi_store_P<0>(acc, 1, d0, 256, 0, 1.f, wr, wc, fr, fq); }
        else if (pn == 9) { bf16* d0 = (bf16*)(ws + WS_RK) + (size_t)r0 * 256; bf16* tb = (bf16*)(ws + (lat ? WS_RKT_L : WS_RKT_C)) + (size_t)b * 256 * TL;
#pragma unroll
            for (int bj = 0; bj < 2; ++bj) { epi_store_P<0>(acc, bj, d0, 256, 0, 0.125f, wr, wc, fr, fq); epi_store_T(acc, bj, tb, TL, 0, t0, 0.125f, wr, wc, fr, fq); } }
        else if (pn < 12) { bf16* tb = (bf16*)(ws + (lat ? WS_RVT_L : WS_RVT_C)) + (size_t)b * 512 * TL; epi_store_T(acc, 0, tb, TL, (pn - 10) * 256, t0, 1.f, wr, wc, fr, fq); epi_store_T(acc, 1, tb, TL, (pn - 10) * 256, t0, 1.f, wr, wc, fr, fq); }
        else { bf16* d0 = (bf16*)(ws + WS_RG) + (size_t)r0 * 512; epi_store_P<2>(acc, 0, d0, 512, (pn - 12) * 256, 1.f, wr, wc, fr, fq); epi_store_P<2>(acc, 1, d0, 512, (pn - 12) * 256, 1.f, wr, wc, fr, fq); }
    }
};
struct Args { const float* in[22]; float* out; unsigned char* ws; int ph_lo, ph_hi; };
enum { I_X = 0, I_C, I_CTX, I_CCTX, I_ADAW, I_ADAB, I_LNG, I_LNB, I_FWI, I_FWO, I_AWI, I_AWO, I_DLAM, I_DNG, I_SINK, I_RWI, I_RWO, I_MGB, I_MNG, I_RDL, I_RNG, I_RNB };

__device__ __forceinline__ void tr_item(const float* W, int ldw, int k0, int c0, int nvalid, bf16* WT, int K, int r0, LAS float* scr, int lane) {
    const int col = lane & 31;
#pragma unroll 8
    for (int i = 0; i < 32; ++i) { const int kk = 2 * i + (lane >> 5); scr[kk * 33 + col] = (col < nvalid) ? W[(size_t)(k0 + kk) * ldw + c0 + col] : 0.f; }
    LDS_WAIT(); asm volatile("" ::: "memory");
    const int c = lane & 7;
#pragma unroll
    for (int j = 0; j < 4; ++j) { const int n = (lane >> 3) + 8 * j; const LAS float* s = scr + (8 * c) * 33 + n;
        v4u o; o.x = pk2(s[0 * 33], s[1 * 33]); o.y = pk2(s[2 * 33], s[3 * 33]); o.z = pk2(s[4 * 33], s[5 * 33]); o.w = pk2(s[6 * 33], s[7 * 33]);
        *(v4u*)(WT + (size_t)(r0 + n) * K + k0 + 8 * c) = o; }
    LDS_WAIT(); asm volatile("" ::: "memory");
}

__device__ __forceinline__ void p0a_prologue(const Args& a, LAS unsigned char* lds, int G, int vcu, int tid, int lane, int wave) {
    unsigned char* ws = a.ws;
    LAS float* scr = (LAS float*)(lds + wave * 8448);
    const int gw = vcu * NWAVES + wave, NGW = G * NWAVES;
    constexpr int I_FI = 16 * 176, I_FO = 44 * 32, I_AI = 16 * 72, I_AO = 16 * 32, I_RI = 16 * 120, I_RO = 16 * 32;
    constexpr int NITEMS = 4 * I_FI + 4 * I_FO + I_AI + I_AO + I_RI + I_RO;
    for (int it = gw; it < NITEMS; it += NGW) {
        int r = it;
        if (r < 4 * I_FI) { const int mi = r / I_FI; r -= mi * I_FI; const int kb = r / 176, nb = r % 176, pn = nb >> 3, q = nb & 7;
            const int c0 = (q < 4) ? (128 * pn + 32 * q) : (FF + 128 * pn + 32 * (q - 4));
            tr_item(a.in[I_FWI] + (size_t)mi * D * N_FI, N_FI, 64 * kb, c0, 32, (bf16*)(ws + WS_WFI) + (size_t)mi * N_FI * D, D, 32 * nb, scr, lane); continue; }
        r -= 4 * I_FI;
        if (r < 4 * I_FO) { const int mi = r / I_FO; r -= mi * I_FO; const int kb = r / 32, nb = r % 32;
            tr_item(a.in[I_FWO] + (size_t)mi * FF * D, D, 64 * kb, 32 * nb, 32, (bf16*)(ws + WS_WFO) + (size_t)mi * D * FF, FF, 32 * nb, scr, lane); continue; }
        r -= 4 * I_FO;
        if (r < I_AI) { const int kb = r / 72, nb = r % 72; tr_item(a.in[I_AWI], N_AI, 64 * kb, 32 * nb, 32, (bf16*)(ws + WS_WAI), D, 32 * nb, scr, lane); continue; }
        r -= I_AI;
        if (r < I_AO) { const int kb = r / 32, nb = r % 32; tr_item(a.in[I_AWO], D, 64 * kb, 32 * nb, 32, (bf16*)(ws + WS_WAO), D, 32 * nb, scr, lane); continue; }
        r -= I_AO;
        if (r < I_RI) { const int kb = r / 120, nb = r % 120, n0 = 32 * nb; int c0, nv;
            if (n0 < 2048) { c0 = n0; nv = 32; } else if (n0 < 3584) { c0 = n0 + 16; nv = 32; } else if (n0 == 3584) { c0 = 2048; nv = 16; } else { c0 = 0; nv = 0; }
            tr_item(a.in[I_RWI], N_RI_SRC, 64 * kb, c0, nv, (bf16*)(ws + WS_WRI), D, n0, scr, lane); continue; }
        r -= I_RI;
        { const int kb = r / 32, nb = r % 32; tr_item(a.in[I_RWO], D, 64 * kb, 32 * nb, 32, (bf16*)(ws + WS_WRO), D, 32 * nb, scr, lane); }
    }
    __syncthreads();
    {
        LAS float* sc = (LAS float*)lds;
        LAS float* red = (LAS float*)(lds + 36864);
        float* MOD = (float*)(ws + WS_MOD);
        if (blockIdx.x < 288) {
            for (int idx = tid; idx < 9216; idx += 512) { const int r = idx >> 10, k = idx & 1023; const float cv = (r < 8) ? a.in[I_C][r * 1024 + k] : a.in[I_CCTX][k]; sc[idx] = silu_f(cv); }
        }
        __syncthreads();
        for (int u = blockIdx.x; u < 288; u += G) {
            const int l = u / 144, ng = u % 144, n = 64 * ng + lane;
            const float* W = a.in[I_ADAW] + (size_t)l * D * 9216 + n;
            float acc[9];
#pragma unroll
            for (int r = 0; r < 9; ++r) acc[r] = 0.f;
#pragma unroll 8
            for (int kk = 0; kk < 128; ++kk) { const int k = wave * 128 + kk; const float wv = W[(size_t)k * 9216];
#pragma unroll
                for (int r = 0; r < 9; ++r) acc[r] += sc[r * 1024 + k] * wv; }
#pragma unroll
            for (int r = 0; r < 9; ++r) red[(wave * 9 + r) * 64 + lane] = acc[r];
            __syncthreads();
            for (int idx = tid; idx < 576; idx += 512) { const int r = idx >> 6, ln = idx & 63; float s = 0.f;
#pragma unroll
                for (int w = 0; w < 8; ++w) s += red[(w * 9 + r) * 64 + ln];
                MOD[(size_t)(l * 9 + r) * 9216 + 64 * ng + ln] = s + a.in[I_ADAB][l * 9216 + 64 * ng + ln]; }
            __syncthreads();
        }
    }
    if (blockIdx.x == 0) {
        float* cosT = (float*)(ws + WS_ROPE); float* sinT = cosT + 1024;
        for (int idx = tid; idx < 1024; idx += 512) { const int pos = idx >> 4, f = idx & 15; const float inv = powf(10000.0f, -(float)f / 16.0f); const float ang = (float)pos * inv;
            cosT[idx] = cosf(ang); sinT[idx] = sinf(ang); }
        if (wave == 0) { const float* dl = a.in[I_DLAM]; const float s1 = wave_sum(dl[lane] * dl[64 + lane]), s2 = wave_sum(dl[128 + lane] * dl[192 + lane]);
            if (lane == 0) *(float*)(ws + WS_LAM) = expf(s1) - expf(s2) + 0.2f; }
    }
}

__device__ __forceinline__ void p0b_modulate(const Args& a, int gw, int NGW, int lane) {
    const float* MOD = (const float*)(a.ws + WS_MOD); bf16* H = (bf16*)(a.ws + WS_H);
    for (int r = gw; r < M; r += NGW) {
        const float* xr = (r < ML) ? a.in[I_X] + (size_t)r * D : a.in[I_CTX] + (size_t)(r - ML) * D;
        const float* mp = MOD + (size_t)((r < ML) ? (r >> 12) : 8) * 9216;
#pragma unroll
        for (int j = 0; j < 4; ++j) { const int c = 4 * (lane + 64 * j); const f32x4 x = *(const f32x4*)(xr + c), sh = *(const f32x4*)(mp + c), sc = *(const f32x4*)(mp + 1024 + c);
            *(u32x2*)(H + (size_t)r * D + c) = pack4c(x * (sc + 1.0f) + sh); }
    }
}

__device__ __forceinline__ void ln_phase(float* out_l, float* out_c, const float* g, const float* bt, const float* modn, bf16* H, int nrows, int gw, int NGW, int lane) {
    f32x4 g4[4], b4[4];
#pragma unroll
    for (int j = 0; j < 4; ++j) { g4[j] = *(const f32x4*)(g + 4 * (lane + 64 * j)); b4[j] = *(const f32x4*)(bt + 4 * (lane + 64 * j)); }
    for (int r = gw; r < nrows; r += NGW) {
        float* zr = (r < ML) ? out_l + (size_t)r * D : out_c + (size_t)(r - ML) * D;
        f32x4 v[4]; float s = 0.f;
#pragma unroll
        for (int j = 0; j < 4; ++j) { v[j] = *(const f32x4*)(zr + 4 * (lane + 64 * j)); s += (v[j][0] + v[j][1]) + (v[j][2] + v[j][3]); }
        const float mean = wave_sum(s) * (1.f / D); float s2 = 0.f;
#pragma unroll
        for (int j = 0; j < 4; ++j) { v[j] = v[j] - mean; s2 += (v[j][0] * v[j][0] + v[j][1] * v[j][1]) + (v[j][2] * v[j][2] + v[j][3] * v[j][3]); }
        const float rstd = 1.0f / sqrtf(wave_sum(s2) * (1.f / D) + 1e-5f);
        const float* mp = modn ? modn + (size_t)((r < ML) ? (r >> 12) : 8) * 9216 : nullptr;
#pragma unroll
        for (int j = 0; j < 4; ++j) { const int c = 4 * (lane + 64 * j); const f32x4 y = v[j] * rstd * g4[j] + b4[j]; *(f32x4*)(zr + c) = y;
            if (mp) { const f32x4 sh = *(const f32x4*)(mp + c), sc = *(const f32x4*)(mp + 1024 + c); *(u32x2*)(H + (size_t)r * D + c) = pack4c(y * (sc + 1.0f) + sh); } }
    }
}
template <int NDV> struct AttW { f32x16 o[NDV]; float m, l; };

template <int NDV, bool MASK, int KPB>
__device__ __forceinline__ void attn_block_lds(AttW<NDV>& S, const bf16x8 (&qf)[4], LAS const unsigned char* Kl, LAS const unsigned char* Vl, int r, int h, int qpos, int kpos0) {
    f32x16 st;
#pragma unroll
    for (int i = 0; i < 16; ++i) st[i] = 0.f;
#pragma unroll
    for (int s = 0; s < 4; ++s) { const bf16x8 kf = *(LAS const bf16x8*)(Kl + r * KPB + 32 * s + 16 * h); st = mfma32(kf, qf[s], st); }
    if (MASK) {
#pragma unroll
        for (int i = 0; i < 16; ++i) { const int dlt = qpos - (kpos0 + crow(i, h)); if (dlt > 128 || dlt < -128) st[i] = -INFINITY; }
    }
    float mx = st[0];
#pragma unroll
    for (int i = 1; i < 16; ++i) mx = fmaxf(mx, st[i]);
    mx = fmaxf(mx, __shfl_xor(mx, 32));
    const float mn = fmaxf(S.m, mx), alpha = fexp2(S.m - mn);
    const bool same = (mn == S.m);
    S.m = mn;
    float ps = 0.f;
#pragma unroll
    for (int i = 0; i < 16; ++i) { st[i] = fexp2(st[i] - mn); ps += st[i]; }
    S.l = S.l * alpha + ps;
    if (!__all(same)) {
#pragma unroll
        for (int d = 0; d < NDV; ++d) S.o[d] = S.o[d] * alpha;
    }
    bf16x8 pf[2];
#pragma unroll
    for (int s2 = 0; s2 < 2; ++s2) { v4u w; w.x = cvtpk(st[8 * s2 + 0], st[8 * s2 + 1]); w.y = cvtpk(st[8 * s2 + 2], st[8 * s2 + 3]); w.z = cvtpk(st[8 * s2 + 4], st[8 * s2 + 5]); w.w = cvtpk(st[8 * s2 + 6], st[8 * s2 + 7]);
        pf[s2] = __builtin_bit_cast(bf16x8, w); }
#pragma unroll
    for (int s2 = 0; s2 < 2; ++s2)
#pragma unroll
        for (int d = 0; d < NDV; ++d) { LAS const unsigned char* vp = Vl + (32 * d + r) * 136 + 32 * s2 + 8 * h;
            const u32x2 lo = *(LAS const u32x2*)vp, hi = *(LAS const u32x2*)(vp + 16); v4u w; w.x = lo.x; w.y = lo.y; w.z = hi.x; w.w = hi.y;
            S.o[d] = mfma32(__builtin_bit_cast(bf16x8, w), pf[s2], S.o[d]); }
}

__device__ __forceinline__ void load_q(bf16x8 (&qf)[4], const bf16* Qp, int pitch, int r, int h) {
#pragma unroll
    for (int s = 0; s < 4; ++s) qf[s] = ldg16(Qp + (size_t)r * pitch + 16 * s + 8 * h);
}

template <bool DIFF> struct AttStage { v4u k[DIFF ? 2 : 1]; v4u v[DIFF ? 2 : 1]; };
template <bool DIFF>
__device__ __forceinline__ void att_gload(AttStage<DIFF>& R, const bf16* Kg, int kpitch, const bf16* Vg, int vpitch, int tid) {
    constexpr int NC = DIFF ? 2 : 1, KCH = DIFF ? 16 : 8;
#pragma unroll
    for (int i = 0; i < NC; ++i) { const int id = tid + 512 * i; R.k[i] = *(const v4u*)(Kg + (size_t)(id / KCH) * kpitch + (id % KCH) * 8); R.v[i] = *(const v4u*)(Vg + (size_t)(id >> 3) * vpitch + (id & 7) * 8); }
}
template <bool DIFF>
__device__ __forceinline__ void att_lstore(const AttStage<DIFF>& R, LAS unsigned char* Kl, LAS unsigned char* Vl, int tid) {
    constexpr int NC = DIFF ? 2 : 1, KCH = DIFF ? 16 : 8, KPB = DIFF ? 272 : 144;
#pragma unroll
    for (int i = 0; i < NC; ++i) { const int id = tid + 512 * i;
        *(LAS v4u*)(Kl + (id / KCH) * KPB + (id % KCH) * 16) = R.k[i];
        LAS unsigned char* vp = Vl + (id >> 3) * 136 + (id & 7) * 16;
        u32x2 a, b; a.x = R.v[i].x; a.y = R.v[i].y; b.x = R.v[i].z; b.y = R.v[i].w; *(LAS u32x2*)vp = a; *(LAS u32x2*)(vp + 8) = b; }
}

constexpr int ATT_UNITS = 2176;
constexpr int ATT_KB_D = 64 * 272, ATT_VB_D = 128 * 136, ATT_ST_D = ATT_KB_D + ATT_VB_D;
constexpr int ATT_KB_W = 64 * 144, ATT_VB_W = 64 * 136, ATT_ST_W = ATT_KB_W + ATT_VB_W;
__device__ __forceinline__ void attn_phase(const Args& a, LAS unsigned char* lds, int G, int vcu, int tid, int lane, int wave) {
    unsigned char* ws = a.ws;
    const bf16* AQ = (const bf16*)(ws + WS_AQ); const bf16* AK = (const bf16*)(ws + WS_AK); const bf16* BQ = (const bf16*)(ws + WS_BQ); const bf16* BK = (const bf16*)(ws + WS_BK);
    const bf16* VTA_L = (const bf16*)(ws + WS_VTA_L); const bf16* VTA_C = (const bf16*)(ws + WS_VTA_C); const bf16* VTB_L = (const bf16*)(ws + WS_VTB_L); const bf16* VTB_C = (const bf16*)(ws + WS_VTB_C);
    bf16* O = (bf16*)(ws + WS_H);
    const int r = lane & 31, h = lane >> 5;
    LAS float* X = (LAS float*)lds;
    for (int u = vcu; u < ATT_UNITS; u += G) {
        const bool isdiff = (u < 1024) || (u >= 2048 && u < 2112);
        if (isdiff) {
            const bool lat = u < 1024; const int uu = lat ? u : u - 2048;
            const int bh = lat ? (uu >> 5) : (uu >> 1), qb = lat ? (uu & 31) : (uu & 1), b = bh >> 2, hd = bh & 3;
            const int sub = wave & 1, qs = wave >> 1;
            const int qrow0 = (lat ? b * T : ML + b * TC) + qb * 128 + qs * 32;
            bf16x8 qf[4]; load_q(qf, AQ + (size_t)qrow0 * 512 + hd * 128 + sub * 64, 512, r, h);
            AttW<4> S;
#pragma unroll
            for (int d = 0; d < 4; ++d)
#pragma unroll
                for (int i = 0; i < 16; ++i) S.o[d][i] = 0.f;
            S.m = -1e30f; S.l = 0.f;
            const int NTL = lat ? T / 64 : 0, NT = NTL + TC / 64;
            const bf16* KL = AK + (size_t)(b * T) * 512 + hd * 128; const bf16* KC = AK + (size_t)(ML + b * TC) * 512 + hd * 128;
            const bf16* VL = VTA_L + (size_t)(b * 4 + hd) * 128 * T; const bf16* VC = VTA_C + (size_t)(b * 4 + hd) * 128 * TC;
            AttStage<true> R;
            { const bool c0 = NTL == 0; att_gload<true>(R, c0 ? KC : KL, 512, c0 ? VC : VL, c0 ? TC : T, tid); att_lstore<true>(R, lds, lds + ATT_KB_D, tid); }
            __syncthreads();
            for (int t = 0; t < NT; ++t) {
                const int tn = t + 1;
                if (tn < NT) { const bool c = tn >= NTL; const int tt = c ? tn - NTL : tn; att_gload<true>(R, (c ? KC : KL) + (size_t)tt * 64 * 512, 512, (c ? VC : VL) + tt * 64, c ? TC : T, tid); }
                LAS const unsigned char* Kl = lds + (t & 1) * ATT_ST_D + sub * 128; LAS const unsigned char* Vl = lds + (t & 1) * ATT_ST_D + ATT_KB_D;
                attn_block_lds<4, false, 272>(S, qf, Kl, Vl, r, h, 0, 0);
                attn_block_lds<4, false, 272>(S, qf, Kl + 32 * 272, Vl + 64, r, h, 0, 0);
                if (tn < NT) att_lstore<true>(R, lds + (tn & 1) * ATT_ST_D, lds + (tn & 1) * ATT_ST_D + ATT_KB_D, tid);
                __syncthreads();
            }
            const float lt = S.l + __shfl_xor(S.l, 32); const float inv = 1.0f / lt;
            if (sub == 1) { const float lam = *(const float*)(ws + WS_LAM); const float f = inv * lam;
#pragma unroll
                for (int d = 0; d < 4; ++d)
#pragma unroll
                    for (int i = 0; i < 16; ++i) X[(qs * 128 + 32 * d + crow(i, h)) * 32 + r] = S.o[d][i] * f; }
            __syncthreads();
            if (sub == 0) { float ss = 0.f;
#pragma unroll
                for (int d = 0; d < 4; ++d)
#pragma unroll
                    for (int i = 0; i < 16; ++i) { const float v = S.o[d][i] * inv - X[(qs * 128 + 32 * d + crow(i, h)) * 32 + r]; S.o[d][i] = v; ss += v * v; }
                ss += __shfl_xor(ss, 32);
                const float rs = 0.8f / sqrtf(ss * (1.0f / 128.0f) + 1e-5f);
                const float* gn = a.in[I_DNG];
                bf16* op = O + (size_t)(qrow0 + r) * D + hd * 128;
#pragma unroll
                for (int d = 0; d < 4; ++d)
#pragma unroll
                    for (int k4 = 0; k4 < 4; ++k4) { const int dv = 32 * d + 8 * k4 + 4 * h; const f32x4 g4 = *(const f32x4*)(gn + dv);
                        f32x4 v; v[0] = S.o[d][4 * k4] * rs * g4[0]; v[1] = S.o[d][4 * k4 + 1] * rs * g4[1]; v[2] = S.o[d][4 * k4 + 2] * rs * g4[2]; v[3] = S.o[d][4 * k4 + 3] * rs * g4[3];
                        *(u32x2*)(op + dv) = pack4c(v); }
            }
            __syncthreads();
        } else {
            const bool lat = u < 2048; const int uu = lat ? u - 1024 : u - 2112;
            const int bk = lat ? (uu >> 6) : (uu >> 2), qb = lat ? (uu & 63) : (uu & 3), b = bk >> 1, kvh = bk & 1;
            const int g4i = wave >> 1, qs = wave & 1, hd = kvh * 4 + g4i;
            const int t0 = qb * 64 + qs * 32;
            const int qrow0 = (lat ? b * T : ML + b * TC) + t0;
            bf16x8 qf[4]; load_q(qf, BQ + (size_t)qrow0 * 512 + hd * 64, 512, r, h);
            AttW<2> S;
#pragma unroll
            for (int d = 0; d < 2; ++d)
#pragma unroll
                for (int i = 0; i < 16; ++i) S.o[d][i] = 0.f;
            S.m = a.in[I_SINK][hd] * LOG2E; S.l = (h == 0) ? 1.0f : 0.0f;
            const int lo = lat ? ((qb * 64 - 128) < 0 ? 0 : (qb * 64 - 128)) : 0, hi = lat ? ((qb * 64 + 192) > T ? T : (qb * 64 + 192)) : 0;
            const int NTL = (hi - lo) / 64, NT = NTL + TC / 64;
            const bf16* KL = BK + (size_t)(b * T + lo) * 128 + kvh * 64; const bf16* KC = BK + (size_t)(ML + b * TC) * 128 + kvh * 64;
            const bf16* VL = VTB_L + (size_t)(b * 2 + kvh) * 64 * T + lo; const bf16* VC = VTB_C + (size_t)(b * 2 + kvh) * 64 * TC;
            AttStage<false> R;
            { const bool c0 = NTL == 0; att_gload<false>(R, c0 ? KC : KL, 128, c0 ? VC : VL, c0 ? TC : T, tid); att_lstore<false>(R, lds, lds + ATT_KB_W, tid); }
            __syncthreads();
            for (int t = 0; t < NT; ++t) {
                const int tn = t + 1;
                if (tn < NT) { const bool c = tn >= NTL; const int tt = c ? tn - NTL : tn; att_gload<false>(R, (c ? KC : KL) + (size_t)tt * 64 * 128, 128, (c ? VC : VL) + tt * 64, c ? TC : T, tid); }
                LAS const unsigned char* Kl = lds + (t & 1) * ATT_ST_W; LAS const unsigned char* Vl = lds + (t & 1) * ATT_ST_W + ATT_KB_W;
                if (t < NTL) { const int kp = lo + t * 64;
                    attn_block_lds<2, true, 144>(S, qf, Kl, Vl, r, h, t0 + r, kp);
                    attn_block_lds<2, true, 144>(S, qf, Kl + 32 * 144, Vl + 64, r, h, t0 + r, kp + 32);
                } else {
                    attn_block_lds<2, false, 144>(S, qf, Kl, Vl, r, h, 0, 0);
                    attn_block_lds<2, false, 144>(S, qf, Kl + 32 * 144, Vl + 64, r, h, 0, 0);
                }
                if (tn < NT) att_lstore<false>(R, lds + (tn & 1) * ATT_ST_W, lds + (tn & 1) * ATT_ST_W + ATT_KB_W, tid);
                __syncthreads();
            }
            const float lt = S.l + __shfl_xor(S.l, 32); const float inv = 1.0f / lt;
            bf16* op = O + (size_t)(qrow0 + r) * D + 512 + hd * 64;
#pragma unroll
            for (int d = 0; d < 2; ++d)
#pragma unroll
                for (int k4 = 0; k4 < 4; ++k4) { const int dv = 32 * d + 8 * k4 + 4 * h;
                    f32x4 v; v[0] = S.o[d][4 * k4] * inv; v[1] = S.o[d][4 * k4 + 1] * inv; v[2] = S.o[d][4 * k4 + 2] * inv; v[3] = S.o[d][4 * k4 + 3] * inv;
                    *(u32x2*)(op + dv) = pack4c(v); }
        }
    }
}
constexpr int SC_CT = 0;
constexpr int SC_S = 39168;
constexpr int SC_SA = SC_S + 8 * 4352;
constexpr int SC_SB = SC_SA + 4352 * 4;
constexpr int SC_SG = SC_SB + 4352 * 4;
constexpr int SC_CH = SC_SG + 4352 * 4;
static_assert(SC_CH + 4 * 128 <= RING_BYTES, "scan LDS");

template <int DK, bool MLSTM>
__device__ __forceinline__ void scan_chain(const Args& a, LAS unsigned char* lds, int b, int hd, int dir, int tid, int lane, int wave) {
    unsigned char* ws = a.ws;
    constexpr int KS = DK / 32, CTP = DK + 8, NDVT = MLSTM ? 9 : 8, NOWN = MLSTM ? 9 : 4;
    const int c = lane & 15, g = lane >> 4;
    const bf16* Qr = MLSTM ? (const bf16*)(ws + WS_MQ) + hd * 128 : (const bf16*)(ws + WS_RQ) + hd * 64;
    const bf16* Kr = MLSTM ? (const bf16*)(ws + WS_MK) + hd * 128 : (const bf16*)(ws + WS_RK) + hd * 64;
    constexpr int RP = MLSTM ? 512 : 256;
    const bf16* KtL = MLSTM ? (const bf16*)(ws + WS_MKT_L) + (size_t)(b * 4 + hd) * 128 * T : (const bf16*)(ws + WS_RKT_L) + (size_t)(b * 4 + hd) * 64 * T;
    const bf16* KtC = MLSTM ? (const bf16*)(ws + WS_MKT_C) + (size_t)(b * 4 + hd) * 128 * TC : (const bf16*)(ws + WS_RKT_C) + (size_t)(b * 4 + hd) * 64 * TC;
    const bf16* VtL = MLSTM ? (const bf16*)(ws + WS_MVT_L) + (size_t)(b * 4 + hd) * 128 * T : (const bf16*)(ws + WS_RVT_L) + (size_t)(b * 4 + hd) * 128 * T;
    const bf16* VtC = MLSTM ? (const bf16*)(ws + WS_MVT_C) + (size_t)(b * 4 + hd) * 128 * TC : (const bf16*)(ws + WS_RVT_C) + (size_t)(b * 4 + hd) * 128 * TC;
    bf16* OUT = (bf16*)(ws + (dir == 0 ? WS_H : WS_HB)) + (MLSTM ? hd * 128 : 512 + hd * 128);
    LAS bf16* CT = (LAS bf16*)(lds + SC_CT);
    LAS bf16* Sw = (LAS bf16*)(lds + SC_S + wave * 4352);
    LAS float* sa = (LAS float*)(lds + SC_SA); LAS float* sb = (LAS float*)(lds + SC_SB); LAS float* sg = (LAS float*)(lds + SC_SG);
    LAS float* mch = (LAS float*)(lds + SC_CH); LAS float* bend = mch + 36; LAS float* gend = bend + 34;
    const bool fwd = dir == 0;
    for (int i = tid; i < 144 * CTP / 2; i += 512) ((LAS unsigned*)CT)[i] = 0u;
    float lg = 0.f;
    if (MLSTM) {
        const float* GATE = (const float*)(ws + WS_GATE);
        for (int ci = wave; ci < 34; ci += 8) {
            const int rowb = (ci < 2) ? (ML + b * TC + ci * 128) : (b * T + (ci - 2) * 128), pb = ci * 128;
            const int u0 = 2 * lane, u1 = 2 * lane + 1, i0 = fwd ? u0 : 127 - u0, i1 = fwd ? u1 : 127 - u1;
            const float f0 = GATE[(size_t)(rowb + i0) * 16 + dir * 8 + 4 + hd], f1 = GATE[(size_t)(rowb + i1) * 16 + dir * 8 + 4 + hd];
            const float p0 = GATE[(size_t)(rowb + i0) * 16 + dir * 8 + hd], p1 = GATE[(size_t)(rowb + i1) * 16 + dir * 8 + hd];
            float s = f0 + f1;
#pragma unroll
            for (int o = 1; o < 64; o <<= 1) { const float t = __shfl_up(s, o); if (lane >= o) s += t; }
            const float b1 = s, b0 = s - f1, a0 = p0 - b0, a1 = p1 - b1;
            float pm = fmaxf(a0, a1);
#pragma unroll
            for (int o = 1; o < 64; o <<= 1) { const float t = __shfl_up(pm, o); if (lane >= o) pm = fmaxf(pm, t); }
            float ex = __shfl_up(pm, 1); if (lane == 0) ex = -INFINITY;
            const float g0 = fmaxf(ex, a0), g1 = pm;
            sa[pb + i0] = a0; sa[pb + i1] = a1; sb[pb + i0] = b0; sb[pb + i1] = b1; sg[pb + i0] = g0; sg[pb + i1] = g1;
            if (lane == 63) { bend[ci] = b1; gend[ci] = g1; }
        }
        __syncthreads();
        if (tid == 0) { float m = 0.f;
            for (int s = 0; s < 34; ++s) { const int ci = fwd ? s : (s < 2 ? 1 - s : 35 - s); mch[s] = m; m = bend[ci] + fmaxf(m, gend[ci]); }
            mch[34] = m; }
    } else {
        const float x = a.in[I_RDL][dir * 4 + hd]; lg = fminf(x, 0.f) - log1pf(__expf(-fabsf(x)));
    }
    __syncthreads();
    const int dkt = MLSTM ? wave : (wave & 3), dv0 = MLSTM ? 0 : 4 * (wave >> 2);
    f32x4 ct[NOWN];
#pragma unroll
    for (int t = 0; t < NOWN; ++t) ct[t] = (f32x4){0.f, 0.f, 0.f, 0.f};
    bf16x8 ones; { const short o1 = (c == 0) ? (short)0x3F80 : (short)0; ones = (bf16x8){o1, o1, o1, o1, o1, o1, o1, o1}; }

    for (int s = 0; s < 34; ++s) {
        const int ci = fwd ? s : (s < 2 ? 1 - s : 35 - s);
        const bool isctx = ci < 2;
        const int rowb = isctx ? (ML + b * TC + ci * 128) : (b * T + (ci - 2) * 128);
        const int pb = ci * 128;
        const int tp = isctx ? TC : T;
        const bf16* Kt = isctx ? KtC + ci * 128 : KtL + (ci - 2) * 128;
        const bf16* Vt = isctx ? VtC + ci * 128 : VtL + (ci - 2) * 128;
        float m_c = 0.f, m_new = 0.f, b_end = 0.f;
        if (MLSTM) { m_c = mch[s]; m_new = mch[s + 1]; b_end = bend[ci]; }
        if (!isctx) {
            const int q = 16 * wave + c;
            bf16x8 qf[KS];
#pragma unroll
            for (int ks = 0; ks < KS; ++ks) qf[ks] = ldg16(Qr + (size_t)(rowb + q) * RP + 32 * ks + 8 * g);
            float gq = 0.f; if (MLSTM) gq = fmaxf(m_c, sg[pb + q]);
#pragma unroll 1
            for (int jt = 0; jt < 8; ++jt) {
                f32x4 acc = (f32x4){0.f, 0.f, 0.f, 0.f};
#pragma unroll
                for (int ks = 0; ks < KS; ++ks) acc = mfma16(ldg16(Kr + (size_t)(rowb + 16 * jt + c) * RP + 32 * ks + 8 * g), qf[ks], acc);
                f32x4 v;
#pragma unroll
                for (int e = 0; e < 4; ++e) { const int j = 16 * jt + 4 * g + e; const bool ok = fwd ? (j <= q) : (j >= q);
                    float dm;
                    if (MLSTM) dm = fexp(sa[pb + j] - gq); else dm = fexp(lg * (float)(fwd ? (q - j) : (j - q)));
                    v[e] = ok ? acc[e] * dm : 0.f; }
                *(LAS u32x2*)(Sw + c * 136 + 16 * jt + 4 * g) = pack4c(v);
            }
            LDS_WAIT();
            f32x4 nt[NDVT];
#pragma unroll
            for (int t = 0; t < NDVT; ++t) nt[t] = (f32x4){0.f, 0.f, 0.f, 0.f};
#pragma unroll 1
            for (int ks2 = 0; ks2 < 4; ++ks2) {
                const bf16x8 sf = *(const LAS bf16x8*)(Sw + c * 136 + 32 * ks2 + 8 * g);
#pragma unroll
                for (int t = 0; t < 8; ++t) nt[t] = mfma16(ldg16(Vt + (size_t)(16 * t + c) * tp + 32 * ks2 + 8 * g), sf, nt[t]);
                if (MLSTM) nt[NDVT - 1] = mfma16(ones, sf, nt[NDVT - 1]);
            }
            const float wi = MLSTM ? fexp(m_c - gq) : fexp(lg * (float)(fwd ? (q + 1) : (128 - q)));
#pragma unroll
            for (int ks = 0; ks < KS; ++ks) {
                const bf16x8 qs = scale8u(qf[ks], wi);
#pragma unroll
                for (int t = 0; t < NDVT; ++t) nt[t] = mfma16(*(const LAS bf16x8*)(CT + (16 * t + c) * CTP + 32 * ks + 8 * g), qs, nt[t]);
            }
            float inv = 1.f;
            if (MLSTM) { const float den = __shfl(nt[NDVT - 1][0], c); const float fl = fexp(-(sb[pb + q] + gq)); inv = 1.0f / fmaxf(fabsf(den), fl); }
            bf16* op = OUT + (size_t)(rowb + q) * D + 4 * g;
#pragma unroll
            for (int t = 0; t < 8; ++t) *(u32x2*)(op + 16 * t) = pack4c(nt[t] * inv);
            __syncthreads();
        }
#if !defined(DBG_NO3)
        const float decay = MLSTM ? fexp(b_end + m_c - m_new) : fexp(lg * 128.0f);
#pragma unroll
        for (int t = 0; t < NOWN; ++t) ct[t] = ct[t] * decay;
#pragma unroll 1
        for (int ks2 = 0; ks2 < 4; ++ks2) {
            f32x4 w0, w1;
#pragma unroll
            for (int e = 0; e < 4; ++e) { const int j0 = 32 * ks2 + 8 * g + e, j1 = j0 + 4;
                if (MLSTM) { w0[e] = fexp(sa[pb + j0] + b_end - m_new); w1[e] = fexp(sa[pb + j1] + b_end - m_new); }
                else { w0[e] = fexp(lg * (float)(fwd ? (127 - j0) : j0)); w1[e] = fexp(lg * (float)(fwd ? (127 - j1) : j1)); } }
            const bf16x8 kf = scale8v(ldg16(Kt + (size_t)(16 * dkt + c) * tp + 32 * ks2 + 8 * g), w0, w1);
#pragma unroll
            for (int t = 0; t < NOWN; ++t) {
                const bool ext = MLSTM && (t == 8);
                const bf16x8 vf = ext ? ones : ldg16(Vt + (size_t)(16 * (dv0 + t) + c) * tp + 32 * ks2 + 8 * g);
                ct[t] = mfma16(kf, vf, ct[t]);
            }
        }
#pragma unroll
        for (int t = 0; t < NOWN; ++t) *(LAS u32x2*)(CT + (16 * (dv0 + t) + c) * CTP + 16 * dkt + 4 * g) = pack4c(ct[t]);
        __syncthreads();
#endif
    }
}

constexpr int SCAN_UNITS = 128;
__device__ __forceinline__ void scan_phase(const Args& a, LAS unsigned char* lds, int G, int tid, int lane, int wave) {
#ifndef DBG_SCAN
#define DBG_SCAN 0
#endif
    for (int u = blockIdx.x; u < SCAN_UNITS; u += G) {
        const int uu = u & 63, b = uu >> 3, hd = (uu >> 1) & 3, dir = uu & 1;
        const bool zero = (DBG_SCAN == 1) || (DBG_SCAN == 2 && u >= 64) || (DBG_SCAN == 3 && u < 64);
        if (zero) { bf16* OUT = (bf16*)(a.ws + (dir == 0 ? WS_H : WS_HB)) + (u < 64 ? hd * 128 : 512 + hd * 128);
            for (int i = tid; i < T * 16; i += 512) { const int row = i >> 4, c8 = (i & 15) * 8; *(v4u*)(OUT + (size_t)(b * T + row) * D + c8) = (v4u){0u, 0u, 0u, 0u}; } }
        else if (u < 64) scan_chain<128, true>(a, lds, b, hd, dir, tid, lane, wave);
        else scan_chain<64, false>(a, lds, b, hd, dir, tid, lane, wave);
        __syncthreads();
    }
}

__device__ __forceinline__ void rec_merge_phase(const Args& a, int gw, int NGW, int lane) {
    unsigned char* ws = a.ws;
    bf16* HF = (bf16*)(ws + WS_H); const bf16* HB = (const bf16*)(ws + WS_HB); const bf16* MO = (const bf16*)(ws + WS_MO); const bf16* RG = (const bf16*)(ws + WS_RG);
    const int col = 16 * lane; const bool ism = lane < 32;
    for (int r = gw; r < ML; r += NGW) {
        const v4u f0 = *(const v4u*)(HF + (size_t)r * D + col), f1 = *(const v4u*)(HF + (size_t)r * D + col + 8), b0 = *(const v4u*)(HB + (size_t)r * D + col), b1 = *(const v4u*)(HB + (size_t)r * D + col + 8);
        const bf16* gp = ism ? MO + (size_t)r * 512 + col : RG + (size_t)r * 512 + (col - 512);
        const v4u g0 = *(const v4u*)gp, g1 = *(const v4u*)(gp + 8);
        float v[16], gt[16];
#pragma unroll
        for (int k = 0; k < 4; ++k) { v[2 * k] = bflo(f0[k]) + bflo(b0[k]); v[2 * k + 1] = bfhi(f0[k]) + bfhi(b0[k]); v[8 + 2 * k] = bflo(f1[k]) + bflo(b1[k]); v[8 + 2 * k + 1] = bfhi(f1[k]) + bfhi(b1[k]);
            gt[2 * k] = bflo(g0[k]); gt[2 * k + 1] = bfhi(g0[k]); gt[8 + 2 * k] = bflo(g1[k]); gt[8 + 2 * k + 1] = bfhi(g1[k]); }
        float s = 0.f;
#pragma unroll
        for (int k = 0; k < 16; ++k) s += v[k];
        s += __shfl_xor(s, 1); s += __shfl_xor(s, 2); s += __shfl_xor(s, 4);
        const float mean = s * (1.0f / 128.0f); float q = 0.f;
#pragma unroll
        for (int k = 0; k < 16; ++k) { v[k] -= mean; q += v[k] * v[k]; }
        q += __shfl_xor(q, 1); q += __shfl_xor(q, 2); q += __shfl_xor(q, 4);
        const float rstd = 1.0f / sqrtf(q * (1.0f / 128.0f) + 1e-5f);
        const float* gn = ism ? a.in[I_MNG] + col : a.in[I_RNG] + (col - 512);
        const float* bn = a.in[I_RNB] + (ism ? 0 : col - 512);
        float o[16];
#pragma unroll
        for (int k = 0; k < 16; ++k) { float y = v[k] * rstd * gn[k]; if (!ism) y += bn[k]; o[k] = y * gt[k]; }
        v4u w0, w1;
#pragma unroll
        for (int k = 0; k < 4; ++k) { w0[k] = cvtpk(o[2 * k], o[2 * k + 1]); w1[k] = cvtpk(o[8 + 2 * k], o[8 + 2 * k + 1]); }
        *(v4u*)(HF + (size_t)r * D + col) = w0; *(v4u*)(HF + (size_t)r * D + col + 8) = w1;
    }
}
typedef const __attribute__((address_space(4))) Args* kargp;
__device__ __forceinline__ Args phase_args() {
    kargp p = (kargp)__builtin_amdgcn_kernarg_segment_ptr(); asm volatile("" : "+s"(p));
    Args la;
#pragma unroll
    for (int i = 0; i < 22; ++i) la.in[i] = p->in[i];
    la.out = p->out; la.ws = p->ws; la.ph_lo = p->ph_lo; la.ph_hi = p->ph_hi; return la;
}
#ifndef PH_MASK
#define PH_MASK 0x7ff
#endif
#define EN(k) (((PH_MASK) >> (k)) & 1)
#ifndef REP_ATT
#define REP_ATT 1
#endif
#ifndef REP_SCAN
#define REP_SCAN 1
#endif
#define PH_LANE() int ptid = threadIdx.x; asm volatile("" : "+v"(ptid)); const int tid = ptid, lane = ptid & 63, wave = __builtin_amdgcn_readfirstlane(ptid >> 6); const int gw = vcu * NWAVES + wave; (void)tid; (void)lane; (void)gw

__global__ void __launch_bounds__(NWAVES * 64, 2) mk_fwd(Args a_unused) {
    extern __shared__ __attribute__((aligned(16))) unsigned char lds_raw[];
    LAS unsigned char* lds = (LAS unsigned char*)lds_raw;
    volatile LAS unsigned* MISC = (volatile LAS unsigned*)(lds + MISC_OFF);
    const int tid = threadIdx.x, lane = tid & 63, wave = __builtin_amdgcn_readfirstlane(tid >> 6);
    const int G = gridDim.x; int vcu; { const int bx = blockIdx.x; vcu = (G % 8 == 0) ? (bx % 8) * (G / 8) + bx / 8 : bx; }
    const int NGW = G * NWAVES;
    for (int u = tid; u < (LDS_BYTES - LDSCTL_OFF) / 4; u += NWAVES * 64) ((LAS unsigned*)(lds + LDSCTL_OFF))[u] = 0u;
    __syncthreads();
    int lo, hi; XcdBarrier bar;
    { const Args pa = phase_args(); PH_LANE(); lo = pa.ph_lo; hi = pa.ph_hi; gu32* ctl = (gu32*)(pa.ws + WS_CTL);
      bar.bar = (unsigned*)(ctl + CW_BAR); bar.x = 0; bar.st = nullptr;
      if (!MK_PER_PHASE) bar = xcd_barrier_post((unsigned*)(ctl + CW_BAR), MISC + 8); }
#define IN(k) (lo <= (k) && (k) < hi)
#define SEAM(k) do { if (IN(k) && IN((k) + 1)) { if (MK_PER_PHASE) { if (tid == 0) __hip_atomic_store((gu32*)bar.bar - CW_BAR + CW_TMO, 0xBADBA0u, RLX_AGENT); } else xcd_barrier(bar); } } while (0)
    int kD = D, kFF = FF; asm volatile("" : "+s"(kD), "+s"(kFF));

    if (EN(0) && IN(0)) { const Args pa = phase_args(); PH_LANE(); p0a_prologue(pa, lds, G, vcu, tid, lane, wave); } SEAM(0);
    if (EN(1) && IN(1)) { const Args pa = phase_args(); PH_LANE(); p0b_modulate(pa, gw, NGW, lane); } SEAM(1);

    for (int l = 0; l < 2; ++l) {
        const int pb = 2 + 11 * l;
        const int rows_post = (l == 0) ? M : ML;
#pragma unroll
        for (int j = 0; j < 2; ++j) {
            const int p0 = pb + (j == 0 ? 0 : 8);
            const int rows = (j == 0) ? M : rows_post;
            if (EN(2) && IN(p0)) {
                const Args pa = phase_args(); PH_LANE(); unsigned char* ws = pa.ws;
                pg8::Gemm g{(const bf16*)(ws + WS_H), (const bf16*)(ws + WS_WFI) + (size_t)(l * 2 + j) * N_FI * D, rows, N_FI, kD}; pg8::StaticOrder S; S.init(rows, N_FI, G, (int)blockIdx.x);
                EpiSwiglu E{(bf16*)(ws + WS_ACT)};
                pg8::gemm_phase<EpiSwiglu, pg8::StaticOrder, true, true>(lds, g, S, E);
            }
            SEAM(p0);
            if (EN(3) && IN(p0 + 1)) {
                const Args pa = phase_args(); PH_LANE(); unsigned char* ws = pa.ws;
                const int s = (j == 0) ? 0 : 2;
                pg8::Gemm g{(const bf16*)(ws + WS_ACT), (const bf16*)(ws + WS_WFO) + (size_t)(l * 2 + j) * D * FF, rows, D, kFF}; pg8::StaticOrder S; S.init(rows, D, G, (int)blockIdx.x);
                const bool first = (l == 0 && j == 0);
                float* XC = (float*)(ws + WS_XC);
                EpiResid E{first ? pa.in[I_X] : pa.out, first ? pa.in[I_CTX] : XC, pa.out, XC, (const float*)(ws + WS_MOD) + (size_t)l * 9 * 9216 + (s * 3 + 2) * 1024, 0.5f};
                pg8::gemm_phase<EpiResid, pg8::StaticOrder, true, true>(lds, g, S, E);
            }
            SEAM(p0 + 1);
            if (EN(4) && IN(p0 + 2)) {
                const Args pa = phase_args(); PH_LANE(); unsigned char* ws = pa.ws;
                const int s = (j == 0) ? 0 : 2;
                const float* MOD = (const float*)(ws + WS_MOD);
                const float* modn = nullptr;
                if (j == 0) modn = MOD + (size_t)l * 9 * 9216 + (1 * 3) * 1024; else if (l == 0) modn = MOD + (size_t)1 * 9 * 9216;
                ln_phase(pa.out, (float*)(ws + WS_XC), pa.in[I_LNG] + (l * 3 + s) * D, pa.in[I_LNB] + (l * 3 + s) * D, modn, (bf16*)(ws + WS_H), rows, gw, NGW, lane);
            }
            if (!(l == 1 && j == 1)) SEAM(p0 + 2);
            if (j == 0) {
                if (IN(pb + 3)) {
                    if (EN(5) && l == 0) {
                        const Args pa = phase_args(); PH_LANE(); unsigned char* ws = pa.ws;
                        pg8::Gemm g{(const bf16*)(ws + WS_H), (const bf16*)(ws + WS_WAI), M, N_AI, kD}; pg8::StaticOrder S; S.init(M, N_AI, G, (int)blockIdx.x);
                        EpiAttnIn E{ws};
                        pg8::gemm_phase<EpiAttnIn, pg8::StaticOrder, true, true>(lds, g, S, E);
                    }
                    if (EN(6) && l == 1) {
                        const Args pa = phase_args(); PH_LANE(); unsigned char* ws = pa.ws;
                        pg8::Gemm g{(const bf16*)(ws + WS_H), (const bf16*)(ws + WS_WRI), M, N_RI, kD}; pg8::StaticOrder S; S.init(M, N_RI, G, (int)blockIdx.x);
                        EpiRecIn E{ws, pa.in[I_MGB]};
                        pg8::gemm_phase<EpiRecIn, pg8::StaticOrder, true, true>(lds, g, S, E);
                    }
                }
                SEAM(pb + 3);
                if (IN(pb + 4)) {
                    if (EN(7) && l == 0) { for (int rep = 0; rep < REP_ATT; ++rep) { const Args pa = phase_args(); PH_LANE(); attn_phase(pa, lds, G, vcu, tid, lane, wave); __syncthreads(); } }
                    if (EN(8) && l == 1) { for (int rep = 0; rep < REP_SCAN; ++rep) { const Args pa = phase_args(); PH_LANE(); scan_phase(pa, lds, G, tid, lane, wave); __syncthreads(); } }
                }
                SEAM(pb + 4);
                if (EN(9) && IN(pb + 5)) { if (l == 1) { const Args pa = phase_args(); PH_LANE(); rec_merge_phase(pa, gw, NGW, lane); } }
                SEAM(pb + 5);
                if (EN(10) && IN(pb + 6)) {
                    const Args pa = phase_args(); PH_LANE(); unsigned char* ws = pa.ws;
                    pg8::Gemm g{(const bf16*)(ws + WS_H), (const bf16*)(ws + (l == 0 ? WS_WAO : WS_WRO)), rows_post, D, kD}; pg8::StaticOrder S; S.init(rows_post, D, G, (int)blockIdx.x);
                    float* XC = (float*)(ws + WS_XC);
                    EpiResid E{pa.out, XC, pa.out, XC, (const float*)(ws + WS_MOD) + (size_t)l * 9 * 9216 + (1 * 3 + 2) * 1024, 1.0f};
                    pg8::gemm_phase<EpiResid, pg8::StaticOrder, true, true>(lds, g, S, E);
                }
                SEAM(pb + 6);
                if (EN(4) && IN(pb + 7)) {
                    const Args pa = phase_args(); PH_LANE(); unsigned char* ws = pa.ws;
                    ln_phase(pa.out, (float*)(ws + WS_XC), pa.in[I_LNG] + (l * 3 + 1) * D, pa.in[I_LNB] + (l * 3 + 1) * D, (const float*)(ws + WS_MOD) + (size_t)l * 9 * 9216 + (2 * 3) * 1024, (bf16*)(ws + WS_H), rows_post, gw, NGW, lane);
                }
                SEAM(pb + 7);
            }
        }
    }
#undef IN
#undef SEAM
}

#ifdef DBG_DUMP
__global__ void dbg_dump(const unsigned short* A, const unsigned short* B, const unsigned short* C, size_t n, float* out) {
    const size_t i = (size_t)blockIdx.x * 256 + threadIdx.x;
    float v = 0.f;
    if (i < n) { if (A) v += __uint_as_float(((unsigned)A[i]) << 16); if (B) v += 2.0f * __uint_as_float(((unsigned)B[i]) << 16); if (C) v += 4.0f * __uint_as_float(((unsigned)C[i]) << 16); }
    out[i] = v;
}
#endif
extern "C" void kernel_launch(void* const* d_in, const int* in_sizes, int n_in, void* d_out, int out_size, void* d_ws, size_t ws_size, hipStream_t stream) {
    static int grid = 0;
    if (grid == 0) {
        if (n_in != 22 || in_sizes[0] != ML * D || out_size != ML * D || ws_size < WS_END) { fprintf(stderr, "kernel_launch: unexpected shapes (n_in %d, in0 %d, out %d, ws %zu)\n", n_in, n_in > 0 ? in_sizes[0] : -1, out_size, ws_size); grid = -1; return; }
        int dev = 0, cus = 0, per_cu = 0;
        if (hipGetDevice(&dev) != hipSuccess || hipDeviceGetAttribute(&cus, hipDeviceAttributeMultiprocessorCount, dev) != hipSuccess) { grid = -1; return; }
        if (hipFuncSetAttribute((const void*)mk_fwd, hipFuncAttributeMaxDynamicSharedMemorySize, LDS_BYTES) != hipSuccess) { fprintf(stderr, "kernel_launch: hipFuncSetAttribute failed\n"); grid = -1; return; }
        if (hipOccupancyMaxActiveBlocksPerMultiprocessor(&per_cu, (const void*)mk_fwd, NWAVES * 64, LDS_BYTES) != hipSuccess || per_cu < 1) fprintf(stderr, "kernel_launch: occupancy query reports %d\n", per_cu);
        (void)hipGetLastError();
        grid = cus;
    }
    if (grid < 0) return;
    if (hipMemsetAsync((char*)d_ws + WS_CTL, 0, CTL_ZERO_BYTES, stream) != hipSuccess) return;
    Args a{};
    for (int i = 0; i < 22; ++i) a.in[i] = (const float*)d_in[i];
    a.out = (float*)d_out; a.ws = (unsigned char*)d_ws;
#if MK_PER_PHASE
    for (int p = 0; p < MK_STOP; ++p) { a.ph_lo = p; a.ph_hi = p + 1; hipLaunchKernelGGL(mk_fwd, dim3(grid), dim3(NWAVES * 64), LDS_BYTES, stream, a); }
#ifdef DBG_DUMP
    hipLaunchKernelGGL(dbg_dump, dim3(ML * D / 256), dim3(256), 0, stream, DBG_A ? (const unsigned short*)((char*)d_ws + DBG_A) : nullptr, DBG_B ? (const unsigned short*)((char*)d_ws + DBG_B) : nullptr, DBG_C ? (const unsigned short*)((char*)d_ws + DBG_C) : nullptr, (size_t)DBG_N, (float*)d_out);
#endif
#else
    a.ph_lo = 0; a.ph_hi = MK_STOP;
    hipLaunchKernelGGL(mk_fwd, dim3(grid), dim3(NWAVES * 64), LDS_BYTES, stream, a);
#endif
}
```

```cpp
#include <hip/hip_runtime.h>
#include <cstdio>
#include <cstdint>
namespace pg8 {
#define PG8_LAS __attribute__((address_space(3)))
typedef unsigned short bf16_t;
typedef short bf16x8 __attribute__((ext_vector_type(8)));
typedef float f32x4 __attribute__((ext_vector_type(4)));
typedef unsigned u32x4 __attribute__((ext_vector_type(4)));
constexpr int BM = 256, BK = 64, HALF = 128, HTB = HALF * BK * 2  , STAGE_BYTES = 8 * HTB, NXCD = 8, WGM = 8;

__host__ __device__ __forceinline__ int lds_byte(int r, int c) { const int st = (r >> 4) * 2 + (c >> 5), rr = r & 15, cc = c & 31, ob = rr * 64 + cc * 2; return st * 1024 + (ob ^ (((ob >> 9) & 1) << 5)); }
__host__ __device__ __forceinline__ void stage_rc(int b, int& R, int& C) { const int st = b / 1024, sb = b % 1024, swz = sb ^ (((sb >> 9) & 1) << 5); R = (st >> 1) * 16 + swz / 64; C = (st & 1) * 32 + (swz % 64) / 2; }
__host__ __device__ __forceinline__ int perm32(int rho) { const int n = rho >> 4, i = rho & 15; return 8 * (i >> 2) + 4 * n + (i & 3); }

struct Unit { int pm, pn; };
struct Gemm { const bf16_t* A; const bf16_t* Bt; int M, N, K; };

struct StaticOrder {
    int nM, nN, nwg, G, c;
    __host__ __device__ void init(int M, int N, int G_, int c_) { nM = M / BM; nN = N / BM; nwg = nM * nN; G = G_; c = c_; }
    __host__ __device__ bool next(int i, Unit& u) const {
        const long L = (long)i * G + c; if (L >= nwg) return false;
        int wgid = (int)L; { const int q = nwg / NXCD, r = nwg % NXCD, xcd = wgid % NXCD, off = wgid / NXCD; wgid = (xcd < r ? xcd * (q + 1) : r * (q + 1) + (xcd - r) * q) + off; }
        const int nig = WGM * nN, gid = wgid / nig, fm = gid * WGM, gsz = (nM - fm) < WGM ? (nM - fm) : WGM;
        u.pm = fm + ((wgid % nig) % gsz); u.pn = (wgid % nig) / gsz; return true;
    }
    __device__ __forceinline__ void a_ready(const Unit&) const {}
    __device__ __forceinline__ void done(const Unit&) const {}
};

__device__ __forceinline__ unsigned cvt_pk_bf16(float lo, float hi) { unsigned r; asm volatile("v_cvt_pk_bf16_f32 %0, %1, %2" : "=v"(r) : "v"(lo), "v"(hi)); return r; }
template <class Epi, class Sched, bool ALIGN_EPI = false, bool SP2 = false>
__device__ __forceinline__ void gemm_phase(PG8_LAS unsigned char* lds, const Gemm g, const Sched& S, const Epi& E) {
    int tid_l = threadIdx.x; asm volatile("" : "+v"(tid_l));
    const int tid = tid_l, wid = __builtin_amdgcn_readfirstlane(tid >> 6), lane = tid & 63, wr = wid >> 2, wc = wid & 3, fr = lane & 15, fq = lane >> 4;
    const int K = g.K, nt = K / BK;
    unsigned voffA[2], voffB[2];
#pragma unroll
    for (int i = 0; i < 2; ++i) { int R, C; stage_rc(tid * 16 + i * 8192, R, C); const int Rb = Epi::PERM ? ((R & ~31) + perm32(R & 31)) : R;
        voffA[i] = (unsigned)(R * K + C) * 2u; voffB[i] = (unsigned)(Rb * K + C) * 2u; }
    const size_t kstep = (size_t)(BK * 2);
    const size_t hstep = (size_t)HALF * K * 2;
    const size_t tstep = 2 * hstep;
    const unsigned ldsw = (unsigned)wid * 1024u;
    const int aoff = lds_byte(wr * 64 + fr, fq * 8), boff = lds_byte(wc * 32 + fr, fq * 8);
#define PG8_SA(b, h) (((b) * 2 + (h)) * HTB)
#define PG8_SB(b, h) ((4 + (b) * 2 + (h)) * HTB)
#define PG8_STAGE(bufoff, gbase, voff) do { _Pragma("unroll") for (int _i = 0; _i < 2; ++_i) \
        __builtin_amdgcn_global_load_lds((const unsigned*)((const char*)(gbase) + (voff)[_i]), (PG8_LAS unsigned*)(lds + (bufoff) + ldsw + _i * 8192), 16, 0, 0); } while (0)
#define PG8_LDA(dst, b, h) do { _Pragma("unroll") for (int m = 0; m < 4; ++m) _Pragma("unroll") for (int k = 0; k < 2; ++k) dst[m][k] = *(const PG8_LAS bf16x8*)(lds + PG8_SA(b, h) + aoff + m * 2048 + k * 1024); } while (0)
#define PG8_LDB(dst, b, h) do { _Pragma("unroll") for (int n = 0; n < 2; ++n) _Pragma("unroll") for (int k = 0; k < 2; ++k) dst[n][k] = *(const PG8_LAS bf16x8*)(lds + PG8_SB(b, h) + boff + n * 2048 + k * 1024); } while (0)
#define PG8_MMA(ai, bj, At, Bt) do { __builtin_amdgcn_s_setprio(1); _Pragma("unroll") for (int m = 0; m < 4; ++m) _Pragma("unroll") for (int n = 0; n < 2; ++n) _Pragma("unroll") for (int k = 0; k < 2; ++k) \
        acc[ai][bj][m][n] = __builtin_amdgcn_mfma_f32_16x16x32_bf16(Bt[n][k], At[m][k], acc[ai][bj][m][n], 0, 0, 0); __builtin_amdgcn_s_setprio(0); } while (0)
#define PG8_WAIT_V(n) asm volatile("s_waitcnt vmcnt(" #n ")" ::: "memory")
#define PG8_WAIT_L(n) asm volatile("s_waitcnt lgkmcnt(" #n ")" ::: "memory")
#define PG8_BAR __builtin_amdgcn_s_barrier()
#define PG8_SCHED __builtin_amdgcn_sched_barrier(0)
    Unit cur, nxt; int ui = 0;
    if (!S.next(0, cur)) return;
    f32x4 acc[2][2][4][2];
#pragma unroll
    for (int a = 0; a < 2; ++a)
#pragma unroll
        for (int b = 0; b < 2; ++b)
#pragma unroll
            for (int m = 0; m < 4; ++m)
#pragma unroll
                for (int n = 0; n < 2; ++n) acc[a][b][m][n] = (f32x4){0.f, 0.f, 0.f, 0.f};
    bf16x8 At[4][2], B0[2][2], B1[2][2];
    const char* cA = (const char*)g.A + (size_t)cur.pm * tstep; const char* cB = (const char*)g.Bt + (size_t)cur.pn * tstep;
    S.a_ready(cur);
    if constexpr (SP2) {
        PG8_STAGE(PG8_SB(0, 0), cB, voffB); PG8_STAGE(PG8_SB(0, 1), cB + hstep, voffB); PG8_STAGE(PG8_SA(0, 0), cA, voffA); PG8_STAGE(PG8_SA(0, 1), cA + hstep, voffA);
        if (wr == 1) PG8_BAR;
        PG8_WAIT_V(2); PG8_BAR;
        PG8_STAGE(PG8_SB(1, 0), cB + kstep, voffB); PG8_STAGE(PG8_SA(1, 0), cA + kstep, voffA); PG8_STAGE(PG8_SB(1, 1), cB + hstep + kstep, voffB);
        PG8_WAIT_V(6); PG8_BAR;
    } else {
        PG8_STAGE(PG8_SB(0, 0), cB, voffB); PG8_STAGE(PG8_SA(0, 0), cA, voffA); PG8_STAGE(PG8_SB(0, 1), cB + hstep, voffB); PG8_STAGE(PG8_SA(0, 1), cA + hstep, voffA);
        if (wr == 1) PG8_BAR;
        PG8_WAIT_V(4); PG8_BAR;
        PG8_STAGE(PG8_SB(1, 0), cB + kstep, voffB); PG8_STAGE(PG8_SA(1, 0), cA + kstep, voffA); PG8_STAGE(PG8_SB(1, 1), cB + hstep + kstep, voffB);
        PG8_WAIT_V(6); PG8_BAR;
    }
    for (;;) {
        const bool has_next = S.next(ui + 1, nxt);
        const char* nA = has_next ? (const char*)g.A + (size_t)nxt.pm * tstep : cA; const char* nB = has_next ? (const char*)g.Bt + (size_t)nxt.pn * tstep : cB;
        for (int t = 0; t < nt; t += 2) {
            const bool last = (t == nt - 2);
            const char* a1 = cA + (size_t)(t + 1) * kstep;
            const char* a2 = last ? nA : cA + (size_t)(t + 2) * kstep; const char* b2 = last ? nB : cB + (size_t)(t + 2) * kstep;
            const char* a3 = a2 + kstep; const char* b3 = b2 + kstep;
            if (last && has_next) S.a_ready(nxt);
            if constexpr (SP2) {
            PG8_LDB(B0, 0, 0); PG8_LDB(B1, 0, 1); PG8_SCHED; PG8_LDA(At, 0, 0); PG8_STAGE(PG8_SA(1, 1), a1 + hstep, voffA);
            PG8_WAIT_V(8); PG8_WAIT_L(0); PG8_BAR; PG8_MMA(0, 0, At, B0); PG8_MMA(0, 1, At, B1); PG8_BAR; PG8_SCHED;
            PG8_LDA(At, 0, 1); PG8_STAGE(PG8_SB(0, 0), b2, voffB); PG8_STAGE(PG8_SB(0, 1), b2 + hstep, voffB); PG8_STAGE(PG8_SA(0, 0), a2, voffA);
            PG8_WAIT_V(8); PG8_WAIT_L(0); PG8_BAR; PG8_MMA(1, 0, At, B0); PG8_MMA(1, 1, At, B1); PG8_BAR; PG8_SCHED;
            PG8_LDB(B0, 1, 0); PG8_LDB(B1, 1, 1); PG8_SCHED; PG8_LDA(At, 1, 0); PG8_STAGE(PG8_SA(0, 1), a2 + hstep, voffA);
            PG8_WAIT_V(8); PG8_WAIT_L(0); PG8_BAR; PG8_MMA(0, 0, At, B0); PG8_MMA(0, 1, At, B1); PG8_BAR; PG8_SCHED;
            PG8_LDA(At, 1, 1); PG8_STAGE(PG8_SB(1, 0), b3, voffB); PG8_STAGE(PG8_SB(1, 1), b3 + hstep, voffB); PG8_STAGE(PG8_SA(1, 0), a3, voffA);
            PG8_WAIT_V(8); PG8_WAIT_L(0); PG8_BAR; PG8_MMA(1, 0, At, B0); PG8_MMA(1, 1, At, B1); PG8_BAR; PG8_SCHED;
            } else {
            PG8_LDB(B0, 0, 0); PG8_SCHED; PG8_LDA(At, 0, 0); PG8_STAGE(PG8_SA(1, 1), a1 + hstep, voffA);
            PG8_WAIT_L(8); PG8_BAR; PG8_WAIT_L(0); PG8_MMA(0, 0, At, B0); PG8_BAR; PG8_SCHED;
            PG8_LDB(B1, 0, 1); PG8_STAGE(PG8_SB(0, 0), b2, voffB);
            PG8_BAR; PG8_WAIT_L(0); PG8_MMA(0, 1, At, B1); PG8_BAR;
            PG8_LDA(At, 0, 1); PG8_STAGE(PG8_SA(0, 0), a2, voffA);
            PG8_BAR; PG8_WAIT_L(0); PG8_MMA(1, 0, At, B0); PG8_BAR; PG8_SCHED;
            PG8_STAGE(PG8_SB(0, 1), b2 + hstep, voffB);
            PG8_WAIT_V(6); PG8_BAR; PG8_MMA(1, 1, At, B1); PG8_BAR;
            PG8_LDB(B0, 1, 0); PG8_SCHED; PG8_LDA(At, 1, 0); PG8_STAGE(PG8_SA(0, 1), a2 + hstep, voffA);
            PG8_WAIT_L(8); PG8_BAR; PG8_WAIT_L(0); PG8_MMA(0, 0, At, B0); PG8_BAR; PG8_SCHED;
            PG8_LDB(B1, 1, 1); PG8_STAGE(PG8_SB(1, 0), b3, voffB);
            PG8_BAR; PG8_WAIT_L(0); PG8_MMA(0, 1, At, B1); PG8_BAR;
            PG8_LDA(At, 1, 1); PG8_STAGE(PG8_SA(1, 0), a3, voffA);
            PG8_BAR; PG8_WAIT_L(0); PG8_MMA(1, 0, At, B0); PG8_BAR; PG8_SCHED;
            PG8_STAGE(PG8_SB(1, 1), b3 + hstep, voffB);
            PG8_WAIT_V(6); PG8_BAR; PG8_MMA(1, 1, At, B1); PG8_BAR;
            }
        }
        if constexpr (ALIGN_EPI) { if (wr == 0) PG8_BAR; }
        if constexpr (!Epi::AFTER_DRAIN) { E(acc, cur, wr, wc, fr, fq); S.done(cur); }
        if (!has_next) break;
#pragma unroll
        for (int a = 0; a < 2; ++a)
#pragma unroll
            for (int b = 0; b < 2; ++b)
#pragma unroll
                for (int m = 0; m < 4; ++m)
#pragma unroll
                    for (int n = 0; n < 2; ++n) acc[a][b][m][n] = (f32x4){0.f, 0.f, 0.f, 0.f};
        cur = nxt; cA = nA; cB = nB; ++ui;
        if constexpr (ALIGN_EPI) { if (wr == 1) PG8_BAR; }
    }
    PG8_WAIT_V(0);
    if constexpr (!ALIGN_EPI) { if (wr == 0) PG8_BAR; }
    PG8_BAR;
    if constexpr (Epi::AFTER_DRAIN) { E.fused(acc, cur, wr, wc, fr, fq, lds, wid, lane); S.done(cur); }
#undef PG8_SA
#undef PG8_SB
#undef PG8_STAGE
#undef PG8_LDA
#undef PG8_LDB
#undef PG8_MMA
#undef PG8_WAIT_V
#undef PG8_WAIT_L
#undef PG8_BAR
#undef PG8_SCHED
}
}
#define GAS __attribute__((address_space(1)))
#define LAS __attribute__((address_space(3)))
typedef unsigned short bf16;
typedef unsigned v4u __attribute__((ext_vector_type(4)));
typedef float f32x4 __attribute__((ext_vector_type(4)));
typedef short bf16x8 __attribute__((ext_vector_type(8)));
typedef GAS unsigned gu32;
typedef GAS unsigned long long gu64;
#define RLX_AGENT __ATOMIC_RELAXED, __HIP_MEMORY_SCOPE_AGENT
#define LDS_WAIT() asm volatile("s_waitcnt lgkmcnt(0)" ::: "memory")
#define VM_WAIT() asm volatile("s_waitcnt vmcnt(0)" ::: "memory")
__device__ __forceinline__ unsigned long long rt() { return __builtin_amdgcn_s_memrealtime(); }
__device__ __forceinline__ unsigned f2bf(float f) { unsigned u = __builtin_bit_cast(unsigned, f); return (u + 0x7fffu + ((u >> 16) & 1u)) >> 16; }
__device__ __forceinline__ unsigned pk2(float lo, float hi) { return f2bf(lo) | (f2bf(hi) << 16); }

#define XB_TMO      128
#define XB_XCNT(j)  (256  + 64 * (j))
#define XB_XSUB(j)  (1280 + 64 * (j))
#define XB_XGEN(j)  (2304 + 64 * (j))
#define XB_TOP      3328
#define XB_TOPGEN   3392
#define XCD_BAR_WORDS 3456
#define XB_SPIN_CAP (1u << 18)

__device__ __forceinline__ unsigned xb_ld(unsigned* p)              { return __hip_atomic_load(p, __ATOMIC_RELAXED, __HIP_MEMORY_SCOPE_AGENT); }
__device__ __forceinline__ unsigned xb_add(unsigned* p, unsigned v) { return __hip_atomic_fetch_add(p, v, __ATOMIC_RELAXED, __HIP_MEMORY_SCOPE_AGENT); }
__device__ __forceinline__ unsigned xb_xcc_id() { return (unsigned)__builtin_amdgcn_s_getreg((3 << 11) | 20) & 0xFu; }
#define XB_SPIN(cond, bar) do { unsigned _sp = 0; while (cond) { __builtin_amdgcn_s_sleep(1); \
    if ((++_sp & 255u) == 0u) { if (xb_ld(&(bar)[XB_TMO])) break; if (_sp > XB_SPIN_CAP) { atomicAdd(&(bar)[XB_TMO], 1u); break; } } } } while (0)

struct XcdBarrier {
    unsigned* bar; unsigned x;
    volatile LAS unsigned* st;
};

__device__ __forceinline__ XcdBarrier xcd_barrier_post(unsigned* bar, volatile LAS unsigned* st) {
    XcdBarrier b; b.bar = bar; b.x = xb_xcc_id(); b.st = st;
    if (threadIdx.x == 0) (void)xb_add(&bar[XB_XCNT(b.x)], 1u);
    return b;
}
__device__ __forceinline__ void xcd_barrier_complete(unsigned* bar, unsigned x, unsigned& nloc, unsigned& nx) {
    const unsigned G = gridDim.x * gridDim.y * gridDim.z;
    unsigned sum, cnt, mine, sp = 0u;
    for (;;) {
        sum = 0u; cnt = 0u; mine = 0u;
#pragma unroll
        for (unsigned j = 0; j < 16; ++j) { const unsigned c = xb_ld(&bar[XB_XCNT(j)]); sum += c; cnt += (c > 0u) ? 1u : 0u; mine = (j == x) ? c : mine; }
        if (sum == G) break;
        __builtin_amdgcn_s_sleep(1);
        if ((++sp & 255u) == 0u) { if (xb_ld(&bar[XB_TMO])) break; if (sp > XB_SPIN_CAP) { atomicAdd(&bar[XB_TMO], 1u); break; } }
    }
    nloc = mine > 0u ? mine : 1u; nx = cnt > 0u ? cnt : 1u;
}

__device__ __forceinline__ void xcd_barrier(const XcdBarrier& b) {
    asm volatile("s_waitcnt vmcnt(0)" ::: "memory");
    __syncthreads();
    if (threadIdx.x == 0) {
        unsigned* bar = b.bar;
        __builtin_amdgcn_s_waitcnt(0);
        unsigned nloc = b.st[0], nx = b.st[1];
        if (nloc == 0u) { xcd_barrier_complete(bar, b.x, nloc, nx); b.st[0] = nloc; b.st[1] = nx; }
        const unsigned old = xb_add(&bar[XB_XSUB(b.x)], 1u);
        const unsigned gen = old / nloc;
        if (old + 1u == (gen + 1u) * nloc) {
            __builtin_amdgcn_fence(__ATOMIC_RELEASE, "agent");
            asm volatile("s_waitcnt vmcnt(0)" ::: "memory");
            const unsigned og = xb_add(&bar[XB_TOP], 1u);
            const unsigned tg = og / nx;
            if (og + 1u == (tg + 1u) * nx) xb_add(&bar[XB_TOPGEN], 1u);
            else XB_SPIN(xb_ld(&bar[XB_TOPGEN]) == tg, bar);
            __builtin_amdgcn_fence(__ATOMIC_ACQUIRE, "agent");
            xb_add(&bar[XB_XGEN(b.x)], 1u);
            asm volatile("s_waitcnt vmcnt(0)" ::: "memory");
        } else {
            XB_SPIN(xb_ld(&bar[XB_XGEN(b.x)]) == gen, bar);
            __builtin_amdgcn_fence(__ATOMIC_ACQUIRE, "agent");
            asm volatile("s_waitcnt vmcnt(0)" ::: "memory");
        }
    }
    __syncthreads();
}
constexpr int NB = 8, T = 4096, D = 1024, TC = 256, FF = 2816;
constexpr int ML = NB * T, MC = NB * TC, M = ML + MC;
constexpr int N_FI = 2 * FF, N_AI = 2304, N_RI = 3840, N_RI_SRC = 3600;
constexpr float ALPHA = 1.41421356237309515f;
constexpr float LOG2E = 1.4426950408889634f;
constexpr float QSCALE = 0.125f * LOG2E;
constexpr int NWAVES = 8;
#ifndef MK_PER_PHASE
#define MK_PER_PHASE 0
#endif
constexpr int N_PHASES = 2 + 2 * 11;
#ifndef MK_STOP
#define MK_STOP N_PHASES
#endif

constexpr size_t MiB = 1u << 20;
constexpr size_t WS_CTL = 0, CTL_ZERO_BYTES = 1 * MiB;
constexpr size_t WS_MOD = 1 * MiB;
constexpr size_t WS_ROPE = WS_MOD + 704 * 1024;
constexpr size_t WS_LAM = WS_ROPE + 8192;
constexpr size_t WS_WFI = 2 * MiB;
constexpr size_t WS_WFO = 46 * MiB;
constexpr size_t WS_WAI = 68 * MiB;
constexpr size_t WS_WAO = WS_WAI + 4608 * 1024;
constexpr size_t WS_WRI = WS_WAO + 2 * MiB;
constexpr size_t WS_WRO = WS_WRI + 7680 * 1024;
constexpr size_t WS_XC = 84 * MiB;
constexpr size_t WS_H = 92 * MiB;
constexpr size_t WS_HB = 160 * MiB;
constexpr size_t WS_BIG = 228 * MiB;
constexpr size_t WS_END = 500 * MiB;
static_assert(WS_WRO + 2 * MiB <= WS_XC, "weights");
constexpr size_t WS_ACT = WS_BIG;
constexpr size_t WS_AQ = WS_BIG, WS_AK = WS_BIG + 34 * MiB, WS_BQ = WS_BIG + 68 * MiB, WS_BK = WS_BIG + 102 * MiB;
constexpr size_t WS_VTA_L = WS_BIG + 111 * MiB, WS_VTA_C = WS_BIG + 143 * MiB, WS_VTB_L = WS_BIG + 145 * MiB, WS_VTB_C = WS_BIG + 153 * MiB;
constexpr size_t WS_MQ = WS_BIG, WS_MK = WS_BIG + 34 * MiB, WS_MO = WS_BIG + 68 * MiB, WS_RQ = WS_BIG + 102 * MiB, WS_RK = WS_BIG + 119 * MiB, WS_RG = WS_BIG + 136 * MiB;
constexpr size_t WS_MKT_L = WS_BIG + 170 * MiB, WS_MKT_C = WS_BIG + 202 * MiB, WS_MVT_L = WS_BIG + 204 * MiB, WS_MVT_C = WS_BIG + 236 * MiB;
constexpr size_t WS_RVT_L = WS_BIG + 238 * MiB, WS_RVT_C = WS_BIG + 270 * MiB;
constexpr size_t WS_RKT_L = 2 * MiB, WS_RKT_C = 18 * MiB, WS_GATE = 20 * MiB;
static_assert(WS_RVT_C + 2 * MiB <= WS_END && WS_GATE + (size_t)M * 16 * 4 <= 24 * MiB, "ws map");

constexpr int CW_TMO = 0, CW_CODE = 1, CW_BAR = 4096;
constexpr int RING_BYTES = 131072;
constexpr int LDSCTL_OFF = RING_BYTES, MISC_OFF = LDSCTL_OFF + 320;
constexpr int LDS_BYTES = 147456;
typedef float f32x16 __attribute__((ext_vector_type(16)));
typedef short bf16x4 __attribute__((ext_vector_type(4)));
typedef unsigned u32x2 __attribute__((ext_vector_type(2)));
__device__ __forceinline__ float wave_sum(float v) {
#pragma unroll
    for (int o = 1; o < 64; o <<= 1) v += __shfl_xor(v, o);
    return v;
}
__device__ __forceinline__ float bf2f(unsigned short b) { return __uint_as_float(((unsigned)b) << 16); }
__device__ __forceinline__ float bflo(unsigned w) { return __uint_as_float(w << 16); }
__device__ __forceinline__ float bfhi(unsigned w) { return __uint_as_float(w & 0xffff0000u); }
__device__ __forceinline__ float fexp2(float x) { return __builtin_amdgcn_exp2f(x); }
__device__ __forceinline__ float fexp(float x) { return __builtin_amdgcn_exp2f(x * LOG2E); }
__device__ __forceinline__ float frcp(float x) { return __builtin_amdgcn_rcpf(x); }
__device__ __forceinline__ float silu_f(float x) { return x * frcp(1.0f + fexp(-x)); }
__device__ __forceinline__ float sigmoid_f(float x) { return frcp(1.0f + fexp(-x)); }
__device__ __forceinline__ u32x2 pack4(f32x4 v) { u32x2 w; w.x = pk2(v[0], v[1]); w.y = pk2(v[2], v[3]); return w; }
__device__ __forceinline__ f32x4 mfma16(bf16x8 a, bf16x8 b, f32x4 c) { return __builtin_amdgcn_mfma_f32_16x16x32_bf16(a, b, c, 0, 0, 0); }
__device__ __forceinline__ f32x16 mfma32(bf16x8 a, bf16x8 b, f32x16 c) { return __builtin_amdgcn_mfma_f32_32x32x16_bf16(a, b, c, 0, 0, 0); }
__device__ __forceinline__ int crow(int i, int h) { return (i & 3) + 8 * (i >> 2) + 4 * h; }
__device__ __forceinline__ bf16x8 ldg16(const bf16* p) { return *(const bf16x8*)p; }
__device__ __forceinline__ bf16x8 scale8u(bf16x8 v, float s) {
    const v4u u = __builtin_bit_cast(v4u, v); v4u o;
    o.x = pk2(bflo(u.x) * s, bfhi(u.x) * s); o.y = pk2(bflo(u.y) * s, bfhi(u.y) * s); o.z = pk2(bflo(u.z) * s, bfhi(u.z) * s); o.w = pk2(bflo(u.w) * s, bfhi(u.w) * s);
    return __builtin_bit_cast(bf16x8, o);
}
__device__ __forceinline__ bf16x8 scale8v(bf16x8 v, f32x4 s0, f32x4 s1) {
    const v4u u = __builtin_bit_cast(v4u, v); v4u o;
    o.x = pk2(bflo(u.x) * s0[0], bfhi(u.x) * s0[1]); o.y = pk2(bflo(u.y) * s0[2], bfhi(u.y) * s0[3]); o.z = pk2(bflo(u.z) * s1[0], bfhi(u.z) * s1[1]); o.w = pk2(bflo(u.w) * s1[2], bfhi(u.w) * s1[3]);
    return __builtin_bit_cast(bf16x8, o);
}
typedef __bf16 bf16x2_t __attribute__((ext_vector_type(2)));
typedef float f32x2_t __attribute__((ext_vector_type(2)));
__device__ __forceinline__ unsigned cvtpk(float lo, float hi) { const f32x2_t v = {lo, hi}; const bf16x2_t b = __builtin_convertvector(v, bf16x2_t); return __builtin_bit_cast(unsigned, b); }
__device__ __forceinline__ u32x2 pack4c(f32x4 v) { u32x2 w; w.x = cvtpk(v[0], v[1]); w.y = cvtpk(v[2], v[3]); return w; }

struct EpiSwiglu {
    static constexpr bool PERM = true, AFTER_DRAIN = false;
    bf16* ACT;
    __device__ __forceinline__ void operator()(const f32x4 (&acc)[2][2][4][2], const pg8::Unit& u, int wr, int wc, int fr, int fq) const {
        const int row0 = u.pm * 256 + wr * 64 + fr, col0 = u.pn * 128 + wc * 32 + 8 * fq;
#pragma unroll
        for (int ai = 0; ai < 2; ++ai)
#pragma unroll
            for (int m = 0; m < 4; ++m) {
                bf16* rowp = ACT + (size_t)(row0 + ai * 128 + m * 16) * FF + col0;
                const f32x4 g0 = acc[ai][0][m][0], g1 = acc[ai][0][m][1], u0 = acc[ai][1][m][0], u1 = acc[ai][1][m][1];
                f32x4 a0, a1;
#pragma unroll
                for (int e = 0; e < 4; ++e) { a0[e] = silu_f(g0[e]) * u0[e]; a1[e] = silu_f(g1[e]) * u1[e]; }
                v4u w; w.x = cvtpk(a0[0], a0[1]); w.y = cvtpk(a0[2], a0[3]); w.z = cvtpk(a1[0], a1[1]); w.w = cvtpk(a1[2], a1[3]);
                *(v4u*)rowp = w;
            }
    }
};

struct EpiResid {
    static constexpr bool PERM = false, AFTER_DRAIN = false;
    const float* base_l; const float* base_c; float* out_l; float* out_c; const float* gate; float wgt;
    __device__ __forceinline__ void operator()(const f32x4 (&acc)[2][2][4][2], const pg8::Unit& u, int wr, int wc, int fr, int fq) const {
        const int r0 = u.pm * 256; const bool lat = r0 < ML; const int mr = lat ? (r0 >> 12) : 8;
        const float* bp = lat ? base_l + (size_t)r0 * D : base_c + (size_t)(r0 - ML) * D;
        float* op = lat ? out_l + (size_t)r0 * D : out_c + (size_t)(r0 - ML) * D;
        const float* gp = gate + (size_t)mr * 9216;
        const int col0 = u.pn * 256 + wc * 32 + 4 * fq;
        f32x4 gv[2][2];
#pragma unroll
        for (int bj = 0; bj < 2; ++bj)
#pragma unroll
            for (int n = 0; n < 2; ++n) gv[bj][n] = *(const f32x4*)(gp + col0 + bj * 128 + n * 16) * wgt;
#pragma unroll
        for (int ai = 0; ai < 2; ++ai)
#pragma unroll
            for (int m = 0; m < 4; ++m) {
                const size_t ro = (size_t)(ai * 128 + wr * 64 + m * 16 + fr) * D;
#pragma unroll
                for (int bj = 0; bj < 2; ++bj)
#pragma unroll
                    for (int n = 0; n < 2; ++n) { const int c = col0 + bj * 128 + n * 16; const f32x4 x = *(const f32x4*)(bp + ro + c);
                        *(f32x4*)(op + ro + c) = x * ALPHA + gv[bj][n] * acc[ai][bj][m][n]; }
            }
    }
};

__device__ __forceinline__ void epi_store_T(const f32x4 (&acc)[2][2][4][2], int bj, bf16* tb, int TL, int trow, int t0, float sc, int wr, int wc, int fr, int fq) {
#ifdef NO_T
    return;
#endif
    bf16* p0 = tb + (size_t)(trow + bj * 128 + wc * 32 + 4 * fq) * TL + t0 + wr * 64 + fr;
#pragma unroll
    for (int ai = 0; ai < 2; ++ai)
#pragma unroll
        for (int m = 0; m < 4; ++m) {
#pragma unroll
            for (int n = 0; n < 2; ++n) { const u32x2 w = pack4c(acc[ai][bj][m][n] * sc);
                bf16* p = p0 + (size_t)(16 * n) * TL + ai * 128 + m * 16;
                p[0] = (bf16)(w.x & 0xffffu); p[(size_t)TL] = (bf16)(w.x >> 16); p[(size_t)2 * TL] = (bf16)(w.y & 0xffffu); p[(size_t)3 * TL] = (bf16)(w.y >> 16); }
            asm volatile("" ::: "memory");
        }
}
template <int ACT>
__device__ __forceinline__ void epi_store_P(const f32x4 (&acc)[2][2][4][2], int bj, bf16* dst0, int pitch, int cb, float sc, int wr, int wc, int fr, int fq) {
    bf16* p0 = dst0 + (size_t)(wr * 64 + fr) * pitch + cb + bj * 128 + wc * 32 + 4 * fq;
#pragma unroll
    for (int ai = 0; ai < 2; ++ai)
#pragma unroll
        for (int m = 0; m < 4; ++m) {
#pragma unroll
            for (int n = 0; n < 2; ++n) { f32x4 v = acc[ai][bj][m][n] * sc;
                if (ACT == 1) {
#pragma unroll
                    for (int e = 0; e < 4; ++e) v[e] = sigmoid_f(v[e]); }
                if (ACT == 2) {
#pragma unroll
                    for (int e = 0; e < 4; ++e) v[e] = silu_f(v[e]); }
                *(u32x2*)(p0 + (size_t)(ai * 128 + m * 16) * pitch + 16 * n) = pack4c(v); }
            asm volatile("" ::: "memory");
        }
}
__device__ __forceinline__ void epi_store_R(const f32x4 (&acc)[2][2][4][2], int bj, bf16* dst0, int pitch, int cb, float sc, bool rope, int t0, const float* cosT, const float* sinT, int wr, int wc, int fr, int fq) {
#ifdef NO_R
    return;
#endif
    bf16* p0 = dst0 + (size_t)(wr * 64 + fr) * pitch + cb + bj * 128 + wc * 32 + 4 * fq;
#pragma unroll
    for (int ai = 0; ai < 2; ++ai)
#pragma unroll
        for (int m = 0; m < 4; ++m) { const int rr = ai * 128 + wr * 64 + m * 16 + fr; const int t = t0 + rr;
            const f32x4 x1 = acc[ai][bj][m][0], x2 = acc[ai][bj][m][1]; f32x4 o1 = x1, o2 = x2;
            if (rope) { const int pos = (wc & 1) ? (t & 63) : (t >> 6);
                const f32x4 c4 = *(const f32x4*)(cosT + pos * 16 + 4 * fq), s4 = *(const f32x4*)(sinT + pos * 16 + 4 * fq);
                o1 = x1 * c4 - x2 * s4; o2 = x2 * c4 + x1 * s4; }
            bf16* p = p0 + (size_t)(ai * 128 + m * 16) * pitch;
            *(u32x2*)p = pack4c(o1 * sc); *(u32x2*)(p + 16) = pack4c(o2 * sc);
            asm volatile("" ::: "memory"); }
}

struct EpiAttnIn {
    static constexpr bool PERM = false, AFTER_DRAIN = false;
    unsigned char* ws;
    __device__ __forceinline__ void operator()(const f32x4 (&acc)[2][2][4][2], const pg8::Unit& u, int wr, int wc, int fr, int fq) const {
        asm volatile("" : "+v"(fr), "+v"(fq));
        const int r0 = u.pm * 256; const bool lat = r0 < ML; const int b = lat ? (r0 >> 12) : ((r0 - ML) >> 8); const int t0 = lat ? (r0 & 4095) : 0;
        const int pn = u.pn; const int TL = lat ? T : TC;
        const float* cosT = (const float*)(ws + WS_ROPE); const float* sinT = cosT + 1024;
        if (pn == 4 || pn == 5) {
            bf16* vb = (bf16*)(ws + (lat ? WS_VTA_L : WS_VTA_C)) + (size_t)b * 512 * TL;
            epi_store_T(acc, 0, vb, TL, (pn - 4) * 256, t0, 1.f, wr, wc, fr, fq); epi_store_T(acc, 1, vb, TL, (pn - 4) * 256, t0, 1.f, wr, wc, fr, fq);
        } else if (pn == 8) {
            epi_store_R(acc, 0, (bf16*)(ws + WS_BK) + (size_t)r0 * 128, 128, 0, 1.f, lat, t0, cosT, sinT, wr, wc, fr, fq);
            epi_store_T(acc, 1, (bf16*)(ws + (lat ? WS_VTB_L : WS_VTB_C)) + (size_t)b * 128 * TL, TL, -128, t0, 1.f, wr, wc, fr, fq);
        } else {
            const size_t off = (pn < 2) ? WS_AQ : (pn < 4) ? WS_AK : WS_BQ;
            bf16* dst = (bf16*)(ws + off); const int cb = (pn & 1) * 256; const float sc = (pn < 2 || pn >= 6) ? QSCALE : 1.f;
            epi_store_R(acc, 0, dst + (size_t)r0 * 512, 512, cb, sc, lat, t0, cosT, sinT, wr, wc, fr, fq); epi_store_R(acc, 1, dst + (size_t)r0 * 512, 512, cb, sc, lat, t0, cosT, sinT, wr, wc, fr, fq);
        }
    }
};

struct EpiRecIn {
    static constexpr bool PERM = false, AFTER_DRAIN = false;
    unsigned char* ws; const float* gate_b;
    __device__ __forceinline__ void operator()(const f32x4 (&acc)[2][2][4][2], const pg8::Unit& u, int wr, int wc, int fr, int fq) const {
        asm volatile("" : "+v"(fr), "+v"(fq));
        const int r0 = u.pm * 256; const bool lat = r0 < ML; const int b = lat ? (r0 >> 12) : ((r0 - ML) >> 8); const int t0 = lat ? (r0 & 4095) : 0;
        const int pn = u.pn; const int TL = lat ? T : TC;
        if (pn == 14) {
            if (wc == 0) {
                const f32x4 gb = *(const f32x4*)(gate_b + 4 * fq);
                const bool isf = (fq & 1) != 0;
#pragma unroll
                for (int ai = 0; ai < 2; ++ai)
#pragma unroll
                    for (int m = 0; m < 4; ++m) { const int rr = ai * 128 + wr * 64 + m * 16 + fr; f32x4 v = acc[ai][0][m][0] + gb;
                        if (isf) {
#pragma unroll
                            for (int e = 0; e < 4; ++e) { const float x = v[e]; v[e] = fminf(x, 0.f) - log1pf(__expf(-fabsf(x))); } }
                        *(f32x4*)((float*)(ws + WS_GATE) + (size_t)(r0 + rr) * 16 + 4 * fq) = v; }
            }
        } else if (pn < 2) { bf16* d0 = (bf16*)(ws + WS_MQ) + (size_t)r0 * 512; epi_store_P<0>(acc, 0, d0, 512, pn * 256, 1.f, wr, wc, fr, fq); epi_store_P<0>(acc, 1, d0, 512, pn * 256, 1.f, wr, wc, fr, fq); }
        else if (pn < 4) { const float sc = 0.08838834764831845f; bf16* d0 = (bf16*)(ws + WS_MK) + (size_t)r0 * 512; bf16* tb = (bf16*)(ws + (lat ? WS_MKT_L : WS_MKT_C)) + (size_t)b * 512 * TL;
#pragma unroll
            for (int bj = 0; bj < 2; ++bj) { epi_store_P<0>(acc, bj, d0, 512, (pn - 2) * 256, sc, wr, wc, fr, fq); epi_store_T(acc, bj, tb, TL, (pn - 2) * 256, t0, sc, wr, wc, fr, fq); } }
        else if (pn < 6) { bf16* tb = (bf16*)(ws + (lat ? WS_MVT_L : WS_MVT_C)) + (size_t)b * 512 * TL; epi_store_T(acc, 0, tb, TL, (pn - 4) * 256, t0, 1.f, wr, wc, fr, fq); epi_store_T(acc, 1, tb, TL, (pn - 4) * 256, t0, 1.f, wr, wc, fr, fq); }
        else if (pn < 8) { bf16* d0 = (bf16*)(ws + WS_MO) + (size_t)r0 * 512; epi_store_P<1>(acc, 0, d0, 512, (pn - 6) * 256, 1.f, wr, wc, fr, fq); epi_store_P<1>(acc, 1, d0, 512, (pn - 6) * 256, 1.f, wr, wc, fr, fq); }
        else if (pn == 8) { bf16* d0 = (bf16*)(ws + WS_RQ) + (size_t)r0 * 256; epi_store_P<0>(acc, 0, d0, 256, 0, 1.f, wr, wc, fr, fq); epi_store_P<0>(acc, 1, d0, 256, 0, 1.f, wr, wc, fr, fq); }
        else if (pn == 9) { bf16* d0 = (bf16*)(ws + WS_RK) + (size_t)r0 * 256; bf16* tb = (bf16*)(ws + (lat ? WS_RKT_L : WS_RKT_C)) + (size_t)b * 256 * TL;
#pragma unroll
            for (int bj = 0; bj < 2; ++bj) { epi_store_P<0>(acc, bj, d0, 256, 0, 0.125f, wr, wc, fr, fq); epi_store_T(acc, bj, tb, TL, 0, t0, 0.125f, wr, wc, fr, fq); } }
        else if (pn < 12) { bf16* tb = (bf16*)(ws + (lat ? WS_RVT_L : WS_RVT_C)) + (size_t)b * 512 * TL; epi_store_T(acc, 0, tb, TL, (pn - 10) * 256, t0, 1.f, wr, wc, fr, fq); epi_store_T(acc, 1, tb, TL, (pn - 10) * 256, t0, 1.f, wr, wc, fr, fq); }
        else { bf16* d0 = (bf16*)(ws + WS_RG) + (size_t)r0 * 512; epi_store_P<2>(acc, 0, d0, 512, (pn - 12) * 256, 1.f, wr, wc, fr, fq); epi_store_P<2>(acc, 1, d0, 512, (pn - 12) * 256, 1.f, wr, wc, fr, fq); }
    }
};
struct Args { const float* in[22]; float* out; unsigned char* ws; int ph_lo, ph_hi; };
enum { I_X = 0, I_C, I_CTX, I_CCTX, I_ADAW, I_ADAB, I_LNG, I_LNB, I_FWI, I_FWO, I_AWI, I_AWO, I_DLAM, I_DNG, I_SINK, I_RWI, I_RWO, I_MGB, I_MNG, I_RDL, I_RNG, I_RNB };

__device__ __forceinline__ void tr_item(const float* W, int ldw, int k0, int c0, int nvalid, bf16* WT, int K, int r0, LAS float* scr, int lane) {
    const int col = lane & 31;
#pragma unroll 8
    for (int i = 0; i < 32; ++i) { const int kk = 2 * i + (lane >> 5); scr[kk * 33 + col] = (col < nvalid) ? W[(size_t)(k0 + kk) * ldw + c0 + col] : 0.f; }
    LDS_WAIT(); asm volatile("" ::: "memory");
    const int c = lane & 7;
#pragma unroll
    for (int j = 0; j < 4; ++j) { const int n = (lane >> 3) + 8 * j; const LAS float* s = scr + (8 * c) * 33 + n;
        v4u o; o.x = pk2(s[0 * 33], s[1 * 33]); o.y = pk2(s[2 * 33], s[3 * 33]); o.z = pk2(s[4 * 33], s[5 * 33]); o.w = pk2(s[6 * 33], s[7 * 33]);
        *(v4u*)(WT + (size_t)(r0 + n) * K + k0 + 8 * c) = o; }
    LDS_WAIT(); asm volatile("" ::: "memory");
}

__device__ __forceinline__ void p0a_prologue(const Args& a, LAS unsigned char* lds, int G, int vcu, int tid, int lane, int wave) {
    unsigned char* ws = a.ws;
    LAS float* scr = (LAS float*)(lds + wave * 8448);
    const int gw = vcu * NWAVES + wave, NGW = G * NWAVES;
    constexpr int I_FI = 16 * 176, I_FO = 44 * 32, I_AI = 16 * 72, I_AO = 16 * 32, I_RI = 16 * 120, I_RO = 16 * 32;
    constexpr int NITEMS = 4 * I_FI + 4 * I_FO + I_AI + I_AO + I_RI + I_RO;
    for (int it = gw; it < NITEMS; it += NGW) {
        int r = it;
        if (r < 4 * I_FI) { const int mi = r / I_FI; r -= mi * I_FI; const int kb = r / 176, nb = r % 176, pn = nb >> 3, q = nb & 7;
            const int c0 = (q < 4) ? (128 * pn + 32 * q) : (FF + 128 * pn + 32 * (q - 4));
            tr_item(a.in[I_FWI] + (size_t)mi * D * N_FI, N_FI, 64 * kb, c0, 32, (bf16*)(ws + WS_WFI) + (size_t)mi * N_FI * D, D, 32 * nb, scr, lane); continue; }
        r -= 4 * I_FI;
        if (r < 4 * I_FO) { const int mi = r / I_FO; r -= mi * I_FO; const int kb = r / 32, nb = r % 32;
            tr_item(a.in[I_FWO] + (size_t)mi * FF * D, D, 64 * kb, 32 * nb, 32, (bf16*)(ws + WS_WFO) + (size_t)mi * D * FF, FF, 32 * nb, scr, lane); continue; }
        r -= 4 * I_FO;
        if (r < I_AI) { const int kb = r / 72, nb = r % 72; tr_item(a.in[I_AWI], N_AI, 64 * kb, 32 * nb, 32, (bf16*)(ws + WS_WAI), D, 32 * nb, scr, lane); continue; }
        r -= I_AI;
        if (r < I_AO) { const int kb = r / 32, nb = r % 32; tr_item(a.in[I_AWO], D, 64 * kb, 32 * nb, 32, (bf16*)(ws + WS_WAO), D, 32 * nb, scr, lane); continue; }
        r -= I_AO;
        if (r < I_RI) { const int kb = r / 120, nb = r % 120, n0 = 32 * nb; int c0, nv;
            if (n0 < 2048) { c0 = n0; nv = 32; } else if (n0 < 3584) { c0 = n0 + 16; nv = 32; } else if (n0 == 3584) { c0 = 2048; nv = 16; } else { c0 = 0; nv = 0; }
            tr_item(a.in[I_RWI], N_RI_SRC, 64 * kb, c0, nv, (bf16*)(ws + WS_WRI), D, n0, scr, lane); continue; }
        r -= I_RI;
        { const int kb = r / 32, nb = r % 32; tr_item(a.in[I_RWO], D, 64 * kb, 32 * nb, 32, (bf16*)(ws + WS_WRO), D, 32 * nb, scr, lane); }
    }
    __syncthreads();
    {
        LAS float* sc = (LAS float*)lds;
        LAS float* red = (LAS float*)(lds + 36864);
        float* MOD = (float*)(ws + WS_MOD);
        if (blockIdx.x < 288) {
            for (int idx = tid; idx < 9216; idx += 512) { const int r = idx >> 10, k = idx & 1023; const float cv = (r < 8) ? a.in[I_C][r * 1024 + k] : a.in[I_CCTX][k]; sc[idx] = silu_f(cv); }
        }
        __syncthreads();
        for (int u = blockIdx.x; u < 288; u += G) {
            const int l = u / 144, ng = u % 144, n = 64 * ng + lane;
            const float* W = a.in[I_ADAW] + (size_t)l * D * 9216 + n;
            float acc[9];
#pragma unroll
            for (int r = 0; r < 9; ++r) acc[r] = 0.f;
#pragma unroll 8
            for (int kk = 0; kk < 128; ++kk) { const int k = wave * 128 + kk; const float wv = W[(size_t)k * 9216];
#pragma unroll
                for (int r = 0; r < 9; ++r) acc[r] += sc[r * 1024 + k] * wv; }
#pragma unroll
            for (int r = 0; r < 9; ++r) red[(wave * 9 + r) * 64 + lane] = acc[r];
            __syncthreads();
            for (int idx = tid; idx < 576; idx += 512) { const int r = idx >> 6, ln = idx & 63; float s = 0.f;
#pragma unroll
                for (int w = 0; w < 8; ++w) s += red[(w * 9 + r) * 64 + ln];
                MOD[(size_t)(l * 9 + r) * 9216 + 64 * ng + ln] = s + a.in[I_ADAB][l * 9216 + 64 * ng + ln]; }
            __syncthreads();
        }
    }
    if (blockIdx.x == 0) {
        float* cosT = (float*)(ws + WS_ROPE); float* sinT = cosT + 1024;
        for (int idx = tid; idx < 1024; idx += 512) { const int pos = idx >> 4, f = idx & 15; const float inv = powf(10000.0f, -(float)f / 16.0f); const float ang = (float)pos * inv;
            cosT[idx] = cosf(ang); sinT[idx] = sinf(ang); }
        if (wave == 0) { const float* dl = a.in[I_DLAM]; const float s1 = wave_sum(dl[lane] * dl[64 + lane]), s2 = wave_sum(dl[128 + lane] * dl[192 + lane]);
            if (lane == 0) *(float*)(ws + WS_LAM) = expf(s1) - expf(s2) + 0.2f; }
    }
}

__device__ __forceinline__ void p0b_modulate(const Args& a, int gw, int NGW, int lane) {
    const float* MOD = (const float*)(a.ws + WS_MOD); bf16* H = (bf16*)(a.ws + WS_H);
    for (int r = gw; r < M; r += NGW) {
        const float* xr = (r < ML) ? a.in[I_X] + (size_t)r * D : a.in[I_CTX] + (size_t)(r - ML) * D;
        const float* mp = MOD + (size_t)((r < ML) ? (r >> 12) : 8) * 9216;
#pragma unroll
        for (int j = 0; j < 4; ++j) { const int c = 4 * (lane + 64 * j); const f32x4 x = *(const f32x4*)(xr + c), sh = *(const f32x4*)(mp + c), sc = *(const f32x4*)(mp + 1024 + c);
            *(u32x2*)(H + (size_t)r * D + c) = pack4c(x * (sc + 1.0f) + sh); }
    }
}

__device__ __forceinline__ void ln_phase(float* out_l, float* out_c, const float* g, const float* bt, const float* modn, bf16* H, int nrows, int gw, int NGW, int lane) {
    f32x4 g4[4], b4[4];
#pragma unroll
    for (int j = 0; j < 4; ++j) { g4[j] = *(const f32x4*)(g + 4 * (lane + 64 * j)); b4[j] = *(const f32x4*)(bt + 4 * (lane + 64 * j)); }
    for (int r = gw; r < nrows; r += NGW) {
        float* zr = (r < ML) ? out_l + (size_t)r * D : out_c + (size_t)(r - ML) * D;
        f32x4 v[4]; float s = 0.f;
#pragma unroll
        for (int j = 0; j < 4; ++j) { v[j] = *(const f32x4*)(zr + 4 * (lane + 64 * j)); s += (v[j][0] + v[j][1]) + (v[j][2] + v[j][3]); }
        const float mean = wave_sum(s) * (1.f / D); float s2 = 0.f;
#pragma unroll
        for (int j = 0; j < 4; ++j) { v[j] = v[j] - mean; s2 += (v[j][0] * v[j][0] + v[j][1] * v[j][1]) + (v[j][2] * v[j][2] + v[j][3] * v[j][3]); }
        const float rstd = 1.0f / sqrtf(wave_sum(s2) * (1.f / D) + 1e-5f);
        const float* mp = modn ? modn + (size_t)((r < ML) ? (r >> 12) : 8) * 9216 : nullptr;
#pragma unroll
        for (int j = 0; j < 4; ++j) { const int c = 4 * (lane + 64 * j); const f32x4 y = v[j] * rstd * g4[j] + b4[j]; *(f32x4*)(zr + c) = y;
            if (mp) { const f32x4 sh = *(const f32x4*)(mp + c), sc = *(const f32x4*)(mp + 1024 + c); *(u32x2*)(H + (size_t)r * D + c) = pack4c(y * (sc + 1.0f) + sh); } }
    }
}
template <int NDV> struct AttW { f32x16 o[NDV]; float m, l; };

template <int NDV, bool MASK, int KPB>
__device__ __forceinline__ void attn_block_lds(AttW<NDV>& S, const bf16x8 (&qf)[4], LAS const unsigned char* Kl, LAS const unsigned char* Vl, int r, int h, int qpos, int kpos0) {
    f32x16 st;
#pragma unroll
    for (int i = 0; i < 16; ++i) st[i] = 0.f;
#pragma unroll
    for (int s = 0; s < 4; ++s) { const bf16x8 kf = *(LAS const bf16x8*)(Kl + r * KPB + 32 * s + 16 * h); st = mfma32(kf, qf[s], st); }
    if (MASK) {
#pragma unroll
        for (int i = 0; i < 16; ++i) { const int dlt = qpos - (kpos0 + crow(i, h)); if (dlt > 128 || dlt < -128) st[i] = -INFINITY; }
    }
    float mx = st[0];
#pragma unroll
    for (int i = 1; i < 16; ++i) mx = fmaxf(mx, st[i]);
    mx = fmaxf(mx, __shfl_xor(mx, 32));
    const float mn = fmaxf(S.m, mx), alpha = fexp2(S.m - mn);
    const bool same = (mn == S.m);
    S.m = mn;
    float ps = 0.f;
#pragma unroll
    for (int i = 0; i < 16; ++i) { st[i] = fexp2(st[i] - mn); ps += st[i]; }
    S.l = S.l * alpha + ps;
    if (!__all(same)) {
#pragma unroll
        for (int d = 0; d < NDV; ++d) S.o[d] = S.o[d] * alpha;
    }
    bf16x8 pf[2];
#pragma unroll
    for (int s2 = 0; s2 < 2; ++s2) { v4u w; w.x = cvtpk(st[8 * s2 + 0], st[8 * s2 + 1]); w.y = cvtpk(st[8 * s2 + 2], st[8 * s2 + 3]); w.z = cvtpk(st[8 * s2 + 4], st[8 * s2 + 5]); w.w = cvtpk(st[8 * s2 + 6], st[8 * s2 + 7]);
        pf[s2] = __builtin_bit_cast(bf16x8, w); }
#pragma unroll
    for (int s2 = 0; s2 < 2; ++s2)
#pragma unroll
        for (int d = 0; d < NDV; ++d) { LAS const unsigned char* vp = Vl + (32 * d + r) * 136 + 32 * s2 + 8 * h;
            const u32x2 lo = *(LAS const u32x2*)vp, hi = *(LAS const u32x2*)(vp + 16); v4u w; w.x = lo.x; w.y = lo.y; w.z = hi.x; w.w = hi.y;
            S.o[d] = mfma32(__builtin_bit_cast(bf16x8, w), pf[s2], S.o[d]); }
}

__device__ __forceinline__ void load_q(bf16x8 (&qf)[4], const bf16* Qp, int pitch, int r, int h) {
#pragma unroll
    for (int s = 0; s < 4; ++s) qf[s] = ldg16(Qp + (size_t)r * pitch + 16 * s + 8 * h);
}

template <bool DIFF> struct AttStage { v4u k[DIFF ? 2 : 1]; v4u v[DIFF ? 2 : 1]; };
template <bool DIFF>
__device__ __forceinline__ void att_gload(AttStage<DIFF>& R, const bf16* Kg, int kpitch, const bf16* Vg, int vpitch, int tid) {
    constexpr int NC = DIFF ? 2 : 1, KCH = DIFF ? 16 : 8;
#pragma unroll
    for (int i = 0; i < NC; ++i) { const int id = tid + 512 * i; R.k[i] = *(const v4u*)(Kg + (size_t)(id / KCH) * kpitch + (id % KCH) * 8); R.v[i] = *(const v4u*)(Vg + (size_t)(id >> 3) * vpitch + (id & 7) * 8); }
}
template <bool DIFF>
__device__ __forceinline__ void att_lstore(const AttStage<DIFF>& R, LAS unsigned char* Kl, LAS unsigned char* Vl, int tid) {
    constexpr int NC = DIFF ? 2 : 1, KCH = DIFF ? 16 : 8, KPB = DIFF ? 272 : 144;
#pragma unroll
    for (int i = 0; i < NC; ++i) { const int id = tid + 512 * i;
        *(LAS v4u*)(Kl + (id / KCH) * KPB + (id % KCH) * 16) = R.k[i];
        LAS unsigned char* vp = Vl + (id >> 3) * 136 + (id & 7) * 16;
        u32x2 a, b; a.x = R.v[i].x; a.y = R.v[i].y; b.x = R.v[i].z; b.y = R.v[i].w; *(LAS u32x2*)vp = a; *(LAS u32x2*)(vp + 8) = b; }
}

constexpr int ATT_UNITS = 2176;
constexpr int ATT_KB_D = 64 * 272, ATT_VB_D = 128 * 136, ATT_ST_D = ATT_KB_D + ATT_VB_D;
constexpr int ATT_KB_W = 64 * 144, ATT_VB_W = 64 * 136, ATT_ST_W = ATT_KB_W + ATT_VB_W;
__device__ __forceinline__ void attn_phase(const Args& a, LAS unsigned char* lds, int G, int vcu, int tid, int lane, int wave) {
    unsigned char* ws = a.ws;
    const bf16* AQ = (const bf16*)(ws + WS_AQ); const bf16* AK = (const bf16*)(ws + WS_AK); const bf16* BQ = (const bf16*)(ws + WS_BQ); const bf16* BK = (const bf16*)(ws + WS_BK);
    const bf16* VTA_L = (const bf16*)(ws + WS_VTA_L); const bf16* VTA_C = (const bf16*)(ws + WS_VTA_C); const bf16* VTB_L = (const bf16*)(ws + WS_VTB_L); const bf16* VTB_C = (const bf16*)(ws + WS_VTB_C);
    bf16* O = (bf16*)(ws + WS_H);
    const int r = lane & 31, h = lane >> 5;
    LAS float* X = (LAS float*)lds;
    for (int u = vcu; u < ATT_UNITS; u += G) {
        const bool isdiff = (u < 1024) || (u >= 2048 && u < 2112);
        if (isdiff) {
            const bool lat = u < 1024; const int uu = lat ? u : u - 2048;
            const int bh = lat ? (uu >> 5) : (uu >> 1), qb = lat ? (uu & 31) : (uu & 1), b = bh >> 2, hd = bh & 3;
            const int sub = wave & 1, qs = wave >> 1;
            const int qrow0 = (lat ? b * T : ML + b * TC) + qb * 128 + qs * 32;
            bf16x8 qf[4]; load_q(qf, AQ + (size_t)qrow0 * 512 + hd * 128 + sub * 64, 512, r, h);
            AttW<4> S;
#pragma unroll
            for (int d = 0; d < 4; ++d)
#pragma unroll
                for (int i = 0; i < 16; ++i) S.o[d][i] = 0.f;
            S.m = -1e30f; S.l = 0.f;
            const int NTL = lat ? T / 64 : 0, NT = NTL + TC / 64;
            const bf16* KL = AK + (size_t)(b * T) * 512 + hd * 128; const bf16* KC = AK + (size_t)(ML + b * TC) * 512 + hd * 128;
            const bf16* VL = VTA_L + (size_t)(b * 4 + hd) * 128 * T; const bf16* VC = VTA_C + (size_t)(b * 4 + hd) * 128 * TC;
            AttStage<true> R;
            { const bool c0 = NTL == 0; att_gload<true>(R, c0 ? KC : KL, 512, c0 ? VC : VL, c0 ? TC : T, tid); att_lstore<true>(R, lds, lds + ATT_KB_D, tid); }
            __syncthreads();
            for (int t = 0; t < NT; ++t) {
                const int tn = t + 1;
                if (tn < NT) { const bool c = tn >= NTL; const int tt = c ? tn - NTL : tn; att_gload<true>(R, (c ? KC : KL) + (size_t)tt * 64 * 512, 512, (c ? VC : VL) + tt * 64, c ? TC : T, tid); }
                LAS const unsigned char* Kl = lds + (t & 1) * ATT_ST_D + sub * 128; LAS const unsigned char* Vl = lds + (t & 1) * ATT_ST_D + ATT_KB_D;
                attn_block_lds<4, false, 272>(S, qf, Kl, Vl, r, h, 0, 0);
                attn_block_lds<4, false, 272>(S, qf, Kl + 32 * 272, Vl + 64, r, h, 0, 0);
                if (tn < NT) att_lstore<true>(R, lds + (tn & 1) * ATT_ST_D, lds + (tn & 1) * ATT_ST_D + ATT_KB_D, tid);
                __syncthreads();
            }
            const float lt = S.l + __shfl_xor(S.l, 32); const float inv = 1.0f / lt;
            if (sub == 1) { const float lam = *(const float*)(ws + WS_LAM); const float f = inv * lam;
#pragma unroll
                for (int d = 0; d < 4; ++d)
#pragma unroll
                    for (int i = 0; i < 16; ++i) X[(qs * 128 + 32 * d + crow(i, h)) * 32 + r] = S.o[d][i] * f; }
            __syncthreads();
            if (sub == 0) { float ss = 0.f;
#pragma unroll
                for (int d = 0; d < 4; ++d)
#pragma unroll
                    for (int i = 0; i < 16; ++i) { const float v = S.o[d][i] * inv - X[(qs * 128 + 32 * d + crow(i, h)) * 32 + r]; S.o[d][i] = v; ss += v * v; }
                ss += __shfl_xor(ss, 32);
                const float rs = 0.8f / sqrtf(ss * (1.0f / 128.0f) + 1e-5f);
                const float* gn = a.in[I_DNG];
                bf16* op = O + (size_t)(qrow0 + r) * D + hd * 128;
#pragma unroll
                for (int d = 0; d < 4; ++d)
#pragma unroll
                    for (int k4 = 0; k4 < 4; ++k4) { const int dv = 32 * d + 8 * k4 + 4 * h; const f32x4 g4 = *(const f32x4*)(gn + dv);
                        f32x4 v; v[0] = S.o[d][4 * k4] * rs * g4[0]; v[1] = S.o[d][4 * k4 + 1] * rs * g4[1]; v[2] = S.o[d][4 * k4 + 2] * rs * g4[2]; v[3] = S.o[d][4 * k4 + 3] * rs * g4[3];
                        *(u32x2*)(op + dv) = pack4c(v); }
            }
            __syncthreads();
        } else {
            const bool lat = u < 2048; const int uu = lat ? u - 1024 : u - 2112;
            const int bk = lat ? (uu >> 6) : (uu >> 2), qb = lat ? (uu & 63) : (uu & 3), b = bk >> 1, kvh = bk & 1;
            const int g4i = wave >> 1, qs = wave & 1, hd = kvh * 4 + g4i;
            const int t0 = qb * 64 + qs * 32;
            const int qrow0 = (lat ? b * T : ML + b * TC) + t0;
            bf16x8 qf[4]; load_q(qf, BQ + (size_t)qrow0 * 512 + hd * 64, 512, r, h);
            AttW<2> S;
#pragma unroll
            for (int d = 0; d < 2; ++d)
#pragma unroll
                for (int i = 0; i < 16; ++i) S.o[d][i] = 0.f;
            S.m = a.in[I_SINK][hd] * LOG2E; S.l = (h == 0) ? 1.0f : 0.0f;
            const int lo = lat ? ((qb * 64 - 128) < 0 ? 0 : (qb * 64 - 128)) : 0, hi = lat ? ((qb * 64 + 192) > T ? T : (qb * 64 + 192)) : 0;
            const int NTL = (hi - lo) / 64, NT = NTL + TC / 64;
            const bf16* KL = BK + (size_t)(b * T + lo) * 128 + kvh * 64; const bf16* KC = BK + (size_t)(ML + b * TC) * 128 + kvh * 64;
            const bf16* VL = VTB_L + (size_t)(b * 2 + kvh) * 64 * T + lo; const bf16* VC = VTB_C + (size_t)(b * 2 + kvh) * 64 * TC;
            AttStage<false> R;
            { const bool c0 = NTL == 0; att_gload<false>(R, c0 ? KC : KL, 128, c0 ? VC : VL, c0 ? TC : T, tid); att_lstore<false>(R, lds, lds + ATT_KB_W, tid); }
            __syncthreads();
            for (int t = 0; t < NT; ++t) {
                const int tn = t + 1;
                if (tn < NT) { const bool c = tn >= NTL; const int tt = c ? tn - NTL : tn; att_gload<false>(R, (c ? KC : KL) + (size_t)tt * 64 * 128, 128, (c ? VC : VL) + tt * 64, c ? TC : T, tid); }
                LAS const unsigned char* Kl = lds + (t & 1) * ATT_ST_W; LAS const unsigned char* Vl = lds + (t & 1) * ATT_ST_W + ATT_KB_W;
                if (t < NTL) { const int kp = lo + t * 64;
                    attn_block_lds<2, true, 144>(S, qf, Kl, Vl, r, h, t0 + r, kp);
                    attn_block_lds<2, true, 144>(S, qf, Kl + 32 * 144, Vl + 64, r, h, t0 + r, kp + 32);
                } else {
                    attn_block_lds<2, false, 144>(S, qf, Kl, Vl, r, h, 0, 0);
                    attn_block_lds<2, false, 144>(S, qf, Kl + 32 * 144, Vl + 64, r, h, 0, 0);
                }
                if (tn < NT) att_lstore<false>(R, lds + (tn & 1) * ATT_ST_W, lds + (tn & 1) * ATT_ST_W + ATT_KB_W, tid);
                __syncthreads();
            }
            const float lt = S.l + __shfl_xor(S.l, 32); const float inv = 1.0f / lt;
            bf16* op = O + (size_t)(qrow0 + r) * D + 512 + hd * 64;
#pragma unroll
            for (int d = 0; d < 2; ++d)
#pragma unroll
                for (int k4 = 0; k4 < 4; ++k4) { const int dv = 32 * d + 8 * k4 + 4 * h;
                    f32x4 v; v[0] = S.o[d][4 * k4] * inv; v[1] = S.o[d][4 * k4 + 1] * inv; v[2] = S.o[d][4 * k4 + 2] * inv; v[3] = S.o[d][4 * k4 + 3] * inv;
                    *(u32x2*)(op + dv) = pack4c(v); }
        }
    }
}
constexpr int SC_K = 0;
constexpr int SC_V = 34816;
constexpr int SC_CT = SC_V + 17408;
constexpr int SC_S = SC_CT + 21760;
constexpr int SC_AL = SC_S + 8 * 4352;
constexpr int SC_CH = SC_AL + 1536;
static_assert(SC_CH + 4 * 128 <= RING_BYTES, "scan LDS");
constexpr size_t WS_SCAL = 500 * MiB;

template <int DK> struct ScanStage { v4u k[DK / 32]; v4u v[2]; float sc; };

template <int DK, bool MLSTM>
__device__ __forceinline__ void scan_gload(ScanStage<DK>& R, bf16x8 (&qf)[DK / 32], bf16x8 (&ktf)[4], const bf16* Krow, int RP, const bf16* Qrow, const bf16* Vt, const bf16* Kt, int tp, const float* scal, bool isctx, int tid, int wave, int c, int g, int dkt) {
    constexpr int KCH = DK / 8, NCK = DK / 32;
    if (!isctx) {
#pragma unroll
        for (int i = 0; i < NCK; ++i) { const int id = tid + 512 * i; R.k[i] = *(const v4u*)(Krow + (size_t)(id / KCH) * RP + (id % KCH) * 8); }
#pragma unroll
        for (int ks = 0; ks < DK / 32; ++ks) qf[ks] = ldg16(Qrow + (size_t)(16 * wave + c) * RP + 32 * ks + 8 * g);
    }
#pragma unroll
    for (int i = 0; i < 2; ++i) { const int id = tid + 512 * i; R.v[i] = *(const v4u*)(Vt + (size_t)(id >> 4) * tp + (id & 15) * 8); }
#pragma unroll
    for (int ks2 = 0; ks2 < 4; ++ks2) ktf[ks2] = ldg16(Kt + (size_t)(16 * dkt + c) * tp + 32 * ks2 + 8 * g);
    if (MLSTM) { if (tid < 384) R.sc = __hip_atomic_load(scal + (tid >> 7) * 4352 + (tid & 127), __ATOMIC_RELAXED, __HIP_MEMORY_SCOPE_AGENT); }
}
template <int DK, bool MLSTM>
__device__ __forceinline__ void scan_lstore(const ScanStage<DK>& R, LAS unsigned char* lds, bool isctx, int tid) {
    constexpr int KCH = DK / 8, NCK = DK / 32, KPB = DK * 2 + 16;
    if (!isctx) {
#pragma unroll
        for (int i = 0; i < NCK; ++i) { const int id = tid + 512 * i; *(LAS v4u*)(lds + SC_K + (id / KCH) * KPB + (id % KCH) * 16) = R.k[i]; }
    }
#pragma unroll
    for (int i = 0; i < 2; ++i) { const int id = tid + 512 * i; *(LAS v4u*)(lds + SC_V + (id >> 4) * 272 + (id & 15) * 16) = R.v[i]; }
    if (MLSTM) { if (tid < 384) ((LAS float*)(lds + SC_AL))[tid] = R.sc; }
}

template <int DK, bool MLSTM>
__device__ __forceinline__ void scan_chain(const Args& a, LAS unsigned char* lds, int unit, int b, int hd, int dir, int half, int tid, int lane, int wave) {
    unsigned char* ws = a.ws;
    constexpr int KS = DK / 32, KPB = DK * 2 + 16, NT2 = MLSTM ? 5 : 4, NOWN = MLSTM ? 5 : 2;
    const int c = lane & 15, g = lane >> 4;
    constexpr int RP = MLSTM ? 512 : 256;
    const bf16* Qr = MLSTM ? (const bf16*)(ws + WS_MQ) + hd * 128 : (const bf16*)(ws + WS_RQ) + hd * 64;
    const bf16* Kr = MLSTM ? (const bf16*)(ws + WS_MK) + hd * 128 : (const bf16*)(ws + WS_RK) + hd * 64;
    const bf16* KtL = MLSTM ? (const bf16*)(ws + WS_MKT_L) + (size_t)(b * 4 + hd) * 128 * T : (const bf16*)(ws + WS_RKT_L) + (size_t)(b * 4 + hd) * 64 * T;
    const bf16* KtC = MLSTM ? (const bf16*)(ws + WS_MKT_C) + (size_t)(b * 4 + hd) * 128 * TC : (const bf16*)(ws + WS_RKT_C) + (size_t)(b * 4 + hd) * 64 * TC;
    const bf16* VtL = (MLSTM ? (const bf16*)(ws + WS_MVT_L) : (const bf16*)(ws + WS_RVT_L)) + (size_t)((b * 4 + hd) * 128 + half * 64) * T;
    const bf16* VtC = (MLSTM ? (const bf16*)(ws + WS_MVT_C) : (const bf16*)(ws + WS_RVT_C)) + (size_t)((b * 4 + hd) * 128 + half * 64) * TC;
    bf16* OUT = (bf16*)(ws + (dir == 0 ? WS_H : WS_HB)) + (MLSTM ? hd * 128 : 512 + hd * 128) + half * 64;
    float* SCAL = (float*)(ws + WS_SCAL) + (size_t)unit * 3 * 4352;
    LAS bf16* CT = (LAS bf16*)(lds + SC_CT);
    LAS unsigned char* Sw = lds + SC_S + wave * 4352;
    LAS float* sa = (LAS float*)(lds + SC_AL); LAS float* sb = sa + 128; LAS float* sg = sa + 256;
    LAS float* mch = (LAS float*)(lds + SC_CH); LAS float* bend = mch + 36; LAS float* gend = bend + 34;
    const bool fwd = dir == 0;
    for (int i = tid; i < 80 * KPB / 4; i += 512) ((LAS unsigned*)CT)[i] = 0u;
    float lg = 0.f;
    if (MLSTM) {
        const float* GATE = (const float*)(ws + WS_GATE);
        for (int ci = wave; ci < 34; ci += 8) {
            const int rowb = (ci < 2) ? (ML + b * TC + ci * 128) : (b * T + (ci - 2) * 128), pb = ci * 128;
            const int u0 = 2 * lane, u1 = 2 * lane + 1, i0 = fwd ? u0 : 127 - u0, i1 = fwd ? u1 : 127 - u1;
            const float f0 = GATE[(size_t)(rowb + i0) * 16 + dir * 8 + 4 + hd], f1 = GATE[(size_t)(rowb + i1) * 16 + dir * 8 + 4 + hd];
            const float p0 = GATE[(size_t)(rowb + i0) * 16 + dir * 8 + hd], p1 = GATE[(size_t)(rowb + i1) * 16 + dir * 8 + hd];
            float s = f0 + f1;
#pragma unroll
            for (int o = 1; o < 64; o <<= 1) { const float t = __shfl_up(s, o); if (lane >= o) s += t; }
            const float b1 = s, b0 = s - f1, a0 = p0 - b0, a1 = p1 - b1;
            float pm = fmaxf(a0, a1);
#pragma unroll
            for (int o = 1; o < 64; o <<= 1) { const float t = __shfl_up(pm, o); if (lane >= o) pm = fmaxf(pm, t); }
            float ex = __shfl_up(pm, 1); if (lane == 0) ex = -INFINITY;
            const float g0 = fmaxf(ex, a0), g1 = pm;
            SCAL[pb + i0] = a0; SCAL[pb + i1] = a1; SCAL[4352 + pb + i0] = b0; SCAL[4352 + pb + i1] = b1; SCAL[8704 + pb + i0] = g0; SCAL[8704 + pb + i1] = g1;
            if (lane == 63) { bend[ci] = b1; gend[ci] = g1; }
        }
        __threadfence();
        __syncthreads();
        if (tid == 0) { float m = 0.f;
            for (int s = 0; s < 34; ++s) { const int ci = fwd ? s : (s < 2 ? 1 - s : 35 - s); mch[s] = m; m = bend[ci] + fmaxf(m, gend[ci]); }
            mch[34] = m; }
    } else {
        const float x = a.in[I_RDL][dir * 4 + hd]; lg = fminf(x, 0.f) - log1pf(__expf(-fabsf(x)));
    }
    const int dkt = MLSTM ? wave : (wave & 3), dv0 = MLSTM ? 0 : 2 * (wave >> 2);
    f32x4 ct[NOWN];
#pragma unroll
    for (int t = 0; t < NOWN; ++t) ct[t] = (f32x4){0.f, 0.f, 0.f, 0.f};
    bf16x8 ones; { const short o1 = (c == 0) ? (short)0x3F80 : (short)0; ones = (bf16x8){o1, o1, o1, o1, o1, o1, o1, o1}; }

    ScanStage<DK> R; bf16x8 qf[KS], qf_n[KS], ktf[4], ktf_n[4];
#define SCAN_SRC(s_, ci_, isctx_, rowb_, tp_, Kt_, Vt_) \
        const int ci_ = fwd ? (s_) : ((s_) < 2 ? 1 - (s_) : 35 - (s_)); const bool isctx_ = ci_ < 2; \
        const int rowb_ = isctx_ ? (ML + b * TC + ci_ * 128) : (b * T + (ci_ - 2) * 128); const int tp_ = isctx_ ? TC : T; \
        const bf16* Kt_ = isctx_ ? KtC + ci_ * 128 : KtL + (ci_ - 2) * 128; const bf16* Vt_ = isctx_ ? VtC + ci_ * 128 : VtL + (ci_ - 2) * 128;
    { SCAN_SRC(0, ci0, ic0, rb0, tp0, Kt0, Vt0)
      scan_gload<DK, MLSTM>(R, qf_n, ktf_n, Kr + (size_t)rb0 * RP, RP, Qr + (size_t)rb0 * RP, Vt0, Kt0, tp0, SCAL + ci0 * 128, ic0, tid, wave, c, g, dkt); }

    for (int s = 0; s < 34; ++s) {
        SCAN_SRC(s, ci, isctx, rowb, tp, Kt, Vt)
        (void)tp; (void)Kt; (void)Vt;
        __syncthreads();
        scan_lstore<DK, MLSTM>(R, lds, isctx, tid);
#pragma unroll
        for (int ks = 0; ks < KS; ++ks) qf[ks] = qf_n[ks];
#pragma unroll
        for (int k = 0; k < 4; ++k) ktf[k] = ktf_n[k];
        __syncthreads();
        if (s + 1 < 34) { SCAN_SRC(s + 1, ci1, ic1, rb1, tp1, Kt1, Vt1)
            scan_gload<DK, MLSTM>(R, qf_n, ktf_n, Kr + (size_t)rb1 * RP, RP, Qr + (size_t)rb1 * RP, Vt1, Kt1, tp1, SCAL + ci1 * 128, ic1, tid, wave, c, g, dkt); }
        float m_c = 0.f, m_new = 0.f, b_end = 0.f;
        if (MLSTM) { m_c = mch[s]; m_new = mch[s + 1]; b_end = bend[ci]; }
        if (!isctx) {
            const int q = 16 * wave + c;
            float gq = 0.f; if (MLSTM) gq = fmaxf(m_c, sg[q]);
#pragma unroll 2
            for (int jt = 0; jt < 8; ++jt) {
                f32x4 acc = (f32x4){0.f, 0.f, 0.f, 0.f};
#pragma unroll
                for (int ks = 0; ks < KS; ++ks) acc = mfma16(*(LAS const bf16x8*)(lds + SC_K + (16 * jt + c) * KPB + 64 * ks + 16 * g), qf[ks], acc);
                f32x4 v;
#pragma unroll
                for (int e = 0; e < 4; ++e) { const int j = 16 * jt + 4 * g + e; const bool ok = fwd ? (j <= q) : (j >= q);
                    float dm;
                    if (MLSTM) dm = fexp(sa[j] - gq); else dm = fexp(lg * (float)(fwd ? (q - j) : (j - q)));
                    v[e] = ok ? acc[e] * dm : 0.f; }
                *(LAS u32x2*)(Sw + c * 272 + 32 * jt + 8 * g) = pack4c(v);
            }
            LDS_WAIT();
            f32x4 nt[NT2];
#pragma unroll
            for (int t = 0; t < NT2; ++t) nt[t] = (f32x4){0.f, 0.f, 0.f, 0.f};
#pragma unroll
            for (int ks2 = 0; ks2 < 4; ++ks2) {
                const bf16x8 sf = *(LAS const bf16x8*)(Sw + c * 272 + 64 * ks2 + 16 * g);
#pragma unroll
                for (int t = 0; t < 4; ++t) nt[t] = mfma16(*(LAS const bf16x8*)(lds + SC_V + (16 * t + c) * 272 + 64 * ks2 + 16 * g), sf, nt[t]);
                if (MLSTM) nt[NT2 - 1] = mfma16(ones, sf, nt[NT2 - 1]);
            }
            const float wi = MLSTM ? fexp(m_c - gq) : fexp(lg * (float)(fwd ? (q + 1) : (128 - q)));
#pragma unroll
            for (int ks = 0; ks < KS; ++ks) {
                const bf16x8 qs = scale8u(qf[ks], wi);
#pragma unroll
                for (int t = 0; t < NT2; ++t) nt[t] = mfma16(*(LAS const bf16x8*)(lds + SC_CT + (16 * t + c) * KPB + 64 * ks + 16 * g), qs, nt[t]);
            }
            float inv = 1.f;
            if (MLSTM) { const float den = __shfl(nt[NT2 - 1][0], c); const float fl = fexp(-(sb[q] + gq)); inv = 1.0f / fmaxf(fabsf(den), fl); }
            bf16* op = OUT + (size_t)(rowb + q) * D + 4 * g;
#pragma unroll
            for (int t = 0; t < 4; ++t) *(u32x2*)(op + 16 * t) = pack4c(nt[t] * inv);
            __syncthreads();
        }
        const float decay = MLSTM ? fexp(b_end + m_c - m_new) : fexp(lg * 128.0f);
#pragma unroll
        for (int t = 0; t < NOWN; ++t) ct[t] = ct[t] * decay;
#pragma unroll
        for (int ks2 = 0; ks2 < 4; ++ks2) {
            f32x4 w0, w1;
#pragma unroll
            for (int e = 0; e < 4; ++e) { const int j0 = 32 * ks2 + 8 * g + e, j1 = j0 + 4;
                if (MLSTM) { w0[e] = fexp(sa[j0] + b_end - m_new); w1[e] = fexp(sa[j1] + b_end - m_new); }
                else { w0[e] = fexp(lg * (float)(fwd ? (127 - j0) : j0)); w1[e] = fexp(lg * (float)(fwd ? (127 - j1) : j1)); } }
            const bf16x8 kf = scale8v(ktf[ks2], w0, w1);
#pragma unroll
            for (int t = 0; t < NOWN; ++t) {
                const bool ext = MLSTM && (t == 4);
                const bf16x8 vf = ext ? ones : *(LAS const bf16x8*)(lds + SC_V + (16 * (dv0 + t) + c) * 272 + 64 * ks2 + 16 * g);
                ct[t] = mfma16(kf, vf, ct[t]);
            }
        }
#pragma unroll
        for (int t = 0; t < NOWN; ++t) *(LAS u32x2*)(lds + SC_CT + (16 * (dv0 + t) + c) * KPB + 32 * dkt + 8 * g) = pack4c(ct[t]);
    }
#undef SCAN_SRC
}

constexpr int SCAN_UNITS = 256;
__device__ __forceinline__ void scan_phase(const Args& a, LAS unsigned char* lds, int G, int vcu, int tid, int lane, int wave) {
    for (int u = vcu; u < SCAN_UNITS; u += G) {
        const int uu = u & 127, b = uu >> 4, hd = (uu >> 2) & 3, dir = (uu >> 1) & 1, half = uu & 1;
        if (u < 128) scan_chain<128, true>(a, lds, uu, b, hd, dir, half, tid, lane, wave);
        else scan_chain<64, false>(a, lds, uu, b, hd, dir, half, tid, lane, wave);
        __syncthreads();
    }
}

__device__ __forceinline__ void rec_merge_phase(const Args& a, int gw, int NGW, int lane) {
    unsigned char* ws = a.ws;
    bf16* HF = (bf16*)(ws + WS_H); const bf16* HB = (const bf16*)(ws + WS_HB); const bf16* MO = (const bf16*)(ws + WS_MO); const bf16* RG = (const bf16*)(ws + WS_RG);
    const int col = 16 * lane; const bool ism = lane < 32;
    for (int r = gw; r < ML; r += NGW) {
        const v4u f0 = *(const v4u*)(HF + (size_t)r * D + col), f1 = *(const v4u*)(HF + (size_t)r * D + col + 8), b0 = *(const v4u*)(HB + (size_t)r * D + col), b1 = *(const v4u*)(HB + (size_t)r * D + col + 8);
        const bf16* gp = ism ? MO + (size_t)r * 512 + col : RG + (size_t)r * 512 + (col - 512);
        const v4u g0 = *(const v4u*)gp, g1 = *(const v4u*)(gp + 8);
        float v[16], gt[16];
#pragma unroll
        for (int k = 0; k < 4; ++k) { v[2 * k] = bflo(f0[k]) + bflo(b0[k]); v[2 * k + 1] = bfhi(f0[k]) + bfhi(b0[k]); v[8 + 2 * k] = bflo(f1[k]) + bflo(b1[k]); v[8 + 2 * k + 1] = bfhi(f1[k]) + bfhi(b1[k]);
            gt[2 * k] = bflo(g0[k]); gt[2 * k + 1] = bfhi(g0[k]); gt[8 + 2 * k] = bflo(g1[k]); gt[8 + 2 * k + 1] = bfhi(g1[k]); }
        float s = 0.f;
#pragma unroll
        for (int k = 0; k < 16; ++k) s += v[k];
        s += __shfl_xor(s, 1); s += __shfl_xor(s, 2); s += __shfl_xor(s, 4);
        const float mean = s * (1.0f / 128.0f); float q = 0.f;
#pragma unroll
        for (int k = 0; k < 16; ++k) { v[k] -= mean; q += v[k] * v[k]; }
        q += __shfl_xor(q, 1); q += __shfl_xor(q, 2); q += __shfl_xor(q, 4);
        const float rstd = 1.0f / sqrtf(q * (1.0f / 128.0f) + 1e-5f);
        const float* gn = ism ? a.in[I_MNG] + col : a.in[I_RNG] + (col - 512);
        const float* bn = a.in[I_RNB] + (ism ? 0 : col - 512);
        float o[16];
#pragma unroll
        for (int k = 0; k < 16; ++k) { float y = v[k] * rstd * gn[k]; if (!ism) y += bn[k]; o[k] = y * gt[k]; }
        v4u w0, w1;
#pragma unroll
        for (int k = 0; k < 4; ++k) { w0[k] = cvtpk(o[2 * k], o[2 * k + 1]); w1[k] = cvtpk(o[8 + 2 * k], o[8 + 2 * k + 1]); }
        *(v4u*)(HF + (size_t)r * D + col) = w0; *(v4u*)(HF + (size_t)r * D + col + 8) = w1;
    }
}
typedef const __attribute__((address_space(4))) Args* kargp;
__device__ __forceinline__ Args phase_args() {
    kargp p = (kargp)__builtin_amdgcn_kernarg_segment_ptr(); asm volatile("" : "+s"(p));
    Args la;
#pragma unroll
    for (int i = 0; i < 22; ++i) la.in[i] = p->in[i];
    la.out = p->out; la.ws = p->ws; la.ph_lo = p->ph_lo; la.ph_hi = p->ph_hi; return la;
}
#ifndef PH_MASK
#define PH_MASK 0x7ff
#endif
#define EN(k) (((PH_MASK) >> (k)) & 1)
#ifndef REP_FFN1
#define REP_FFN1 1
#endif
#ifndef REP_ATT
#define REP_ATT 1
#endif
#ifndef REP_SCAN
#define REP_SCAN 1
#endif
#define PH_LANE() int ptid = threadIdx.x; asm volatile("" : "+v"(ptid)); const int tid = ptid, lane = ptid & 63, wave = __builtin_amdgcn_readfirstlane(ptid >> 6); const int gw = vcu * NWAVES + wave; (void)tid; (void)lane; (void)gw

__global__ void __launch_bounds__(NWAVES * 64, 2) mk_fwd(Args a_unused) {
    extern __shared__ __attribute__((aligned(16))) unsigned char lds_raw[];
    LAS unsigned char* lds = (LAS unsigned char*)lds_raw;
    volatile LAS unsigned* MISC = (volatile LAS unsigned*)(lds + MISC_OFF);
    const int tid = threadIdx.x, lane = tid & 63, wave = __builtin_amdgcn_readfirstlane(tid >> 6);
    const int G = gridDim.x; int vcu; { const int bx = blockIdx.x; vcu = (G % 8 == 0) ? (bx % 8) * (G / 8) + bx / 8 : bx; }
    const int NGW = G * NWAVES;
    for (int u = tid; u < (LDS_BYTES - LDSCTL_OFF) / 4; u += NWAVES * 64) ((LAS unsigned*)(lds + LDSCTL_OFF))[u] = 0u;
    __syncthreads();
    int lo, hi; XcdBarrier bar;
    { const Args pa = phase_args(); PH_LANE(); lo = pa.ph_lo; hi = pa.ph_hi; gu32* ctl = (gu32*)(pa.ws + WS_CTL);
      bar.bar = (unsigned*)(ctl + CW_BAR); bar.x = 0; bar.st = nullptr;
      if (!MK_PER_PHASE) bar = xcd_barrier_post((unsigned*)(ctl + CW_BAR), MISC + 8); }
#define IN(k) (lo <= (k) && (k) < hi)
#define SEAM(k) do { if (IN(k) && IN((k) + 1)) { if (MK_PER_PHASE) { if (tid == 0) __hip_atomic_store((gu32*)bar.bar - CW_BAR + CW_TMO, 0xBADBA0u, RLX_AGENT); } else xcd_barrier(bar); } } while (0)
    int kD = D, kFF = FF; asm volatile("" : "+s"(kD), "+s"(kFF));

    if (EN(0) && IN(0)) { const Args pa = phase_args(); PH_LANE(); p0a_prologue(pa, lds, G, vcu, tid, lane, wave); } SEAM(0);
    if (EN(1) && IN(1)) { const Args pa = phase_args(); PH_LANE(); p0b_modulate(pa, gw, NGW, lane); } SEAM(1);

    for (int l = 0; l < 2; ++l) {
        const int pb = 2 + 11 * l;
        const int rows_post = (l == 0) ? M : ML;
#pragma unroll
        for (int j = 0; j < 2; ++j) {
            const int p0 = pb + (j == 0 ? 0 : 8);
            const int rows = (j == 0) ? M : rows_post;
            if (EN(2) && IN(p0)) {
                const Args pa = phase_args(); PH_LANE(); unsigned char* ws = pa.ws;
                pg8::Gemm g{(const bf16*)(ws + WS_H), (const bf16*)(ws + WS_WFI) + (size_t)(l * 2 + j) * N_FI * D, rows, N_FI, kD}; pg8::StaticOrder S; S.init(rows, N_FI, G, (int)blockIdx.x);
                EpiSwiglu E{(bf16*)(ws + WS_ACT)};
                for (int rep = 0; rep < REP_FFN1; ++rep) { pg8::gemm_phase<EpiSwiglu, pg8::StaticOrder, true, true>(lds, g, S, E); __syncthreads(); }
            }
            SEAM(p0);
            if (EN(3) && IN(p0 + 1)) {
                const Args pa = phase_args(); PH_LANE(); unsigned char* ws = pa.ws;
                const int s = (j == 0) ? 0 : 2;
                pg8::Gemm g{(const bf16*)(ws + WS_ACT), (const bf16*)(ws + WS_WFO) + (size_t)(l * 2 + j) * D * FF, rows, D, kFF}; pg8::StaticOrder S; S.init(rows, D, G, (int)blockIdx.x);
                const bool first = (l == 0 && j == 0);
                float* XC = (float*)(ws + WS_XC);
                EpiResid E{first ? pa.in[I_X] : pa.out, first ? pa.in[I_CTX] : XC, pa.out, XC, (const float*)(ws + WS_MOD) + (size_t)l * 9 * 9216 + (s * 3 + 2) * 1024, 0.5f};
                pg8::gemm_phase<EpiResid, pg8::StaticOrder, true, true>(lds, g, S, E);
            }
            SEAM(p0 + 1);
            if (EN(4) && IN(p0 + 2)) {
                const Args pa = phase_args(); PH_LANE(); unsigned char* ws = pa.ws;
                const int s = (j == 0) ? 0 : 2;
                const float* MOD = (const float*)(ws + WS_MOD);
                const float* modn = nullptr;
                if (j == 0) modn = MOD + (size_t)l * 9 * 9216 + (1 * 3) * 1024; else if (l == 0) modn = MOD + (size_t)1 * 9 * 9216;
                ln_phase(pa.out, (float*)(ws + WS_XC), pa.in[I_LNG] + (l * 3 + s) * D, pa.in[I_LNB] + (l * 3 + s) * D, modn, (bf16*)(ws + WS_H), rows, gw, NGW, lane);
            }
            if (!(l == 1 && j == 1)) SEAM(p0 + 2);
            if (j == 0) {
                if (IN(pb + 3)) {
                    if (EN(5) && l == 0) {
                        const Args pa = phase_args(); PH_LANE(); unsigned char* ws = pa.ws;
                        pg8::Gemm g{(const bf16*)(ws + WS_H), (const bf16*)(ws + WS_WAI), M, N_AI, kD}; pg8::StaticOrder S; S.init(M, N_AI, G, (int)blockIdx.x);
                        EpiAttnIn E{ws};
                        pg8::gemm_phase<EpiAttnIn, pg8::StaticOrder, true, true>(lds, g, S, E);
                    }
                    if (EN(6) && l == 1) {
                        const Args pa = phase_args(); PH_LANE(); unsigned char* ws = pa.ws;
                        pg8::Gemm g{(const bf16*)(ws + WS_H), (const bf16*)(ws + WS_WRI), M, N_RI, kD}; pg8::StaticOrder S; S.init(M, N_RI, G, (int)blockIdx.x);
                        EpiRecIn E{ws, pa.in[I_MGB]};
                        pg8::gemm_phase<EpiRecIn, pg8::StaticOrder, true, true>(lds, g, S, E);
                    }
                }
                SEAM(pb + 3);
                if (IN(pb + 4)) {
                    if (EN(7) && l == 0) { for (int rep = 0; rep < REP_ATT; ++rep) { const Args pa = phase_args(); PH_LANE(); attn_phase(pa, lds, G, vcu, tid, lane, wave); __syncthreads(); } }
                    if (EN(8) && l == 1) { for (int rep = 0; rep < REP_SCAN; ++rep) { const Args pa = phase_args(); PH_LANE(); scan_phase(pa, lds, G, vcu, tid, lane, wave); __syncthreads(); } }
                }
                SEAM(pb + 4);
                if (EN(9) && IN(pb + 5)) { if (l == 1) { const Args pa = phase_args(); PH_LANE(); rec_merge_phase(pa, gw, NGW, lane); } }
                SEAM(pb + 5);
                if (EN(10) && IN(pb + 6)) {
                    const Args pa = phase_args(); PH_LANE(); unsigned char* ws = pa.ws;
                    pg8::Gemm g{(const bf16*)(ws + WS_H), (const bf16*)(ws + (l == 0 ? WS_WAO : WS_WRO)), rows_post, D, kD}; pg8::StaticOrder S; S.init(rows_post, D, G, (int)blockIdx.x);
                    float* XC = (float*)(ws + WS_XC);
                    EpiResid E{pa.out, XC, pa.out, XC, (const float*)(ws + WS_MOD) + (size_t)l * 9 * 9216 + (1 * 3 + 2) * 1024, 1.0f};
                    pg8::gemm_phase<EpiResid, pg8::StaticOrder, true, true>(lds, g, S, E);
                }
                SEAM(pb + 6);
                if (EN(4) && IN(pb + 7)) {
                    const Args pa = phase_args(); PH_LANE(); unsigned char* ws = pa.ws;
                    ln_phase(pa.out, (float*)(ws + WS_XC), pa.in[I_LNG] + (l * 3 + 1) * D, pa.in[I_LNB] + (l * 3 + 1) * D, (const float*)(ws + WS_MOD) + (size_t)l * 9 * 9216 + (2 * 3) * 1024, (bf16*)(ws + WS_H), rows_post, gw, NGW, lane);
                }
                SEAM(pb + 7);
            }
        }
    }
#undef IN
#undef SEAM
}

#ifdef DBG_DUMP
__global__ void dbg_dump(const unsigned short* A, const unsigned short* B, const unsigned short* C, size_t n, float* out) {
    const size_t i = (size_t)blockIdx.x * 256 + threadIdx.x;
    float v = 0.f;
    if (i < n) { if (A) v += __uint_as_float(((unsigned)A[i]) << 16); if (B) v += 2.0f * __uint_as_float(((unsigned)B[i]) << 16); if (C) v += 4.0f * __uint_as_float(((unsigned)C[i]) << 16); }
    out[i] = v;
}
#endif
extern "C" void kernel_launch(void* const* d_in, const int* in_sizes, int n_in, void* d_out, int out_size, void* d_ws, size_t ws_size, hipStream_t stream) {
    static int grid = 0;
    if (grid == 0) {
        if (n_in != 22 || in_sizes[0] != ML * D || out_size != ML * D || ws_size < WS_END + 8 * MiB) { fprintf(stderr, "kernel_launch: unexpected shapes (n_in %d, in0 %d, out %d, ws %zu)\n", n_in, n_in > 0 ? in_sizes[0] : -1, out_size, ws_size); grid = -1; return; }
        int dev = 0, cus = 0, per_cu = 0;
        if (hipGetDevice(&dev) != hipSuccess || hipDeviceGetAttribute(&cus, hipDeviceAttributeMultiprocessorCount, dev) != hipSuccess) { grid = -1; return; }
        if (hipFuncSetAttribute((const void*)mk_fwd, hipFuncAttributeMaxDynamicSharedMemorySize, LDS_BYTES) != hipSuccess) { fprintf(stderr, "kernel_launch: hipFuncSetAttribute failed\n"); grid = -1; return; }
        if (hipOccupancyMaxActiveBlocksPerMultiprocessor(&per_cu, (const void*)mk_fwd, NWAVES * 64, LDS_BYTES) != hipSuccess || per_cu < 1) fprintf(stderr, "kernel_launch: occupancy query reports %d\n", per_cu);
        (void)hipGetLastError();
        grid = cus;
    }
    if (grid < 0) return;
    if (hipMemsetAsync((char*)d_ws + WS_CTL, 0, CTL_ZERO_BYTES, stream) != hipSuccess) return;
    Args a{};
    for (int i = 0; i < 22; ++i) a.in[i] = (const float*)d_in[i];
    a.out = (float*)d_out; a.ws = (unsigned char*)d_ws;
#if MK_PER_PHASE
    for (int p = 0; p < MK_STOP; ++p) { a.ph_lo = p; a.ph_hi = p + 1; hipLaunchKernelGGL(mk_fwd, dim3(grid), dim3(NWAVES * 64), LDS_BYTES, stream, a); }
#ifdef DBG_DUMP
    hipLaunchKernelGGL(dbg_dump, dim3(ML * D / 256), dim3(256), 0, stream, DBG_A ? (const unsigned short*)((char*)d_ws + DBG_A) : nullptr, DBG_B ? (const unsigned short*)((char*)d_ws + DBG_B) : nullptr, DBG_C ? (const unsigned short*)((char*)d_ws + DBG_C) : nullptr, (size_t)DBG_N, (float*)d_out);
#endif
#else
    a.ph_lo = 0; a.ph_hi = MK_STOP;
    hipLaunchKernelGGL(mk_fwd, dim3(grid), dim3(NWAVES * 64), LDS_BYTES, stream, a);
#endif
}
```

```cpp
#include <hip/hip_runtime.h>
#include <cstdio>
#include <cstdint>
namespace pg8 {
#define PG8_LAS __attribute__((address_space(3)))
typedef unsigned short bf16_t;
typedef short bf16x8 __attribute__((ext_vector_type(8)));
typedef float f32x4 __attribute__((ext_vector_type(4)));
typedef unsigned u32x4 __attribute__((ext_vector_type(4)));
constexpr int BM = 256, BK = 64, HALF = 128, HTB = HALF * BK * 2  , STAGE_BYTES = 8 * HTB, NXCD = 8, WGM = 8;

__host__ __device__ __forceinline__ int lds_byte(int r, int c) { const int st = (r >> 4) * 2 + (c >> 5), rr = r & 15, cc = c & 31, ob = rr * 64 + cc * 2; return st * 1024 + (ob ^ (((ob >> 9) & 1) << 5)); }
__host__ __device__ __forceinline__ void stage_rc(int b, int& R, int& C) { const int st = b / 1024, sb = b % 1024, swz = sb ^ (((sb >> 9) & 1) << 5); R = (st >> 1) * 16 + swz / 64; C = (st & 1) * 32 + (swz % 64) / 2; }
__host__ __device__ __forceinline__ int perm32(int rho) { const int n = rho >> 4, i = rho & 15; return 8 * (i >> 2) + 4 * n + (i & 3); }

struct Unit { int pm, pn, ks; };
struct Gemm { const bf16_t* A; const bf16_t* Bt; int M, N, K, ld; };

struct StaticOrder {
    int nM, nN, nwg, G, c;
    __host__ __device__ void init(int M, int N, int G_, int c_) { nM = M / BM; nN = N / BM; nwg = nM * nN; G = G_; c = c_; }
    __host__ __device__ bool next(int i, Unit& u) const {
        const long L = (long)i * G + c; if (L >= nwg) return false;
        int wgid = (int)L; { const int q = nwg / NXCD, r = nwg % NXCD, xcd = wgid % NXCD, off = wgid / NXCD; wgid = (xcd < r ? xcd * (q + 1) : r * (q + 1) + (xcd - r) * q) + off; }
        const int nig = WGM * nN, gid = wgid / nig, fm = gid * WGM, gsz = (nM - fm) < WGM ? (nM - fm) : WGM;
        u.pm = fm + ((wgid % nig) % gsz); u.pn = (wgid % nig) / gsz; u.ks = 0; return true;
    }
    __device__ __forceinline__ void a_ready(const Unit&) const {}
    __device__ __forceinline__ void done(const Unit&) const {}
};

struct SplitKOrder {
    int nN, nS, nU, G, c;
    __host__ __device__ void init(int M, int N, int nS_, int G_, int c_) { nN = N / BM; nS = nS_; nU = (M / BM) * nN * nS; G = G_; c = c_; }
    __host__ __device__ bool next(int i, Unit& u) const { const int L = i * G + c; if (L >= nU) return false; const int t = L / nS; u.ks = L % nS; u.pm = t / nN; u.pn = t % nN; return true; }
    __device__ __forceinline__ void a_ready(const Unit&) const {}
    __device__ __forceinline__ void done(const Unit&) const {}
};

__device__ __forceinline__ unsigned cvt_pk_bf16(float lo, float hi) { unsigned r; asm volatile("v_cvt_pk_bf16_f32 %0, %1, %2" : "=v"(r) : "v"(lo), "v"(hi)); return r; }
template <class Epi, class Sched, bool ALIGN_EPI = false, bool SP2 = false>
__device__ __forceinline__ void gemm_phase(PG8_LAS unsigned char* lds, const Gemm g, const Sched& S, const Epi& E, int tid_in) {
    int tid_l = tid_in; asm volatile("" : "+v"(tid_l));
    const int tid = tid_l, wid = __builtin_amdgcn_readfirstlane(tid >> 6), lane = tid & 63, wr = wid >> 2, wc = wid & 3, fr = lane & 15, fq = lane >> 4;
    const int K = g.K, nt = K / BK, LD = g.ld;
    unsigned voffA[2], voffB[2];
#pragma unroll
    for (int i = 0; i < 2; ++i) { int R, C; stage_rc(tid * 16 + i * 8192, R, C); const int Rb = Epi::PERM ? ((R & ~31) + perm32(R & 31)) : R;
        voffA[i] = (unsigned)(R * LD + C) * 2u; voffB[i] = (unsigned)(Rb * LD + C) * 2u; }
    const size_t kstep = (size_t)(BK * 2);
    const size_t hstep = (size_t)HALF * LD * 2;
    const size_t tstep = 2 * hstep;
    const unsigned ldsw = (unsigned)wid * 1024u;
    const int aoff = lds_byte(wr * 64 + fr, fq * 8), boff = lds_byte(wc * 32 + fr, fq * 8);
#define PG8_SA(b, h) (((b) * 2 + (h)) * HTB)
#define PG8_SB(b, h) ((4 + (b) * 2 + (h)) * HTB)
#define PG8_STAGE(bufoff, gbase, voff) do { _Pragma("unroll") for (int _i = 0; _i < 2; ++_i) \
        __builtin_amdgcn_global_load_lds((const unsigned*)((const char*)(gbase) + (voff)[_i]), (PG8_LAS unsigned*)(lds + (bufoff) + ldsw + _i * 8192), 16, 0, 0); } while (0)
#define PG8_LDA(dst, b, h) do { _Pragma("unroll") for (int m = 0; m < 4; ++m) _Pragma("unroll") for (int k = 0; k < 2; ++k) dst[m][k] = *(const PG8_LAS bf16x8*)(lds + PG8_SA(b, h) + aoff + m * 2048 + k * 1024); } while (0)
#define PG8_LDB(dst, b, h) do { _Pragma("unroll") for (int n = 0; n < 2; ++n) _Pragma("unroll") for (int k = 0; k < 2; ++k) dst[n][k] = *(const PG8_LAS bf16x8*)(lds + PG8_SB(b, h) + boff + n * 2048 + k * 1024); } while (0)
#define PG8_MMA(ai, bj, At, Bt) do { __builtin_amdgcn_s_setprio(1); _Pragma("unroll") for (int m = 0; m < 4; ++m) _Pragma("unroll") for (int n = 0; n < 2; ++n) _Pragma("unroll") for (int k = 0; k < 2; ++k) \
        acc[ai][bj][m][n] = __builtin_amdgcn_mfma_f32_16x16x32_bf16(Bt[n][k], At[m][k], acc[ai][bj][m][n], 0, 0, 0); __builtin_amdgcn_s_setprio(0); } while (0)
#define PG8_WAIT_V(n) asm volatile("s_waitcnt vmcnt(" #n ")" ::: "memory")
#define PG8_WAIT_L(n) asm volatile("s_waitcnt lgkmcnt(" #n ")" ::: "memory")
#define PG8_BAR __builtin_amdgcn_s_barrier()
#define PG8_SCHED __builtin_amdgcn_sched_barrier(0)
    Unit cur, nxt; int ui = 0;
    if (!S.next(0, cur)) return;
    f32x4 acc[2][2][4][2];
#pragma unroll
    for (int a = 0; a < 2; ++a)
#pragma unroll
        for (int b = 0; b < 2; ++b)
#pragma unroll
            for (int m = 0; m < 4; ++m)
#pragma unroll
                for (int n = 0; n < 2; ++n) acc[a][b][m][n] = (f32x4){0.f, 0.f, 0.f, 0.f};
    bf16x8 At[4][2], B0[2][2], B1[2][2];
    const char* cA = (const char*)g.A + (size_t)cur.pm * tstep + (size_t)cur.ks * K * 2; const char* cB = (const char*)g.Bt + (size_t)cur.pn * tstep + (size_t)cur.ks * K * 2;
    S.a_ready(cur);
    if constexpr (SP2) {
        PG8_STAGE(PG8_SB(0, 0), cB, voffB); PG8_STAGE(PG8_SB(0, 1), cB + hstep, voffB); PG8_STAGE(PG8_SA(0, 0), cA, voffA); PG8_STAGE(PG8_SA(0, 1), cA + hstep, voffA);
        if (wr == 1) PG8_BAR;
        PG8_WAIT_V(2); PG8_BAR;
        PG8_STAGE(PG8_SB(1, 0), cB + kstep, voffB); PG8_STAGE(PG8_SA(1, 0), cA + kstep, voffA); PG8_STAGE(PG8_SB(1, 1), cB + hstep + kstep, voffB);
        PG8_WAIT_V(6); PG8_BAR;
    } else {
        PG8_STAGE(PG8_SB(0, 0), cB, voffB); PG8_STAGE(PG8_SA(0, 0), cA, voffA); PG8_STAGE(PG8_SB(0, 1), cB + hstep, voffB); PG8_STAGE(PG8_SA(0, 1), cA + hstep, voffA);
        if (wr == 1) PG8_BAR;
        PG8_WAIT_V(4); PG8_BAR;
        PG8_STAGE(PG8_SB(1, 0), cB + kstep, voffB); PG8_STAGE(PG8_SA(1, 0), cA + kstep, voffA); PG8_STAGE(PG8_SB(1, 1), cB + hstep + kstep, voffB);
        PG8_WAIT_V(6); PG8_BAR;
    }
    for (;;) {
        const bool has_next = S.next(ui + 1, nxt);
        const char* nA = has_next ? (const char*)g.A + (size_t)nxt.pm * tstep + (size_t)nxt.ks * K * 2 : cA; const char* nB = has_next ? (const char*)g.Bt + (size_t)nxt.pn * tstep + (size_t)nxt.ks * K * 2 : cB;
        for (int t = 0; t < nt; t += 2) {
            const bool last = (t == nt - 2);
            const char* a1 = cA + (size_t)(t + 1) * kstep;
            const char* a2 = last ? nA : cA + (size_t)(t + 2) * kstep; const char* b2 = last ? nB : cB + (size_t)(t + 2) * kstep;
            const char* a3 = a2 + kstep; const char* b3 = b2 + kstep;
            if (last && has_next) S.a_ready(nxt);
            if constexpr (SP2) {
            PG8_LDB(B0, 0, 0); PG8_LDB(B1, 0, 1); PG8_SCHED; PG8_LDA(At, 0, 0); PG8_STAGE(PG8_SA(1, 1), a1 + hstep, voffA);
            PG8_WAIT_V(8); PG8_WAIT_L(0); PG8_BAR; PG8_MMA(0, 0, At, B0); PG8_MMA(0, 1, At, B1); PG8_BAR; PG8_SCHED;
            PG8_LDA(At, 0, 1); PG8_STAGE(PG8_SB(0, 0), b2, voffB); PG8_STAGE(PG8_SB(0, 1), b2 + hstep, voffB); PG8_STAGE(PG8_SA(0, 0), a2, voffA);
            PG8_WAIT_V(8); PG8_WAIT_L(0); PG8_BAR; PG8_MMA(1, 0, At, B0); PG8_MMA(1, 1, At, B1); PG8_BAR; PG8_SCHED;
            PG8_LDB(B0, 1, 0); PG8_LDB(B1, 1, 1); PG8_SCHED; PG8_LDA(At, 1, 0); PG8_STAGE(PG8_SA(0, 1), a2 + hstep, voffA);
            PG8_WAIT_V(8); PG8_WAIT_L(0); PG8_BAR; PG8_MMA(0, 0, At, B0); PG8_MMA(0, 1, At, B1); PG8_BAR; PG8_SCHED;
            PG8_LDA(At, 1, 1); PG8_STAGE(PG8_SB(1, 0), b3, voffB); PG8_STAGE(PG8_SB(1, 1), b3 + hstep, voffB); PG8_STAGE(PG8_SA(1, 0), a3, voffA);
            PG8_WAIT_V(8); PG8_WAIT_L(0); PG8_BAR; PG8_MMA(1, 0, At, B0); PG8_MMA(1, 1, At, B1); PG8_BAR; PG8_SCHED;
            } else {
            PG8_LDB(B0, 0, 0); PG8_SCHED; PG8_LDA(At, 0, 0); PG8_STAGE(PG8_SA(1, 1), a1 + hstep, voffA);
            PG8_WAIT_L(8); PG8_BAR; PG8_WAIT_L(0); PG8_MMA(0, 0, At, B0); PG8_BAR; PG8_SCHED;
            PG8_LDB(B1, 0, 1); PG8_STAGE(PG8_SB(0, 0), b2, voffB);
            PG8_BAR; PG8_WAIT_L(0); PG8_MMA(0, 1, At, B1); PG8_BAR;
            PG8_LDA(At, 0, 1); PG8_STAGE(PG8_SA(0, 0), a2, voffA);
            PG8_BAR; PG8_WAIT_L(0); PG8_MMA(1, 0, At, B0); PG8_BAR; PG8_SCHED;
            PG8_STAGE(PG8_SB(0, 1), b2 + hstep, voffB);
            PG8_WAIT_V(6); PG8_BAR; PG8_MMA(1, 1, At, B1); PG8_BAR;
            PG8_LDB(B0, 1, 0); PG8_SCHED; PG8_LDA(At, 1, 0); PG8_STAGE(PG8_SA(0, 1), a2 + hstep, voffA);
            PG8_WAIT_L(8); PG8_BAR; PG8_WAIT_L(0); PG8_MMA(0, 0, At, B0); PG8_BAR; PG8_SCHED;
            PG8_LDB(B1, 1, 1); PG8_STAGE(PG8_SB(1, 0), b3, voffB);
            PG8_BAR; PG8_WAIT_L(0); PG8_MMA(0, 1, At, B1); PG8_BAR;
            PG8_LDA(At, 1, 1); PG8_STAGE(PG8_SA(1, 0), a3, voffA);
            PG8_BAR; PG8_WAIT_L(0); PG8_MMA(1, 0, At, B0); PG8_BAR; PG8_SCHED;
            PG8_STAGE(PG8_SB(1, 1), b3 + hstep, voffB);
            PG8_WAIT_V(6); PG8_BAR; PG8_MMA(1, 1, At, B1); PG8_BAR;
            }
        }
        if constexpr (ALIGN_EPI) { if (wr == 0) PG8_BAR; }
        if constexpr (!Epi::AFTER_DRAIN) { E(acc, cur, wr, wc, fr, fq); S.done(cur); }
        if (!has_next) break;
#pragma unroll
        for (int a = 0; a < 2; ++a)
#pragma unroll
            for (int b = 0; b < 2; ++b)
#pragma unroll
                for (int m = 0; m < 4; ++m)
#pragma unroll
                    for (int n = 0; n < 2; ++n) acc[a][b][m][n] = (f32x4){0.f, 0.f, 0.f, 0.f};
        cur = nxt; cA = nA; cB = nB; ++ui;
        if constexpr (ALIGN_EPI) { if (wr == 1) PG8_BAR; }
    }
    PG8_WAIT_V(0);
    if constexpr (!ALIGN_EPI) { if (wr == 0) PG8_BAR; }
    PG8_BAR;
    if constexpr (Epi::AFTER_DRAIN) { E.fused(acc, cur, wr, wc, fr, fq, lds, wid, lane); S.done(cur); }
#undef PG8_SA
#undef PG8_SB
#undef PG8_STAGE
#undef PG8_LDA
#undef PG8_LDB
#undef PG8_MMA
#undef PG8_WAIT_V
#undef PG8_WAIT_L
#undef PG8_BAR
#undef PG8_SCHED
}
}
#define GAS __attribute__((address_space(1)))
#define LAS __attribute__((address_space(3)))
typedef unsigned short bf16;
typedef unsigned v4u __attribute__((ext_vector_type(4)));
typedef float f32x4 __attribute__((ext_vector_type(4)));
typedef short bf16x8 __attribute__((ext_vector_type(8)));
typedef GAS unsigned gu32;
typedef GAS unsigned long long gu64;
#define RLX_AGENT __ATOMIC_RELAXED, __HIP_MEMORY_SCOPE_AGENT
#define LDS_WAIT() asm volatile("s_waitcnt lgkmcnt(0)" ::: "memory")
#define VM_WAIT() asm volatile("s_waitcnt vmcnt(0)" ::: "memory")
__device__ __forceinline__ unsigned long long rt() { return __builtin_amdgcn_s_memrealtime(); }
__device__ __forceinline__ unsigned f2bf(float f) { unsigned u = __builtin_bit_cast(unsigned, f); return (u + 0x7fffu + ((u >> 16) & 1u)) >> 16; }
__device__ __forceinline__ unsigned pk2(float lo, float hi) { return f2bf(lo) | (f2bf(hi) << 16); }

#define XB_TMO      128
#define XB_XCNT(j)  (256  + 64 * (j))
#define XB_XSUB(j)  (1280 + 64 * (j))
#define XB_XGEN(j)  (2304 + 64 * (j))
#define XB_TOP      3328
#define XB_TOPGEN   3392
#define XCD_BAR_WORDS 3456
#define XB_SPIN_CAP (1u << 18)

__device__ __forceinline__ unsigned xb_ld(unsigned* p)              { return __hip_atomic_load(p, __ATOMIC_RELAXED, __HIP_MEMORY_SCOPE_AGENT); }
__device__ __forceinline__ unsigned xb_add(unsigned* p, unsigned v) { return __hip_atomic_fetch_add(p, v, __ATOMIC_RELAXED, __HIP_MEMORY_SCOPE_AGENT); }
__device__ __forceinline__ unsigned xb_xcc_id() { return (unsigned)__builtin_amdgcn_s_getreg((3 << 11) | 20) & 0xFu; }
#define XB_SPIN(cond, bar) do { unsigned _sp = 0; while (cond) { __builtin_amdgcn_s_sleep(1); \
    if ((++_sp & 255u) == 0u) { if (xb_ld(&(bar)[XB_TMO])) break; if (_sp > XB_SPIN_CAP) { atomicAdd(&(bar)[XB_TMO], 1u); break; } } } } while (0)

struct XcdBarrier {
    unsigned* bar; unsigned x; int wave;
    volatile LAS unsigned* st;
};

__device__ __forceinline__ XcdBarrier xcd_barrier_post(unsigned* bar, volatile LAS unsigned* st) {
    XcdBarrier b; b.bar = bar; b.x = xb_xcc_id(); b.st = st; b.wave = __builtin_amdgcn_readfirstlane((int)threadIdx.x >> 6);
    if (threadIdx.x == 0) (void)xb_add(&bar[XB_XCNT(b.x)], 1u);
    return b;
}
__device__ __forceinline__ void xcd_barrier_complete(unsigned* bar, unsigned x, unsigned& nloc, unsigned& nx) {
    const unsigned G = gridDim.x * gridDim.y * gridDim.z;
    unsigned sum, cnt, mine, sp = 0u;
    for (;;) {
        sum = 0u; cnt = 0u; mine = 0u;
#pragma unroll
        for (unsigned j = 0; j < 16; ++j) { const unsigned c = xb_ld(&bar[XB_XCNT(j)]); sum += c; cnt += (c > 0u) ? 1u : 0u; mine = (j == x) ? c : mine; }
        if (sum == G) break;
        __builtin_amdgcn_s_sleep(1);
        if ((++sp & 255u) == 0u) { if (xb_ld(&bar[XB_TMO])) break; if (sp > XB_SPIN_CAP) { atomicAdd(&bar[XB_TMO], 1u); break; } }
    }
    nloc = mine > 0u ? mine : 1u; nx = cnt > 0u ? cnt : 1u;
}

__device__ __forceinline__ void xcd_barrier(const XcdBarrier& b) {
    asm volatile("s_waitcnt vmcnt(0)" ::: "memory");
    __syncthreads();
    unsigned xb_lane; asm volatile("v_mbcnt_lo_u32_b32 %0, -1, 0\n\tv_mbcnt_hi_u32_b32 %0, -1, %0" : "=v"(xb_lane));
    if (b.wave == 0 && xb_lane == 0u) {
        unsigned* bar = b.bar;
        __builtin_amdgcn_s_waitcnt(0);
        unsigned nloc = b.st[0], nx = b.st[1];
        if (nloc == 0u) { xcd_barrier_complete(bar, b.x, nloc, nx); b.st[0] = nloc; b.st[1] = nx; }
        const unsigned old = xb_add(&bar[XB_XSUB(b.x)], 1u);
        const unsigned gen = old / nloc;
        if (old + 1u == (gen + 1u) * nloc) {
            __builtin_amdgcn_fence(__ATOMIC_RELEASE, "agent");
            asm volatile("s_waitcnt vmcnt(0)" ::: "memory");
            const unsigned og = xb_add(&bar[XB_TOP], 1u);
            const unsigned tg = og / nx;
            if (og + 1u == (tg + 1u) * nx) xb_add(&bar[XB_TOPGEN], 1u);
            else XB_SPIN(xb_ld(&bar[XB_TOPGEN]) == tg, bar);
            __builtin_amdgcn_fence(__ATOMIC_ACQUIRE, "agent");
            xb_add(&bar[XB_XGEN(b.x)], 1u);
            asm volatile("s_waitcnt vmcnt(0)" ::: "memory");
        } else {
            XB_SPIN(xb_ld(&bar[XB_XGEN(b.x)]) == gen, bar);
            __builtin_amdgcn_fence(__ATOMIC_ACQUIRE, "agent");
            asm volatile("s_waitcnt vmcnt(0)" ::: "memory");
        }
    }
    __syncthreads();
}
constexpr int NB = 8, T = 4096, D = 1024, TC = 256, FF = 2816;
constexpr int ML = NB * T, MC = NB * TC, M = ML + MC;
constexpr int N_FI = 2 * FF, N_AI = 2304, N_RI = 3840, N_RI_SRC = 3600;
constexpr float ALPHA = 1.41421356237309515f;
constexpr float LOG2E = 1.4426950408889634f;
constexpr float QSCALE = 0.125f * LOG2E;
constexpr int NWAVES = 8;
#ifndef MK_PER_PHASE
#define MK_PER_PHASE 0
#endif
constexpr int N_PHASES = 2 + 2 * 11;
#ifndef MK_STOP
#define MK_STOP N_PHASES
#endif

constexpr size_t MiB = 1u << 20;
constexpr size_t WS_CTL = 0, CTL_ZERO_BYTES = 1 * MiB;
constexpr size_t WS_MOD = 1 * MiB;
constexpr size_t WS_ROPE = WS_MOD + 704 * 1024;
constexpr size_t WS_LAM = WS_ROPE + 8192;
constexpr size_t WS_WFI = 2 * MiB;
constexpr size_t WS_WFO = 46 * MiB;
constexpr size_t WS_WAI = 68 * MiB;
constexpr size_t WS_WAO = WS_WAI + 4608 * 1024;
constexpr size_t WS_WRI = WS_WAO + 2 * MiB;
constexpr size_t WS_WRO = WS_WRI + 7680 * 1024;
constexpr size_t WS_XC = 84 * MiB;
constexpr size_t WS_H = 92 * MiB;
constexpr size_t WS_Y = 416 * MiB;
constexpr size_t WS_HB = 160 * MiB;
constexpr size_t WS_BIG = 228 * MiB;
constexpr size_t WS_END = 500 * MiB;
static_assert(WS_WRO + 2 * MiB <= WS_XC, "weights");
constexpr size_t WS_ACT = WS_BIG;
constexpr size_t WS_AQ = WS_BIG, WS_AK = WS_BIG + 34 * MiB, WS_BQ = WS_BIG + 68 * MiB, WS_BK = WS_BIG + 102 * MiB;
constexpr size_t WS_VTA_L = WS_BIG + 111 * MiB, WS_VTA_C = WS_BIG + 143 * MiB, WS_VTB_L = WS_BIG + 145 * MiB, WS_VTB_C = WS_BIG + 153 * MiB;
constexpr size_t WS_MQ = WS_BIG, WS_MK = WS_BIG + 34 * MiB, WS_MO = WS_BIG + 68 * MiB, WS_RQ = WS_BIG + 102 * MiB, WS_RK = WS_BIG + 119 * MiB, WS_RG = WS_BIG + 136 * MiB;
constexpr size_t WS_MKT_L = WS_BIG + 170 * MiB, WS_MKT_C = WS_BIG + 202 * MiB, WS_MVT_L = WS_BIG + 204 * MiB, WS_MVT_C = WS_BIG + 236 * MiB;
constexpr size_t WS_RVT_L = WS_BIG + 238 * MiB, WS_RVT_C = WS_BIG + 270 * MiB;
constexpr size_t WS_RKT_L = 2 * MiB, WS_RKT_C = 18 * MiB, WS_GATE = 20 * MiB;
static_assert(WS_RVT_C + 2 * MiB <= WS_END && WS_GATE + (size_t)M * 16 * 4 <= 24 * MiB, "ws map");

constexpr int CW_TMO = 0, CW_CODE = 1, CW_BAR = 4096;
constexpr int RING_BYTES = 131072;
constexpr int LDSCTL_OFF = RING_BYTES, MISC_OFF = LDSCTL_OFF + 320;
constexpr int LDS_BYTES = 147456;
typedef float f32x16 __attribute__((ext_vector_type(16)));
typedef short bf16x4 __attribute__((ext_vector_type(4)));
typedef unsigned u32x2 __attribute__((ext_vector_type(2)));
__device__ __forceinline__ float wave_sum(float v) {
#pragma unroll
    for (int o = 1; o < 64; o <<= 1) v += __shfl_xor(v, o);
    return v;
}
__device__ __forceinline__ float bf2f(unsigned short b) { return __uint_as_float(((unsigned)b) << 16); }
__device__ __forceinline__ float bflo(unsigned w) { return __uint_as_float(w << 16); }
__device__ __forceinline__ float bfhi(unsigned w) { return __uint_as_float(w & 0xffff0000u); }
__device__ __forceinline__ float fexp2(float x) { return __builtin_amdgcn_exp2f(x); }
__device__ __forceinline__ float fexp(float x) { return __builtin_amdgcn_exp2f(x * LOG2E); }
__device__ __forceinline__ float frcp(float x) { return __builtin_amdgcn_rcpf(x); }
__device__ __forceinline__ float silu_f(float x) { return x * frcp(1.0f + fexp(-x)); }
__device__ __forceinline__ float sigmoid_f(float x) { return frcp(1.0f + fexp(-x)); }
__device__ __forceinline__ u32x2 pack4(f32x4 v) { u32x2 w; w.x = pk2(v[0], v[1]); w.y = pk2(v[2], v[3]); return w; }
__device__ __forceinline__ f32x4 mfma16(bf16x8 a, bf16x8 b, f32x4 c) { return __builtin_amdgcn_mfma_f32_16x16x32_bf16(a, b, c, 0, 0, 0); }
__device__ __forceinline__ f32x16 mfma32(bf16x8 a, bf16x8 b, f32x16 c) { return __builtin_amdgcn_mfma_f32_32x32x16_bf16(a, b, c, 0, 0, 0); }
__device__ __forceinline__ int crow(int i, int h) { return (i & 3) + 8 * (i >> 2) + 4 * h; }
__device__ __forceinline__ bf16x8 ldg16(const bf16* p) { return *(const bf16x8*)p; }
__device__ __forceinline__ bf16x8 scale8u(bf16x8 v, float s) {
    const v4u u = __builtin_bit_cast(v4u, v); v4u o;
    o.x = pk2(bflo(u.x) * s, bfhi(u.x) * s); o.y = pk2(bflo(u.y) * s, bfhi(u.y) * s); o.z = pk2(bflo(u.z) * s, bfhi(u.z) * s); o.w = pk2(bflo(u.w) * s, bfhi(u.w) * s);
    return __builtin_bit_cast(bf16x8, o);
}
__device__ __forceinline__ bf16x8 scale8v(bf16x8 v, f32x4 s0, f32x4 s1) {
    const v4u u = __builtin_bit_cast(v4u, v); v4u o;
    o.x = pk2(bflo(u.x) * s0[0], bfhi(u.x) * s0[1]); o.y = pk2(bflo(u.y) * s0[2], bfhi(u.y) * s0[3]); o.z = pk2(bflo(u.z) * s1[0], bfhi(u.z) * s1[1]); o.w = pk2(bflo(u.w) * s1[2], bfhi(u.w) * s1[3]);
    return __builtin_bit_cast(bf16x8, o);
}
typedef __bf16 bf16x2_t __attribute__((ext_vector_type(2)));
typedef float f32x2_t __attribute__((ext_vector_type(2)));
__device__ __forceinline__ unsigned cvtpk(float lo, float hi) { const f32x2_t v = {lo, hi}; const bf16x2_t b = __builtin_convertvector(v, bf16x2_t); return __builtin_bit_cast(unsigned, b); }
__device__ __forceinline__ u32x2 pack4c(f32x4 v) { u32x2 w; w.x = cvtpk(v[0], v[1]); w.y = cvtpk(v[2], v[3]); return w; }

struct EpiSwiglu {
    static constexpr bool PERM = true, AFTER_DRAIN = false;
    bf16* ACT;
    __device__ __forceinline__ void operator()(const f32x4 (&acc)[2][2][4][2], const pg8::Unit& u, int wr, int wc, int fr, int fq) const {
        const int row0 = u.pm * 256 + wr * 64 + fr, col0 = u.pn * 128 + wc * 32 + 8 * fq;
#pragma unroll
        for (int ai = 0; ai < 2; ++ai)
#pragma unroll
            for (int m = 0; m < 4; ++m) {
                bf16* rowp = ACT + (size_t)(row0 + ai * 128 + m * 16) * FF + col0;
                const f32x4 g0 = acc[ai][0][m][0], g1 = acc[ai][0][m][1], u0 = acc[ai][1][m][0], u1 = acc[ai][1][m][1];
                f32x4 a0, a1;
#pragma unroll
                for (int e = 0; e < 4; ++e) { a0[e] = silu_f(g0[e]) * u0[e]; a1[e] = silu_f(g1[e]) * u1[e]; }
                v4u w; w.x = cvtpk(a0[0], a0[1]); w.y = cvtpk(a0[2], a0[3]); w.z = cvtpk(a1[0], a1[1]); w.w = cvtpk(a1[2], a1[3]);
                *(v4u*)rowp = w;
            }
    }
};

struct EpiResid {
    static constexpr bool PERM = false, AFTER_DRAIN = false;
    const float* base_l; const float* base_c; float* out_l; float* out_c; const float* gate; float wgt;
    __device__ __forceinline__ void operator()(const f32x4 (&acc)[2][2][4][2], const pg8::Unit& u, int wr, int wc, int fr, int fq) const {
        const int r0 = u.pm * 256; const bool lat = r0 < ML; const int mr = lat ? (r0 >> 12) : 8;
        const float* bp = lat ? base_l + (size_t)r0 * D : base_c + (size_t)(r0 - ML) * D;
        float* op = lat ? out_l + (size_t)r0 * D : out_c + (size_t)(r0 - ML) * D;
        const float* gp = gate + (size_t)mr * 9216;
        const int col0 = u.pn * 256 + wc * 32 + 4 * fq;
        f32x4 gv[2][2];
#pragma unroll
        for (int bj = 0; bj < 2; ++bj)
#pragma unroll
            for (int n = 0; n < 2; ++n) gv[bj][n] = *(const f32x4*)(gp + col0 + bj * 128 + n * 16) * wgt;
#pragma unroll
        for (int ai = 0; ai < 2; ++ai)
#pragma unroll
            for (int m = 0; m < 4; ++m) {
                const size_t ro = (size_t)(ai * 128 + wr * 64 + m * 16 + fr) * D;
#pragma unroll
                for (int bj = 0; bj < 2; ++bj)
#pragma unroll
                    for (int n = 0; n < 2; ++n) { const int c = col0 + bj * 128 + n * 16; const f32x4 x = *(const f32x4*)(bp + ro + c);
                        *(f32x4*)(op + ro + c) = x * ALPHA + gv[bj][n] * acc[ai][bj][m][n]; }
            }
    }
};

struct EpiSlab {
    static constexpr bool PERM = false, AFTER_DRAIN = false;
    float* Y; const float* gate; float wgt;
    __device__ __forceinline__ void operator()(const f32x4 (&acc)[2][2][4][2], const pg8::Unit& u, int wr, int wc, int fr, int fq) const {
        asm volatile("" : "+v"(fr), "+v"(fq));
        float* op = Y + ((size_t)u.ks * MC + (size_t)(u.pm * 256)) * D;
        const float* gp = gate + (size_t)8 * 9216;
        const int col0 = u.pn * 256 + wc * 32 + 4 * fq;
        f32x4 gv[2][2];
#pragma unroll
        for (int bj = 0; bj < 2; ++bj)
#pragma unroll
            for (int n = 0; n < 2; ++n) gv[bj][n] = *(const f32x4*)(gp + col0 + bj * 128 + n * 16) * wgt;
#pragma unroll
        for (int ai = 0; ai < 2; ++ai)
#pragma unroll
            for (int m = 0; m < 4; ++m) {
                const size_t ro = (size_t)(ai * 128 + wr * 64 + m * 16 + fr) * D;
#pragma unroll
                for (int bj = 0; bj < 2; ++bj)
#pragma unroll
                    for (int n = 0; n < 2; ++n) { const int c = col0 + bj * 128 + n * 16; *(f32x4*)(op + ro + c) = gv[bj][n] * acc[ai][bj][m][n]; }
            }
    }
};

struct EpiDump {
    static constexpr bool PERM = true, AFTER_DRAIN = false;
    bf16* O;
    __device__ __forceinline__ void operator()(const f32x4 (&acc)[2][2][4][2], const pg8::Unit& u, int wr, int wc, int fr, int fq) const {
        const int row0 = u.pm * 256 + wr * 64 + fr, col0 = u.pn * 256 + wc * 32 + 8 * fq;
#pragma unroll
        for (int ai = 0; ai < 2; ++ai)
#pragma unroll
            for (int m = 0; m < 4; ++m)
#pragma unroll
                for (int bj = 0; bj < 2; ++bj) { const f32x4 a0 = acc[ai][bj][m][0], a1 = acc[ai][bj][m][1];
                    v4u w; w.x = cvtpk(a0[0], a0[1]); w.y = cvtpk(a0[2], a0[3]); w.z = cvtpk(a1[0], a1[1]); w.w = cvtpk(a1[2], a1[3]);
                    *(v4u*)(O + (size_t)(row0 + ai * 128 + m * 16) * D + col0 + bj * 128) = w; }
    }
};

__device__ __forceinline__ void epi_store_T(const f32x4 (&acc)[2][2][4][2], int bj, bf16* tb, int TL, int trow, int t0, float sc, int wr, int wc, int fr, int fq) {
#ifdef NO_T
    return;
#endif
    bf16* p0 = tb + (size_t)(trow + bj * 128 + wc * 32 + 4 * fq) * TL + t0 + wr * 64 + fr;
#pragma unroll
    for (int ai = 0; ai < 2; ++ai)
#pragma unroll
        for (int m = 0; m < 4; ++m) {
#pragma unroll
            for (int n = 0; n < 2; ++n) { const u32x2 w = pack4c(acc[ai][bj][m][n] * sc);
                bf16* p = p0 + (size_t)(16 * n) * TL + ai * 128 + m * 16;
                p[0] = (bf16)(w.x & 0xffffu); p[(size_t)TL] = (bf16)(w.x >> 16); p[(size_t)2 * TL] = (bf16)(w.y & 0xffffu); p[(size_t)3 * TL] = (bf16)(w.y >> 16); }
            asm volatile("" ::: "memory");
        }
}
template <int ACT>
__device__ __forceinline__ void epi_store_P(const f32x4 (&acc)[2][2][4][2], int bj, bf16* dst0, int pitch, int cb, float sc, int wr, int wc, int fr, int fq) {
    bf16* p0 = dst0 + (size_t)(wr * 64 + fr) * pitch + cb + bj * 128 + wc * 32 + 4 * fq;
#pragma unroll
    for (int ai = 0; ai < 2; ++ai)
#pragma unroll
        for (int m = 0; m < 4; ++m) {
#pragma unroll
            for (int n = 0; n < 2; ++n) { f32x4 v = acc[ai][bj][m][n] * sc;
                if (ACT == 1) {
#pragma unroll
                    for (int e = 0; e < 4; ++e) v[e] = sigmoid_f(v[e]); }
                if (ACT == 2) {
#pragma unroll
                    for (int e = 0; e < 4; ++e) v[e] = silu_f(v[e]); }
                *(u32x2*)(p0 + (size_t)(ai * 128 + m * 16) * pitch + 16 * n) = pack4c(v); }
            asm volatile("" ::: "memory");
        }
}
__device__ __forceinline__ void epi_store_R(const f32x4 (&acc)[2][2][4][2], int bj, bf16* dst0, int pitch, int cb, float sc, bool rope, int t0, const float* cosT, const float* sinT, int wr, int wc, int fr, int fq) {
#ifdef NO_R
    return;
#endif
    bf16* p0 = dst0 + (size_t)(wr * 64 + fr) * pitch + cb + bj * 128 + wc * 32 + 4 * fq;
#pragma unroll
    for (int ai = 0; ai < 2; ++ai)
#pragma unroll
        for (int m = 0; m < 4; ++m) { const int rr = ai * 128 + wr * 64 + m * 16 + fr; const int t = t0 + rr;
            const f32x4 x1 = acc[ai][bj][m][0], x2 = acc[ai][bj][m][1]; f32x4 o1 = x1, o2 = x2;
            if (rope) { const int pos = (wc & 1) ? (t & 63) : (t >> 6);
                const f32x4 c4 = *(const f32x4*)(cosT + pos * 16 + 4 * fq), s4 = *(const f32x4*)(sinT + pos * 16 + 4 * fq);
                o1 = x1 * c4 - x2 * s4; o2 = x2 * c4 + x1 * s4; }
            bf16* p = p0 + (size_t)(ai * 128 + m * 16) * pitch;
            *(u32x2*)p = pack4c(o1 * sc); *(u32x2*)(p + 16) = pack4c(o2 * sc);
            asm volatile("" ::: "memory"); }
}

struct EpiAttnIn {
    static constexpr bool PERM = false, AFTER_DRAIN = false;
    unsigned char* ws;
    __device__ __forceinline__ void operator()(const f32x4 (&acc)[2][2][4][2], const pg8::Unit& u, int wr, int wc, int fr, int fq) const {
        asm volatile("" : "+v"(fr), "+v"(fq));
        const int r0 = u.pm * 256; const bool lat = r0 < ML; const int b = lat ? (r0 >> 12) : ((r0 - ML) >> 8); const int t0 = lat ? (r0 & 4095) : 0;
        const int pn = u.pn; const int TL = lat ? T : TC;
        const float* cosT = (const float*)(ws + WS_ROPE); const float* sinT = cosT + 1024;
        if (pn == 4 || pn == 5) {
            bf16* vb = (bf16*)(ws + (lat ? WS_VTA_L : WS_VTA_C)) + (size_t)b * 512 * TL;
            epi_store_T(acc, 0, vb, TL, (pn - 4) * 256, t0, 1.f, wr, wc, fr, fq); epi_store_T(acc, 1, vb, TL, (pn - 4) * 256, t0, 1.f, wr, wc, fr, fq);
        } else if (pn == 8) {
            epi_store_R(acc, 0, (bf16*)(ws + WS_BK) + (size_t)r0 * 128, 128, 0, 1.f, lat, t0, cosT, sinT, wr, wc, fr, fq);
            epi_store_T(acc, 1, (bf16*)(ws + (lat ? WS_VTB_L : WS_VTB_C)) + (size_t)b * 128 * TL, TL, -128, t0, 1.f, wr, wc, fr, fq);
        } else {
            const size_t off = (pn < 2) ? WS_AQ : (pn < 4) ? WS_AK : WS_BQ;
            bf16* dst = (bf16*)(ws + off); const int cb = (pn & 1) * 256; const float sc = (pn < 2 || pn >= 6) ? QSCALE : 1.f;
            epi_store_R(acc, 0, dst + (size_t)r0 * 512, 512, cb, sc, lat, t0, cosT, sinT, wr, wc, fr, fq); epi_store_R(acc, 1, dst + (size_t)r0 * 512, 512, cb, sc, lat, t0, cosT, sinT, wr, wc, fr, fq);
        }
    }
};

struct EpiRecIn {
    static constexpr bool PERM = false, AFTER_DRAIN = false;
    unsigned char* ws; const float* gate_b;
    __device__ __forceinline__ void operator()(const f32x4 (&acc)[2][2][4][2], const pg8::Unit& u, int wr, int wc, int fr, int fq) const {
        asm volatile("" : "+v"(fr), "+v"(fq));
        const int r0 = u.pm * 256; const bool lat = r0 < ML; const int b = lat ? (r0 >> 12) : ((r0 - ML) >> 8); const int t0 = lat ? (r0 & 4095) : 0;
        const int pn = u.pn; const int TL = lat ? T : TC;
        if (pn == 14) {
            if (wc == 0) {
                const f32x4 gb = *(const f32x4*)(gate_b + 4 * fq);
                const bool isf = (fq & 1) != 0;
#pragma unroll
                for (int ai = 0; ai < 2; ++ai)
#pragma unroll
                    for (int m = 0; m < 4; ++m) { const int rr = ai * 128 + wr * 64 + m * 16 + fr; f32x4 v = acc[ai][0][m][0] + gb;
                        if (isf) {
#pragma unroll
                            for (int e = 0; e < 4; ++e) { const float x = v[e]; v[e] = fminf(x, 0.f) - log1pf(__expf(-fabsf(x))); } }
                        *(f32x4*)((float*)(ws + WS_GATE) + (size_t)(r0 + rr) * 16 + 4 * fq) = v; }
            }
        } else if (pn < 2) { bf16* d0 = (bf16*)(ws + WS_MQ) + (size_t)r0 * 512; epi_store_P<0>(acc, 0, d0, 512, pn * 256, 1.f, wr, wc, fr, fq); epi_store_P<0>(acc, 1, d0, 512, pn * 256, 1.f, wr, wc, fr, fq); }
        else if (pn < 4) { const float sc = 0.08838834764831845f; bf16* d0 = (bf16*)(ws + WS_MK) + (size_t)r0 * 512; bf16* tb = (bf16*)(ws + (lat ? WS_MKT_L : WS_MKT_C)) + (size_t)b * 512 * TL;
#pragma unroll
            for (int bj = 0; bj < 2; ++bj) { epi_store_P<0>(acc, bj, d0, 512, (pn - 2) * 256, sc, wr, wc, fr, fq); epi_store_T(acc, bj, tb, TL, (pn - 2) * 256, t0, sc, wr, wc, fr, fq); } }
        else if (pn < 6) { bf16* tb = (bf16*)(ws + (lat ? WS_MVT_L : WS_MVT_C)) + (size_t)b * 512 * TL; epi_store_T(acc, 0, tb, TL, (pn - 4) * 256, t0, 1.f, wr, wc, fr, fq); epi_store_T(acc, 1, tb, TL, (pn - 4) * 256, t0, 1.f, wr, wc, fr, fq); }
        else if (pn < 8) { bf16* d0 = (bf16*)(ws + WS_MO) + (size_t)r0 * 512; epi_store_P<1>(acc, 0, d0, 512, (pn - 6) * 256, 1.f, wr, wc, fr, fq); epi_store_P<1>(acc, 1, d0, 512, (pn - 6) * 256, 1.f, wr, wc, fr, fq); }
        else if (pn == 8) { bf16* d0 = (bf16*)(ws + WS_RQ) + (size_t)r0 * 256; epi_store_P<0>(acc, 0, d0, 256, 0, 1.f, wr, wc, fr, fq); epi_store_P<0>(acc, 1, d0, 256, 0, 1.f, wr, wc, fr, fq); }
        else if (pn == 9) { bf16* d0 = (bf16*)(ws + WS_RK) + (size_t)r0 * 256; bf16* tb = (bf16*)(ws + (lat ? WS_RKT_L : WS_RKT_C)) + (size_t)b * 256 * TL;
#pragma unroll
            for (int bj = 0; bj < 2; ++bj) { epi_store_P<0>(acc, bj, d0, 256, 0, 0.125f, wr, wc, fr, fq); epi_store_T(acc, bj, tb, TL, 0, t0, 0.125f, wr, wc, fr, fq); } }
        else if (pn < 12) { bf16* tb = (bf16*)(ws + (lat ? WS_RVT_L : WS_RVT_C)) + (size_t)b * 512 * TL; epi_store_T(acc, 0, tb, TL, (pn - 10) * 256, t0, 1.f, wr, wc, fr, fq); epi_store_T(acc, 1, tb, TL, (pn - 10) * 256, t0, 1.f, wr, wc, fr, fq); }
        else { bf16* d0 = (bf16*)(ws + WS_RG) + (size_t)r0 * 512; epi_store_P<2>(acc, 0, d0, 512, (pn - 12) * 256, 1.f, wr, wc, fr, fq); epi_store_P<2>(acc, 1, d0, 512, (pn - 12) * 256, 1.f, wr, wc, fr, fq); }
    }
};
struct Args { const float* in[22]; float* out; unsigned char* ws; int ph_lo, ph_hi; };
enum { I_X = 0, I_C, I_CTX, I_CCTX, I_ADAW, I_ADAB, I_LNG, I_LNB, I_FWI, I_FWO, I_AWI, I_AWO, I_DLAM, I_DNG, I_SINK, I_RWI, I_RWO, I_MGB, I_MNG, I_RDL, I_RNG, I_RNB };

__device__ __forceinline__ void tr_item(const float* W, int ldw, int k0, int c0, int nvalid, bf16* WT, int K, int r0, LAS float* scr, int lane) {
    const int col = lane & 31;
#pragma unroll 8
    for (int i = 0; i < 32; ++i) { const int kk = 2 * i + (lane >> 5); scr[kk * 33 + col] = (col < nvalid) ? W[(size_t)(k0 + kk) * ldw + c0 + col] : 0.f; }
    LDS_WAIT(); asm volatile("" ::: "memory");
    const int c = lane & 7;
#pragma unroll
    for (int j = 0; j < 4; ++j) { const int n = (lane >> 3) + 8 * j; const LAS float* s = scr + (8 * c) * 33 + n;
        v4u o; o.x = pk2(s[0 * 33], s[1 * 33]); o.y = pk2(s[2 * 33], s[3 * 33]); o.z = pk2(s[4 * 33], s[5 * 33]); o.w = pk2(s[6 * 33], s[7 * 33]);
        *(v4u*)(WT + (size_t)(r0 + n) * K + k0 + 8 * c) = o; }
    LDS_WAIT(); asm volatile("" ::: "memory");
}

__device__ __forceinline__ void p0a_prologue(const Args& a, LAS unsigned char* lds, int G, int vcu, int tid, int lane, int wave) {
    unsigned char* ws = a.ws;
    LAS float* scr = (LAS float*)(lds + wave * 8448);
    const int gw = vcu * NWAVES + wave, NGW = G * NWAVES;
    constexpr int I_FI = 16 * 176, I_FO = 44 * 32, I_AI = 16 * 72, I_AO = 16 * 32, I_RI = 16 * 120, I_RO = 16 * 32;
    constexpr int NITEMS = 4 * I_FI + 4 * I_FO + I_AI + I_AO + I_RI + I_RO;
    for (int it = gw; it < NITEMS; it += NGW) {
        int r = it;
        if (r < 4 * I_FI) { const int mi = r / I_FI; r -= mi * I_FI; const int kb = r / 176, nb = r % 176, pn = nb >> 3, q = nb & 7;
            const int c0 = (q < 4) ? (128 * pn + 32 * q) : (FF + 128 * pn + 32 * (q - 4));
            tr_item(a.in[I_FWI] + (size_t)mi * D * N_FI, N_FI, 64 * kb, c0, 32, (bf16*)(ws + WS_WFI) + (size_t)mi * N_FI * D, D, 32 * nb, scr, lane); continue; }
        r -= 4 * I_FI;
        if (r < 4 * I_FO) { const int mi = r / I_FO; r -= mi * I_FO; const int kb = r / 32, nb = r % 32;
            tr_item(a.in[I_FWO] + (size_t)mi * FF * D, D, 64 * kb, 32 * nb, 32, (bf16*)(ws + WS_WFO) + (size_t)mi * D * FF, FF, 32 * nb, scr, lane); continue; }
        r -= 4 * I_FO;
        if (r < I_AI) { const int kb = r / 72, nb = r % 72; tr_item(a.in[I_AWI], N_AI, 64 * kb, 32 * nb, 32, (bf16*)(ws + WS_WAI), D, 32 * nb, scr, lane); continue; }
        r -= I_AI;
        if (r < I_AO) { const int kb = r / 32, nb = r % 32; tr_item(a.in[I_AWO], D, 64 * kb, 32 * nb, 32, (bf16*)(ws + WS_WAO), D, 32 * nb, scr, lane); continue; }
        r -= I_AO;
        if (r < I_RI) { const int kb = r / 120, nb = r % 120, n0 = 32 * nb; int c0, nv;
            if (n0 < 2048) { c0 = n0; nv = 32; } else if (n0 < 3584) { c0 = n0 + 16; nv = 32; } else if (n0 == 3584) { c0 = 2048; nv = 16; } else { c0 = 0; nv = 0; }
            tr_item(a.in[I_RWI], N_RI_SRC, 64 * kb, c0, nv, (bf16*)(ws + WS_WRI), D, n0, scr, lane); continue; }
        r -= I_RI;
        { const int kb = r / 32, nb = r % 32; tr_item(a.in[I_RWO], D, 64 * kb, 32 * nb, 32, (bf16*)(ws + WS_WRO), D, 32 * nb, scr, lane); }
    }
    __syncthreads();
    {
        LAS float* sc = (LAS float*)lds;
        LAS float* red = (LAS float*)(lds + 36864);
        float* MOD = (float*)(ws + WS_MOD);
        if (blockIdx.x < 288) {
            for (int idx = tid; idx < 9216; idx += 512) { const int r = idx >> 10, k = idx & 1023; const float cv = (r < 8) ? a.in[I_C][r * 1024 + k] : a.in[I_CCTX][k]; sc[idx] = silu_f(cv); }
        }
        __syncthreads();
        for (int u = blockIdx.x; u < 288; u += G) {
            const int l = u / 144, ng = u % 144, n = 64 * ng + lane;
            const float* W = a.in[I_ADAW] + (size_t)l * D * 9216 + n;
            float acc[9];
#pragma unroll
            for (int r = 0; r < 9; ++r) acc[r] = 0.f;
#pragma unroll 8
            for (int kk = 0; kk < 128; ++kk) { const int k = wave * 128 + kk; const float wv = W[(size_t)k * 9216];
#pragma unroll
                for (int r = 0; r < 9; ++r) acc[r] += sc[r * 1024 + k] * wv; }
#pragma unroll
            for (int r = 0; r < 9; ++r) red[(wave * 9 + r) * 64 + lane] = acc[r];
            __syncthreads();
            for (int idx = tid; idx < 576; idx += 512) { const int r = idx >> 6, ln = idx & 63; float s = 0.f;
#pragma unroll
                for (int w = 0; w < 8; ++w) s += red[(w * 9 + r) * 64 + ln];
                MOD[(size_t)(l * 9 + r) * 9216 + 64 * ng + ln] = s + a.in[I_ADAB][l * 9216 + 64 * ng + ln]; }
            __syncthreads();
        }
    }
    if (blockIdx.x == 0) {
        float* cosT = (float*)(ws + WS_ROPE); float* sinT = cosT + 1024;
        for (int idx = tid; idx < 1024; idx += 512) { const int pos = idx >> 4, f = idx & 15; const float inv = powf(10000.0f, -(float)f / 16.0f); const float ang = (float)pos * inv;
            cosT[idx] = cosf(ang); sinT[idx] = sinf(ang); }
        if (wave == 0) { const float* dl = a.in[I_DLAM]; const float s1 = wave_sum(dl[lane] * dl[64 + lane]), s2 = wave_sum(dl[128 + lane] * dl[192 + lane]);
            if (lane == 0) *(float*)(ws + WS_LAM) = expf(s1) - expf(s2) + 0.2f; }
    }
}

__device__ __forceinline__ void p0b_modulate(const Args& a, int gw, int NGW, int lane) {
    const float* MOD = (const float*)(a.ws + WS_MOD); bf16* H = (bf16*)(a.ws + WS_H);
    for (int r = gw; r < M; r += NGW) {
        const float* xr = (r < ML) ? a.in[I_X] + (size_t)r * D : a.in[I_CTX] + (size_t)(r - ML) * D;
        const float* mp = MOD + (size_t)((r < ML) ? (r >> 12) : 8) * 9216;
#pragma unroll
        for (int j = 0; j < 4; ++j) { const int c = 4 * (lane + 64 * j); const f32x4 x = *(const f32x4*)(xr + c), sh = *(const f32x4*)(mp + c), sc = *(const f32x4*)(mp + 1024 + c);
            *(u32x2*)(H + (size_t)r * D + c) = pack4c(x * (sc + 1.0f) + sh); }
        if (r >= ML) { float* xc = (float*)(a.ws + WS_XC) + (size_t)(r - ML) * D;
#pragma unroll
            for (int j = 0; j < 4; ++j) *(f32x4*)(xc + 4 * (lane + 64 * j)) = *(const f32x4*)(xr + 4 * (lane + 64 * j)); }
    }
}

__device__ __forceinline__ void ln_phase(float* out_l, float* out_c, const float* yc, int nslab, const float* g, const float* bt, const float* modn, bf16* H, int nrows, int gw, int NGW, int lane) {
    f32x4 g4[4], b4[4];
#pragma unroll
    for (int j = 0; j < 4; ++j) { g4[j] = *(const f32x4*)(g + 4 * (lane + 64 * j)); b4[j] = *(const f32x4*)(bt + 4 * (lane + 64 * j)); }
    for (int r = gw; r < nrows; r += NGW) {
        float* zr = (r < ML) ? out_l + (size_t)r * D : out_c + (size_t)(r - ML) * D;
        f32x4 v[4]; float s = 0.f;
#pragma unroll
        for (int j = 0; j < 4; ++j) v[j] = *(const f32x4*)(zr + 4 * (lane + 64 * j));
        if (r >= ML && nslab > 0) { const float* yr = yc + (size_t)(r - ML) * D;
#pragma unroll
            for (int j = 0; j < 4; ++j) v[j] = v[j] * ALPHA;
            for (int sl = 0; sl < nslab; ++sl) {
#pragma unroll
                for (int j = 0; j < 4; ++j) v[j] = v[j] + *(const f32x4*)(yr + (size_t)sl * MC * D + 4 * (lane + 64 * j)); } }
#pragma unroll
        for (int j = 0; j < 4; ++j) s += (v[j][0] + v[j][1]) + (v[j][2] + v[j][3]);
        const float mean = wave_sum(s) * (1.f / D); float s2 = 0.f;
#pragma unroll
        for (int j = 0; j < 4; ++j) { v[j] = v[j] - mean; s2 += (v[j][0] * v[j][0] + v[j][1] * v[j][1]) + (v[j][2] * v[j][2] + v[j][3] * v[j][3]); }
        const float rstd = 1.0f / sqrtf(wave_sum(s2) * (1.f / D) + 1e-5f);
        const float* mp = modn ? modn + (size_t)((r < ML) ? (r >> 12) : 8) * 9216 : nullptr;
#pragma unroll
        for (int j = 0; j < 4; ++j) { const int c = 4 * (lane + 64 * j); const f32x4 y = v[j] * rstd * g4[j] + b4[j]; *(f32x4*)(zr + c) = y;
            if (mp) { const f32x4 sh = *(const f32x4*)(mp + c), sc = *(const f32x4*)(mp + 1024 + c); *(u32x2*)(H + (size_t)r * D + c) = pack4c(y * (sc + 1.0f) + sh); } }
    }
}
template <int NDV> struct AttW { f32x16 o[NDV]; float m, l; };

template <int NDV, bool MASK, int KPB>
__device__ __forceinline__ void attn_block_lds(AttW<NDV>& S, const bf16x8 (&qf)[4], LAS const unsigned char* Kl, LAS const unsigned char* Vl, int r, int h, int qpos, int kpos0) {
    f32x16 st;
#pragma unroll
    for (int i = 0; i < 16; ++i) st[i] = 0.f;
#pragma unroll
    for (int s = 0; s < 4; ++s) { const bf16x8 kf = *(LAS const bf16x8*)(Kl + r * KPB + 32 * s + 16 * h); st = mfma32(kf, qf[s], st); }
    if (MASK) {
#pragma unroll
        for (int i = 0; i < 16; ++i) { const int dlt = qpos - (kpos0 + crow(i, h)); if (dlt > 128 || dlt < -128) st[i] = -INFINITY; }
    }
    float mx = st[0];
#pragma unroll
    for (int i = 1; i < 16; ++i) mx = fmaxf(mx, st[i]);
    mx = fmaxf(mx, __shfl_xor(mx, 32));
    const float mn = fmaxf(S.m, mx), alpha = fexp2(S.m - mn);
    const bool same = (mn == S.m);
    S.m = mn;
    float ps = 0.f;
#pragma unroll
    for (int i = 0; i < 16; ++i) { st[i] = fexp2(st[i] - mn); ps += st[i]; }
    S.l = S.l * alpha + ps;
    if (!__all(same)) {
#pragma unroll
        for (int d = 0; d < NDV; ++d) S.o[d] = S.o[d] * alpha;
    }
    bf16x8 pf[2];
#pragma unroll
    for (int s2 = 0; s2 < 2; ++s2) { v4u w; w.x = cvtpk(st[8 * s2 + 0], st[8 * s2 + 1]); w.y = cvtpk(st[8 * s2 + 2], st[8 * s2 + 3]); w.z = cvtpk(st[8 * s2 + 4], st[8 * s2 + 5]); w.w = cvtpk(st[8 * s2 + 6], st[8 * s2 + 7]);
        pf[s2] = __builtin_bit_cast(bf16x8, w); }
#pragma unroll
    for (int s2 = 0; s2 < 2; ++s2)
#pragma unroll
        for (int d = 0; d < NDV; ++d) { LAS const unsigned char* vp = Vl + (32 * d + r) * 136 + 32 * s2 + 8 * h;
            const u32x2 lo = *(LAS const u32x2*)vp, hi = *(LAS const u32x2*)(vp + 16); v4u w; w.x = lo.x; w.y = lo.y; w.z = hi.x; w.w = hi.y;
            S.o[d] = mfma32(__builtin_bit_cast(bf16x8, w), pf[s2], S.o[d]); }
}

template <int NDV, bool MASK>
__device__ __forceinline__ void attn_softmax(AttW<NDV>& S, f32x16& st, bf16x8 (&pf)[2], int h, int qpos, int kpos0) {
    if (MASK) {
#pragma unroll
        for (int i = 0; i < 16; ++i) { const int dlt = qpos - (kpos0 + crow(i, h)); if (dlt > 128 || dlt < -128) st[i] = -INFINITY; }
    }
    float mx = fmaxf(fmaxf(st[0], st[1]), fmaxf(st[2], st[3]));
#pragma unroll
    for (int i = 4; i < 16; i += 4) mx = fmaxf(mx, fmaxf(fmaxf(st[i], st[i + 1]), fmaxf(st[i + 2], st[i + 3])));
    mx = fmaxf(mx, __shfl_xor(mx, 32));
    const float mn = fmaxf(S.m, mx), alpha = fexp2(S.m - mn);
    const bool same = (mn == S.m);
    S.m = mn;
    float ps = 0.f;
#pragma unroll
    for (int i = 0; i < 16; ++i) { st[i] = fexp2(st[i] - mn); ps += st[i]; }
    S.l = S.l * alpha + ps;
    if (!__all(same)) {
#pragma unroll
        for (int d = 0; d < NDV; ++d) S.o[d] = S.o[d] * alpha;
    }
#pragma unroll
    for (int s2 = 0; s2 < 2; ++s2) { v4u w; w.x = cvtpk(st[8 * s2 + 0], st[8 * s2 + 1]); w.y = cvtpk(st[8 * s2 + 2], st[8 * s2 + 3]); w.z = cvtpk(st[8 * s2 + 4], st[8 * s2 + 5]); w.w = cvtpk(st[8 * s2 + 6], st[8 * s2 + 7]);
        pf[s2] = __builtin_bit_cast(bf16x8, w); }
}
template <int NDV, bool MASK, int KPB>
__device__ __forceinline__ void attn_tile_lds(AttW<NDV>& S, const bf16x8 (&qf)[4], LAS const unsigned char* Kl, LAS const unsigned char* Vl, int r, int h, int qpos, int kpos0) {
    bf16x8 kfa[4], kfb[4];
#pragma unroll
    for (int s = 0; s < 4; ++s) { kfa[s] = *(LAS const bf16x8*)(Kl + r * KPB + 32 * s + 16 * h); kfb[s] = *(LAS const bf16x8*)(Kl + (32 + r) * KPB + 32 * s + 16 * h); }
    __builtin_amdgcn_sched_barrier(0);
    f32x16 sta, stb;
#pragma unroll
    for (int i = 0; i < 16; ++i) { sta[i] = 0.f; stb[i] = 0.f; }
#pragma unroll
    for (int s = 0; s < 4; ++s) { sta = mfma32(kfa[s], qf[s], sta); stb = mfma32(kfb[s], qf[s], stb); }
    u32x2 vlo[2][NDV], vhi[2][NDV];
#pragma unroll
    for (int s2 = 0; s2 < 2; ++s2)
#pragma unroll
        for (int d = 0; d < NDV; ++d) { LAS const unsigned char* vp = Vl + (32 * d + r) * 136 + 32 * s2 + 8 * h; vlo[s2][d] = *(LAS const u32x2*)vp; vhi[s2][d] = *(LAS const u32x2*)(vp + 16); }
    __builtin_amdgcn_sched_barrier(0);
    if (MASK) {
#pragma unroll
        for (int i = 0; i < 16; ++i) { const int dlt = qpos - (kpos0 + crow(i, h)); if (dlt > 128 || dlt < -128) sta[i] = -INFINITY; if (dlt > 160 || dlt < -96) stb[i] = -INFINITY; }
    }
    float mxa = fmaxf(fmaxf(sta[0], sta[1]), fmaxf(sta[2], sta[3])), mxb = fmaxf(fmaxf(stb[0], stb[1]), fmaxf(stb[2], stb[3]));
#pragma unroll
    for (int i = 4; i < 16; i += 4) { mxa = fmaxf(mxa, fmaxf(fmaxf(sta[i], sta[i + 1]), fmaxf(sta[i + 2], sta[i + 3]))); mxb = fmaxf(mxb, fmaxf(fmaxf(stb[i], stb[i + 1]), fmaxf(stb[i + 2], stb[i + 3]))); }
    float mx = fmaxf(mxa, mxb);
    mx = fmaxf(mx, __shfl_xor(mx, 32));
    const float mn = fmaxf(S.m, mx), alpha = fexp2(S.m - mn);
    const bool same = (mn == S.m);
    S.m = mn;
    float p0 = 0.f, p1 = 0.f, p2 = 0.f, p3 = 0.f;
#pragma unroll
    for (int i = 0; i < 16; i += 4) { sta[i] = fexp2(sta[i] - mn); sta[i + 1] = fexp2(sta[i + 1] - mn); sta[i + 2] = fexp2(sta[i + 2] - mn); sta[i + 3] = fexp2(sta[i + 3] - mn);
        stb[i] = fexp2(stb[i] - mn); stb[i + 1] = fexp2(stb[i + 1] - mn); stb[i + 2] = fexp2(stb[i + 2] - mn); stb[i + 3] = fexp2(stb[i + 3] - mn);
        p0 += sta[i] + sta[i + 1]; p1 += sta[i + 2] + sta[i + 3]; p2 += stb[i] + stb[i + 1]; p3 += stb[i + 2] + stb[i + 3]; }
    S.l = S.l * alpha + ((p0 + p1) + (p2 + p3));
    if (!__all(same)) {
#pragma unroll
        for (int d = 0; d < NDV; ++d) S.o[d] = S.o[d] * alpha;
    }
    bf16x8 pf[4];
#pragma unroll
    for (int s2 = 0; s2 < 2; ++s2) { v4u w; w.x = cvtpk(sta[8 * s2 + 0], sta[8 * s2 + 1]); w.y = cvtpk(sta[8 * s2 + 2], sta[8 * s2 + 3]); w.z = cvtpk(sta[8 * s2 + 4], sta[8 * s2 + 5]); w.w = cvtpk(sta[8 * s2 + 6], sta[8 * s2 + 7]);
        pf[s2] = __builtin_bit_cast(bf16x8, w);
        v4u x; x.x = cvtpk(stb[8 * s2 + 0], stb[8 * s2 + 1]); x.y = cvtpk(stb[8 * s2 + 2], stb[8 * s2 + 3]); x.z = cvtpk(stb[8 * s2 + 4], stb[8 * s2 + 5]); x.w = cvtpk(stb[8 * s2 + 6], stb[8 * s2 + 7]);
        pf[2 + s2] = __builtin_bit_cast(bf16x8, x); }
    __builtin_amdgcn_sched_barrier(0);
    u32x2 wlo[2][NDV], whi[2][NDV];
#pragma unroll
    for (int s2 = 0; s2 < 2; ++s2)
#pragma unroll
        for (int d = 0; d < NDV; ++d) { LAS const unsigned char* vp = Vl + 64 + (32 * d + r) * 136 + 32 * s2 + 8 * h; wlo[s2][d] = *(LAS const u32x2*)vp; whi[s2][d] = *(LAS const u32x2*)(vp + 16); }
    __builtin_amdgcn_sched_barrier(0);
#pragma unroll
    for (int s2 = 0; s2 < 2; ++s2)
#pragma unroll
        for (int d = 0; d < NDV; ++d) { v4u w; w.x = vlo[s2][d].x; w.y = vlo[s2][d].y; w.z = vhi[s2][d].x; w.w = vhi[s2][d].y; S.o[d] = mfma32(__builtin_bit_cast(bf16x8, w), pf[s2], S.o[d]); }
#pragma unroll
    for (int s2 = 0; s2 < 2; ++s2)
#pragma unroll
        for (int d = 0; d < NDV; ++d) { v4u w; w.x = wlo[s2][d].x; w.y = wlo[s2][d].y; w.z = whi[s2][d].x; w.w = whi[s2][d].y; S.o[d] = mfma32(__builtin_bit_cast(bf16x8, w), pf[2 + s2], S.o[d]); }
}

__device__ __forceinline__ void load_q(bf16x8 (&qf)[4], const bf16* Qp, int pitch, int r, int h) {
#pragma unroll
    for (int s = 0; s < 4; ++s) qf[s] = ldg16(Qp + (size_t)r * pitch + 16 * s + 8 * h);
}

template <bool DIFF> struct AttStage { v4u k[DIFF ? 2 : 1]; v4u v[DIFF ? 2 : 1]; };
template <bool DIFF>
__device__ __forceinline__ void att_gload(AttStage<DIFF>& R, const bf16* Kg, int kpitch, const bf16* Vg, int vpitch, int tid) {
    constexpr int NC = DIFF ? 2 : 1, KCH = DIFF ? 16 : 8;
#pragma unroll
    for (int i = 0; i < NC; ++i) { const int id = tid + 512 * i; R.k[i] = *(const v4u*)(Kg + (size_t)(id / KCH) * kpitch + (id % KCH) * 8); R.v[i] = *(const v4u*)(Vg + (size_t)(id >> 3) * vpitch + (id & 7) * 8); }
}
template <bool DIFF>
__device__ __forceinline__ void att_lstore(const AttStage<DIFF>& R, LAS unsigned char* Kl, LAS unsigned char* Vl, int tid) {
    constexpr int NC = DIFF ? 2 : 1, KCH = DIFF ? 16 : 8, KPB = DIFF ? 272 : 144;
#pragma unroll
    for (int i = 0; i < NC; ++i) { const int id = tid + 512 * i;
        *(LAS v4u*)(Kl + (id / KCH) * KPB + (id % KCH) * 16) = R.k[i];
        LAS unsigned char* vp = Vl + (id >> 3) * 136 + (id & 7) * 16;
        u32x2 a, b; a.x = R.v[i].x; a.y = R.v[i].y; b.x = R.v[i].z; b.y = R.v[i].w; *(LAS u32x2*)vp = a; *(LAS u32x2*)(vp + 8) = b; }
}

constexpr int ATT_UNITS = 2176;
constexpr int ATT_KB_D = 64 * 272, ATT_VB_D = 128 * 136, ATT_ST_D = ATT_KB_D + ATT_VB_D;
constexpr int ATT_KB_W = 64 * 144, ATT_VB_W = 64 * 136, ATT_ST_W = ATT_KB_W + ATT_VB_W;
__device__ __forceinline__ void attn_phase(const Args& a, LAS unsigned char* lds, int G, int vcu, int tid, int lane, int wave, int only) {
    unsigned char* ws = a.ws;
    const bf16* AQ = (const bf16*)(ws + WS_AQ); const bf16* AK = (const bf16*)(ws + WS_AK); const bf16* BQ = (const bf16*)(ws + WS_BQ); const bf16* BK = (const bf16*)(ws + WS_BK);
    const bf16* VTA_L = (const bf16*)(ws + WS_VTA_L); const bf16* VTA_C = (const bf16*)(ws + WS_VTA_C); const bf16* VTB_L = (const bf16*)(ws + WS_VTB_L); const bf16* VTB_C = (const bf16*)(ws + WS_VTB_C);
    bf16* O = (bf16*)(ws + WS_H);
    const int r = lane & 31, h = lane >> 5;
    LAS float* X = (LAS float*)lds;
    for (int u = vcu; u < ATT_UNITS; u += G) {
        const bool isdiff = (u < 1024) || (u >= 2048 && u < 2112);
        if ((only == 1 && !isdiff) || (only == 2 && isdiff)) continue;
        if (isdiff) {
            const bool lat = u < 1024; const int uu = lat ? u : u - 2048;
            const int bh = lat ? (uu >> 5) : (uu >> 1), qb = lat ? (uu & 31) : (uu & 1), b = bh >> 2, hd = bh & 3;
            const int sub = wave & 1, qs = wave >> 1;
            const int qrow0 = (lat ? b * T : ML + b * TC) + qb * 128 + qs * 32;
            bf16x8 qf[4]; load_q(qf, AQ + (size_t)qrow0 * 512 + hd * 128 + sub * 64, 512, r, h);
            AttW<4> S;
#pragma unroll
            for (int d = 0; d < 4; ++d)
#pragma unroll
                for (int i = 0; i < 16; ++i) S.o[d][i] = 0.f;
            S.m = -1e30f; S.l = 0.f;
            const int NTL = lat ? T / 64 : 0, NT = NTL + TC / 64;
            const bf16* KL = AK + (size_t)(b * T) * 512 + hd * 128; const bf16* KC = AK + (size_t)(ML + b * TC) * 512 + hd * 128;
            const bf16* VL = VTA_L + (size_t)(b * 4 + hd) * 128 * T; const bf16* VC = VTA_C + (size_t)(b * 4 + hd) * 128 * TC;
            AttStage<true> R;
            { const bool c0 = NTL == 0; att_gload<true>(R, c0 ? KC : KL, 512, c0 ? VC : VL, c0 ? TC : T, tid); att_lstore<true>(R, lds, lds + ATT_KB_D, tid); }
            __syncthreads();
            for (int t = 0; t < NT; ++t) {
                const int tn = t + 1;
                if (tn < NT) { const bool c = tn >= NTL; const int tt = c ? tn - NTL : tn; att_gload<true>(R, (c ? KC : KL) + (size_t)tt * 64 * 512, 512, (c ? VC : VL) + tt * 64, c ? TC : T, tid); }
                LAS const unsigned char* Kl = lds + (t & 1) * ATT_ST_D + sub * 128; LAS const unsigned char* Vl = lds + (t & 1) * ATT_ST_D + ATT_KB_D;
                attn_tile_lds<4, false, 272>(S, qf, Kl, Vl, r, h, 0, 0);
                if (tn < NT) att_lstore<true>(R, lds + (tn & 1) * ATT_ST_D, lds + (tn & 1) * ATT_ST_D + ATT_KB_D, tid);
                __syncthreads();
            }
            const float lt = S.l + __shfl_xor(S.l, 32); const float inv = 1.0f / lt;
            if (sub == 1) { const float lam = *(const float*)(ws + WS_LAM); const float f = inv * lam;
#pragma unroll
                for (int d = 0; d < 4; ++d)
#pragma unroll
                    for (int i = 0; i < 16; ++i) X[(qs * 128 + 32 * d + crow(i, h)) * 32 + r] = S.o[d][i] * f; }
            __syncthreads();
            if (sub == 0) { float ss = 0.f;
#pragma unroll
                for (int d = 0; d < 4; ++d)
#pragma unroll
                    for (int i = 0; i < 16; ++i) { const float v = S.o[d][i] * inv - X[(qs * 128 + 32 * d + crow(i, h)) * 32 + r]; S.o[d][i] = v; ss += v * v; }
                ss += __shfl_xor(ss, 32);
                const float rs = 0.8f / sqrtf(ss * (1.0f / 128.0f) + 1e-5f);
                const float* gn = a.in[I_DNG];
                bf16* op = O + (size_t)(qrow0 + r) * D + hd * 128;
#pragma unroll
                for (int d = 0; d < 4; ++d)
#pragma unroll
                    for (int k4 = 0; k4 < 4; ++k4) { const int dv = 32 * d + 8 * k4 + 4 * h; const f32x4 g4 = *(const f32x4*)(gn + dv);
                        f32x4 v; v[0] = S.o[d][4 * k4] * rs * g4[0]; v[1] = S.o[d][4 * k4 + 1] * rs * g4[1]; v[2] = S.o[d][4 * k4 + 2] * rs * g4[2]; v[3] = S.o[d][4 * k4 + 3] * rs * g4[3];
                        *(u32x2*)(op + dv) = pack4c(v); }
            }
            __syncthreads();
        } else {
            const bool lat = u < 2048; const int uu = lat ? u - 1024 : u - 2112;
            const int bk = lat ? (uu >> 6) : (uu >> 2), qb = lat ? (uu & 63) : (uu & 3), b = bk >> 1, kvh = bk & 1;
            const int g4i = wave >> 1, qs = wave & 1, hd = kvh * 4 + g4i;
            const int t0 = qb * 64 + qs * 32;
            const int qrow0 = (lat ? b * T : ML + b * TC) + t0;
            bf16x8 qf[4]; load_q(qf, BQ + (size_t)qrow0 * 512 + hd * 64, 512, r, h);
            AttW<2> S;
#pragma unroll
            for (int d = 0; d < 2; ++d)
#pragma unroll
                for (int i = 0; i < 16; ++i) S.o[d][i] = 0.f;
            S.m = a.in[I_SINK][hd] * LOG2E; S.l = (h == 0) ? 1.0f : 0.0f;
            const int lo = lat ? ((qb * 64 - 128) < 0 ? 0 : (qb * 64 - 128)) : 0, hi = lat ? ((qb * 64 + 192) > T ? T : (qb * 64 + 192)) : 0;
            const int NTL = (hi - lo) / 64, NT = NTL + TC / 64;
            const bf16* KL = BK + (size_t)(b * T + lo) * 128 + kvh * 64; const bf16* KC = BK + (size_t)(ML + b * TC) * 128 + kvh * 64;
            const bf16* VL = VTB_L + (size_t)(b * 2 + kvh) * 64 * T + lo; const bf16* VC = VTB_C + (size_t)(b * 2 + kvh) * 64 * TC;
            AttStage<false> R;
            { const bool c0 = NTL == 0; att_gload<false>(R, c0 ? KC : KL, 128, c0 ? VC : VL, c0 ? TC : T, tid); att_lstore<false>(R, lds, lds + ATT_KB_W, tid); }
            __syncthreads();
            for (int t = 0; t < NT; ++t) {
                const int tn = t + 1;
                if (tn < NT) { const bool c = tn >= NTL; const int tt = c ? tn - NTL : tn; att_gload<false>(R, (c ? KC : KL) + (size_t)tt * 64 * 128, 128, (c ? VC : VL) + tt * 64, c ? TC : T, tid); }
                LAS const unsigned char* Kl = lds + (t & 1) * ATT_ST_W; LAS const unsigned char* Vl = lds + (t & 1) * ATT_ST_W + ATT_KB_W;
                if (t < NTL) attn_tile_lds<2, true, 144>(S, qf, Kl, Vl, r, h, t0 + r, lo + t * 64);
                else attn_tile_lds<2, false, 144>(S, qf, Kl, Vl, r, h, 0, 0);
                if (tn < NT) att_lstore<false>(R, lds + (tn & 1) * ATT_ST_W, lds + (tn & 1) * ATT_ST_W + ATT_KB_W, tid);
                __syncthreads();
            }
            const float lt = S.l + __shfl_xor(S.l, 32); const float inv = 1.0f / lt;
            bf16* op = O + (size_t)(qrow0 + r) * D + 512 + hd * 64;
#pragma unroll
            for (int d = 0; d < 2; ++d)
#pragma unroll
                for (int k4 = 0; k4 < 4; ++k4) { const int dv = 32 * d + 8 * k4 + 4 * h;
                    f32x4 v; v[0] = S.o[d][4 * k4] * inv; v[1] = S.o[d][4 * k4 + 1] * inv; v[2] = S.o[d][4 * k4 + 2] * inv; v[3] = S.o[d][4 * k4 + 3] * inv;
                    *(u32x2*)(op + dv) = pack4c(v); }
        }
    }
}
constexpr int SC_K = 0;
constexpr int SC_V = 34816;
constexpr int SC_CT = SC_V + 17408;
constexpr int SC_S = SC_CT + 21760;
constexpr int SC_AL = SC_S + 8 * 4352;
constexpr int SC_CH = SC_AL + 1536;
static_assert(SC_CH + 4 * 128 <= RING_BYTES, "scan LDS");
constexpr size_t WS_SCAL = 500 * MiB;

template <int DK> struct ScanStage { v4u k[DK / 32]; v4u v[2]; float sc; };

template <int DK, bool MLSTM>
__device__ __forceinline__ void scan_gload(ScanStage<DK>& R, bf16x8 (&qf)[DK / 32], bf16x8 (&ktf)[4], const bf16* Krow, int RP, const bf16* Qrow, const bf16* Vt, const bf16* Kt, int tp, const float* scal, bool isctx, int tid, int wave, int c, int g, int dkt) {
    constexpr int KCH = DK / 8, NCK = DK / 32;
    if (!isctx) {
#pragma unroll
        for (int i = 0; i < NCK; ++i) { const int id = tid + 512 * i; R.k[i] = *(const v4u*)(Krow + (size_t)(id / KCH) * RP + (id % KCH) * 8); }
#pragma unroll
        for (int ks = 0; ks < DK / 32; ++ks) qf[ks] = ldg16(Qrow + (size_t)(16 * wave + c) * RP + 32 * ks + 8 * g);
    }
#pragma unroll
    for (int i = 0; i < 2; ++i) { const int id = tid + 512 * i; R.v[i] = *(const v4u*)(Vt + (size_t)(id >> 4) * tp + (id & 15) * 8); }
#pragma unroll
    for (int ks2 = 0; ks2 < 4; ++ks2) ktf[ks2] = ldg16(Kt + (size_t)(16 * dkt + c) * tp + 32 * ks2 + 8 * g);
    if (MLSTM) { if (tid < 384) R.sc = __hip_atomic_load(scal + (tid >> 7) * 4352 + (tid & 127), __ATOMIC_RELAXED, __HIP_MEMORY_SCOPE_AGENT); }
}
template <int DK, bool MLSTM>
__device__ __forceinline__ void scan_lstore(const ScanStage<DK>& R, LAS unsigned char* lds, bool isctx, int tid) {
    constexpr int KCH = DK / 8, NCK = DK / 32, KPB = DK * 2 + 16;
    if (!isctx) {
#pragma unroll
        for (int i = 0; i < NCK; ++i) { const int id = tid + 512 * i; *(LAS v4u*)(lds + SC_K + (id / KCH) * KPB + (id % KCH) * 16) = R.k[i]; }
    }
#pragma unroll
    for (int i = 0; i < 2; ++i) { const int id = tid + 512 * i; *(LAS v4u*)(lds + SC_V + (id >> 4) * 272 + (id & 15) * 16) = R.v[i]; }
    if (MLSTM) { if (tid < 384) ((LAS float*)(lds + SC_AL))[tid] = R.sc; }
}

template <int DK, bool MLSTM>
__device__ __forceinline__ void scan_chain(const Args& a, LAS unsigned char* lds, int unit, int b, int hd, int dir, int half, int tid, int lane, int wave) {
    unsigned char* ws = a.ws;
    constexpr int KS = DK / 32, KPB = DK * 2 + 16, NT2 = MLSTM ? 5 : 4, NOWN = MLSTM ? 5 : 2;
    const int c = lane & 15, g = lane >> 4;
    constexpr int RP = MLSTM ? 512 : 256;
    const bf16* Qr = MLSTM ? (const bf16*)(ws + WS_MQ) + hd * 128 : (const bf16*)(ws + WS_RQ) + hd * 64;
    const bf16* Kr = MLSTM ? (const bf16*)(ws + WS_MK) + hd * 128 : (const bf16*)(ws + WS_RK) + hd * 64;
    const bf16* KtL = MLSTM ? (const bf16*)(ws + WS_MKT_L) + (size_t)(b * 4 + hd) * 128 * T : (const bf16*)(ws + WS_RKT_L) + (size_t)(b * 4 + hd) * 64 * T;
    const bf16* KtC = MLSTM ? (const bf16*)(ws + WS_MKT_C) + (size_t)(b * 4 + hd) * 128 * TC : (const bf16*)(ws + WS_RKT_C) + (size_t)(b * 4 + hd) * 64 * TC;
    const bf16* VtL = (MLSTM ? (const bf16*)(ws + WS_MVT_L) : (const bf16*)(ws + WS_RVT_L)) + (size_t)((b * 4 + hd) * 128 + half * 64) * T;
    const bf16* VtC = (MLSTM ? (const bf16*)(ws + WS_MVT_C) : (const bf16*)(ws + WS_RVT_C)) + (size_t)((b * 4 + hd) * 128 + half * 64) * TC;
    bf16* OUT = (bf16*)(ws + (dir == 0 ? WS_H : WS_HB)) + (MLSTM ? hd * 128 : 512 + hd * 128) + half * 64;
    float* SCAL = (float*)(ws + WS_SCAL) + (size_t)unit * 3 * 4352;
    LAS bf16* CT = (LAS bf16*)(lds + SC_CT);
    LAS unsigned char* Sw = lds + SC_S + wave * 4352;
    LAS float* sa = (LAS float*)(lds + SC_AL); LAS float* sb = sa + 128; LAS float* sg = sa + 256;
    LAS float* mch = (LAS float*)(lds + SC_CH); LAS float* bend = mch + 36; LAS float* gend = bend + 34;
    const bool fwd = dir == 0;
    for (int i = tid; i < 80 * KPB / 4; i += 512) ((LAS unsigned*)CT)[i] = 0u;
    float lg = 0.f;
    if (MLSTM) {
        const float* GATE = (const float*)(ws + WS_GATE);
        for (int ci = wave; ci < 34; ci += 8) {
            const int rowb = (ci < 2) ? (ML + b * TC + ci * 128) : (b * T + (ci - 2) * 128), pb = ci * 128;
            const int u0 = 2 * lane, u1 = 2 * lane + 1, i0 = fwd ? u0 : 127 - u0, i1 = fwd ? u1 : 127 - u1;
            const float f0 = GATE[(size_t)(rowb + i0) * 16 + dir * 8 + 4 + hd], f1 = GATE[(size_t)(rowb + i1) * 16 + dir * 8 + 4 + hd];
            const float p0 = GATE[(size_t)(rowb + i0) * 16 + dir * 8 + hd], p1 = GATE[(size_t)(rowb + i1) * 16 + dir * 8 + hd];
            float s = f0 + f1;
#pragma unroll
            for (int o = 1; o < 64; o <<= 1) { const float t = __shfl_up(s, o); if (lane >= o) s += t; }
            const float b1 = s, b0 = s - f1, a0 = p0 - b0, a1 = p1 - b1;
            float pm = fmaxf(a0, a1);
#pragma unroll
            for (int o = 1; o < 64; o <<= 1) { const float t = __shfl_up(pm, o); if (lane >= o) pm = fmaxf(pm, t); }
            float ex = __shfl_up(pm, 1); if (lane == 0) ex = -INFINITY;
            const float g0 = fmaxf(ex, a0), g1 = pm;
            SCAL[pb + i0] = a0; SCAL[pb + i1] = a1; SCAL[4352 + pb + i0] = b0; SCAL[4352 + pb + i1] = b1; SCAL[8704 + pb + i0] = g0; SCAL[8704 + pb + i1] = g1;
            if (lane == 63) { bend[ci] = b1; gend[ci] = g1; }
        }
        __threadfence();
        __syncthreads();
        if (tid == 0) { float m = 0.f;
            for (int s = 0; s < 34; ++s) { const int ci = fwd ? s : (s < 2 ? 1 - s : 35 - s); mch[s] = m; m = bend[ci] + fmaxf(m, gend[ci]); }
            mch[34] = m; }
    } else {
        const float x = a.in[I_RDL][dir * 4 + hd]; lg = fminf(x, 0.f) - log1pf(__expf(-fabsf(x)));
    }
    const int dkt = MLSTM ? wave : (wave & 3), dv0 = MLSTM ? 0 : 2 * (wave >> 2);
    f32x4 ct[NOWN];
#pragma unroll
    for (int t = 0; t < NOWN; ++t) ct[t] = (f32x4){0.f, 0.f, 0.f, 0.f};
    bf16x8 ones; { const short o1 = (c == 0) ? (short)0x3F80 : (short)0; ones = (bf16x8){o1, o1, o1, o1, o1, o1, o1, o1}; }

    ScanStage<DK> R; bf16x8 qf[KS], qf_n[KS], ktf[4], ktf_n[4];
#define SCAN_SRC(s_, ci_, isctx_, rowb_, tp_, Kt_, Vt_) \
        const int ci_ = fwd ? (s_) : ((s_) < 2 ? 1 - (s_) : 35 - (s_)); const bool isctx_ = ci_ < 2; \
        const int rowb_ = isctx_ ? (ML + b * TC + ci_ * 128) : (b * T + (ci_ - 2) * 128); const int tp_ = isctx_ ? TC : T; \
        const bf16* Kt_ = isctx_ ? KtC + ci_ * 128 : KtL + (ci_ - 2) * 128; const bf16* Vt_ = isctx_ ? VtC + ci_ * 128 : VtL + (ci_ - 2) * 128;
    { SCAN_SRC(0, ci0, ic0, rb0, tp0, Kt0, Vt0)
      scan_gload<DK, MLSTM>(R, qf_n, ktf_n, Kr + (size_t)rb0 * RP, RP, Qr + (size_t)rb0 * RP, Vt0, Kt0, tp0, SCAL + ci0 * 128, ic0, tid, wave, c, g, dkt); }

    for (int s = 0; s < 34; ++s) {
        SCAN_SRC(s, ci, isctx, rowb, tp, Kt, Vt)
        (void)tp; (void)Kt; (void)Vt;
        __syncthreads();
        scan_lstore<DK, MLSTM>(R, lds, isctx, tid);
#pragma unroll
        for (int ks = 0; ks < KS; ++ks) qf[ks] = qf_n[ks];
#pragma unroll
        for (int k = 0; k < 4; ++k) ktf[k] = ktf_n[k];
        __syncthreads();
        if (s + 1 < 34) { SCAN_SRC(s + 1, ci1, ic1, rb1, tp1, Kt1, Vt1)
            scan_gload<DK, MLSTM>(R, qf_n, ktf_n, Kr + (size_t)rb1 * RP, RP, Qr + (size_t)rb1 * RP, Vt1, Kt1, tp1, SCAL + ci1 * 128, ic1, tid, wave, c, g, dkt); }
        float m_c = 0.f, m_new = 0.f, b_end = 0.f;
        if (MLSTM) { m_c = mch[s]; m_new = mch[s + 1]; b_end = bend[ci]; }
        if (!isctx) {
            const int q = 16 * wave + c;
            float gq = 0.f; if (MLSTM) gq = fmaxf(m_c, sg[q]);
#pragma unroll 2
            for (int jt = 0; jt < 8; ++jt) {
                f32x4 acc = (f32x4){0.f, 0.f, 0.f, 0.f};
#pragma unroll
                for (int ks = 0; ks < KS; ++ks) acc = mfma16(*(LAS const bf16x8*)(lds + SC_K + (16 * jt + c) * KPB + 64 * ks + 16 * g), qf[ks], acc);
                f32x4 v;
#pragma unroll
                for (int e = 0; e < 4; ++e) { const int j = 16 * jt + 4 * g + e; const bool ok = fwd ? (j <= q) : (j >= q);
                    float dm;
                    if (MLSTM) dm = fexp(sa[j] - gq); else dm = fexp(lg * (float)(fwd ? (q - j) : (j - q)));
                    v[e] = ok ? acc[e] * dm : 0.f; }
                *(LAS u32x2*)(Sw + c * 272 + 32 * jt + 8 * g) = pack4c(v);
            }
            LDS_WAIT();
            f32x4 nt[NT2];
#pragma unroll
            for (int t = 0; t < NT2; ++t) nt[t] = (f32x4){0.f, 0.f, 0.f, 0.f};
#pragma unroll
            for (int ks2 = 0; ks2 < 4; ++ks2) {
                const bf16x8 sf = *(LAS const bf16x8*)(Sw + c * 272 + 64 * ks2 + 16 * g);
#pragma unroll
                for (int t = 0; t < 4; ++t) nt[t] = mfma16(*(LAS const bf16x8*)(lds + SC_V + (16 * t + c) * 272 + 64 * ks2 + 16 * g), sf, nt[t]);
                if (MLSTM) nt[NT2 - 1] = mfma16(ones, sf, nt[NT2 - 1]);
            }
            const float wi = MLSTM ? fexp(m_c - gq) : fexp(lg * (float)(fwd ? (q + 1) : (128 - q)));
#pragma unroll
            for (int ks = 0; ks < KS; ++ks) {
                const bf16x8 qs = scale8u(qf[ks], wi);
#pragma unroll
                for (int t = 0; t < NT2; ++t) nt[t] = mfma16(*(LAS const bf16x8*)(lds + SC_CT + (16 * t + c) * KPB + 64 * ks + 16 * g), qs, nt[t]);
            }
            float inv = 1.f;
            if (MLSTM) { const float den = __shfl(nt[NT2 - 1][0], c); const float fl = fexp(-(sb[q] + gq)); inv = 1.0f / fmaxf(fabsf(den), fl); }
            bf16* op = OUT + (size_t)(rowb + q) * D + 4 * g;
#pragma unroll
            for (int t = 0; t < 4; ++t) *(u32x2*)(op + 16 * t) = pack4c(nt[t] * inv);
            __syncthreads();
        }
        const float decay = MLSTM ? fexp(b_end + m_c - m_new) : fexp(lg * 128.0f);
#pragma unroll
        for (int t = 0; t < NOWN; ++t) ct[t] = ct[t] * decay;
#pragma unroll
        for (int ks2 = 0; ks2 < 4; ++ks2) {
            f32x4 w0, w1;
#pragma unroll
            for (int e = 0; e < 4; ++e) { const int j0 = 32 * ks2 + 8 * g + e, j1 = j0 + 4;
                if (MLSTM) { w0[e] = fexp(sa[j0] + b_end - m_new); w1[e] = fexp(sa[j1] + b_end - m_new); }
                else { w0[e] = fexp(lg * (float)(fwd ? (127 - j0) : j0)); w1[e] = fexp(lg * (float)(fwd ? (127 - j1) : j1)); } }
            const bf16x8 kf = scale8v(ktf[ks2], w0, w1);
#pragma unroll
            for (int t = 0; t < NOWN; ++t) {
                const bool ext = MLSTM && (t == 4);
                const bf16x8 vf = ext ? ones : *(LAS const bf16x8*)(lds + SC_V + (16 * (dv0 + t) + c) * 272 + 64 * ks2 + 16 * g);
                ct[t] = mfma16(kf, vf, ct[t]);
            }
        }
#pragma unroll
        for (int t = 0; t < NOWN; ++t) *(LAS u32x2*)(lds + SC_CT + (16 * (dv0 + t) + c) * KPB + 32 * dkt + 8 * g) = pack4c(ct[t]);
    }
#undef SCAN_SRC
}

constexpr int SCAN_UNITS = 256;
__device__ __forceinline__ void scan_phase(const Args& a, LAS unsigned char* lds, int G, int vcu, int tid, int lane, int wave) {
    for (int u = vcu; u < SCAN_UNITS; u += G) {
        const int uu = u & 127, b = uu >> 4, hd = (uu >> 2) & 3, dir = (uu >> 1) & 1, half = uu & 1;
        if (u < 128) scan_chain<128, true>(a, lds, uu, b, hd, dir, half, tid, lane, wave);
        else scan_chain<64, false>(a, lds, uu, b, hd, dir, half, tid, lane, wave);
        __syncthreads();
    }
}

__device__ __forceinline__ void rec_merge_phase(const Args& a, int gw, int NGW, int lane) {
    unsigned char* ws = a.ws;
    bf16* HF = (bf16*)(ws + WS_H); const bf16* HB = (const bf16*)(ws + WS_HB); const bf16* MO = (const bf16*)(ws + WS_MO); const bf16* RG = (const bf16*)(ws + WS_RG);
    const int col = 16 * lane; const bool ism = lane < 32;
    for (int r = gw; r < ML; r += NGW) {
        const v4u f0 = *(const v4u*)(HF + (size_t)r * D + col), f1 = *(const v4u*)(HF + (size_t)r * D + col + 8), b0 = *(const v4u*)(HB + (size_t)r * D + col), b1 = *(const v4u*)(HB + (size_t)r * D + col + 8);
        const bf16* gp = ism ? MO + (size_t)r * 512 + col : RG + (size_t)r * 512 + (col - 512);
        const v4u g0 = *(const v4u*)gp, g1 = *(const v4u*)(gp + 8);
        float v[16], gt[16];
#pragma unroll
        for (int k = 0; k < 4; ++k) { v[2 * k] = bflo(f0[k]) + bflo(b0[k]); v[2 * k + 1] = bfhi(f0[k]) + bfhi(b0[k]); v[8 + 2 * k] = bflo(f1[k]) + bflo(b1[k]); v[8 + 2 * k + 1] = bfhi(f1[k]) + bfhi(b1[k]);
            gt[2 * k] = bflo(g0[k]); gt[2 * k + 1] = bfhi(g0[k]); gt[8 + 2 * k] = bflo(g1[k]); gt[8 + 2 * k + 1] = bfhi(g1[k]); }
        float s = 0.f;
#pragma unroll
        for (int k = 0; k < 16; ++k) s += v[k];
        s += __shfl_xor(s, 1); s += __shfl_xor(s, 2); s += __shfl_xor(s, 4);
        const float mean = s * (1.0f / 128.0f); float q = 0.f;
#pragma unroll
        for (int k = 0; k < 16; ++k) { v[k] -= mean; q += v[k] * v[k]; }
        q += __shfl_xor(q, 1); q += __shfl_xor(q, 2); q += __shfl_xor(q, 4);
        const float rstd = 1.0f / sqrtf(q * (1.0f / 128.0f) + 1e-5f);
        const float* gn = ism ? a.in[I_MNG] + col : a.in[I_RNG] + (col - 512);
        const float* bn = a.in[I_RNB] + (ism ? 0 : col - 512);
        float o[16];
#pragma unroll
        for (int k = 0; k < 16; ++k) { float y = v[k] * rstd * gn[k]; if (!ism) y += bn[k]; o[k] = y * gt[k]; }
        v4u w0, w1;
#pragma unroll
        for (int k = 0; k < 4; ++k) { w0[k] = cvtpk(o[2 * k], o[2 * k + 1]); w1[k] = cvtpk(o[8 + 2 * k], o[8 + 2 * k + 1]); }
        *(v4u*)(HF + (size_t)r * D + col) = w0; *(v4u*)(HF + (size_t)r * D + col + 8) = w1;
    }
}
typedef const __attribute__((address_space(4))) Args* kargp;
__device__ __forceinline__ Args phase_args() {
    kargp p = (kargp)__builtin_amdgcn_kernarg_segment_ptr(); asm volatile("" : "+s"(p));
    Args la;
#pragma unroll
    for (int i = 0; i < 22; ++i) la.in[i] = p->in[i];
    la.out = p->out; la.ws = p->ws; la.ph_lo = p->ph_lo; la.ph_hi = p->ph_hi; return la;
}
#ifndef PH_MASK
#define PH_MASK 0x7ff
#endif
#define EN(k) (((PH_MASK) >> (k)) & 1)
#ifndef REP_FFN2
#define REP_FFN2 1
#endif
#ifndef REP_FFN1
#define REP_FFN1 1
#endif
#ifndef REP_ATT_ONLY
#define REP_ATT_ONLY 0
#endif
#ifndef REP_ATT
#define REP_ATT 1
#endif
#ifndef REP_SCAN
#define REP_SCAN 1
#endif
#define PH_LANE() int plane; asm volatile("v_mbcnt_lo_u32_b32 %0, -1, 0\n\tv_mbcnt_hi_u32_b32 %0, -1, %0" : "=v"(plane)); const int lane = plane, wave = wave_s, tid = wave_s * 64 + plane; const int gw = vcu * NWAVES + wave; (void)tid; (void)lane; (void)gw

__global__ void __launch_bounds__(NWAVES * 64, 2) mk_fwd(Args a_unused) {
    extern __shared__ __attribute__((aligned(16))) unsigned char lds_raw[];
    LAS unsigned char* lds = (LAS unsigned char*)lds_raw;
    volatile LAS unsigned* MISC = (volatile LAS unsigned*)(lds + MISC_OFF);
    const int wave_s = __builtin_amdgcn_readfirstlane((int)threadIdx.x >> 6);
    const int G = gridDim.x; int vcu; { const int bx = blockIdx.x; vcu = (G % 8 == 0) ? (bx % 8) * (G / 8) + bx / 8 : bx; }
    const int NGW = G * NWAVES;
    for (int u = threadIdx.x; u < (LDS_BYTES - LDSCTL_OFF) / 4; u += NWAVES * 64) ((LAS unsigned*)(lds + LDSCTL_OFF))[u] = 0u;
    __syncthreads();
    int lo, hi; XcdBarrier bar;
    { const Args pa = phase_args(); PH_LANE(); lo = pa.ph_lo; hi = pa.ph_hi; gu32* ctl = (gu32*)(pa.ws + WS_CTL);
      bar.bar = (unsigned*)(ctl + CW_BAR); bar.x = 0; bar.st = nullptr; bar.wave = wave_s;
      if (!MK_PER_PHASE) bar = xcd_barrier_post((unsigned*)(ctl + CW_BAR), MISC + 8); }
#define IN(k) (lo <= (k) && (k) < hi)
#define SEAM(k) do { if (IN(k) && IN((k) + 1)) { if (MK_PER_PHASE) { if (threadIdx.x == 0) __hip_atomic_store((gu32*)bar.bar - CW_BAR + CW_TMO, 0xBADBA0u, RLX_AGENT); } else xcd_barrier(bar); } } while (0)
    int kD = D, kFF = FF, k256 = 256; asm volatile("" : "+s"(kD), "+s"(kFF), "+s"(k256));

    if (EN(0) && IN(0)) { const Args pa = phase_args(); PH_LANE(); p0a_prologue(pa, lds, G, vcu, tid, lane, wave); } SEAM(0);
    if (EN(1) && IN(1)) { const Args pa = phase_args(); PH_LANE(); p0b_modulate(pa, gw, NGW, lane); } SEAM(1);

    for (int l = 0; l < 2; ++l) {
        const int pb = 2 + 11 * l;
        const int rows_post = (l == 0) ? M : ML;
#pragma unroll
        for (int j = 0; j < 2; ++j) {
            const int p0 = pb + (j == 0 ? 0 : 8);
            const int rows = (j == 0) ? M : rows_post;
            if (EN(2) && IN(p0)) {
                const Args pa = phase_args(); PH_LANE(); unsigned char* ws = pa.ws;
                pg8::Gemm g{(const bf16*)(ws + WS_H), (const bf16*)(ws + WS_WFI) + (size_t)(l * 2 + j) * N_FI * D, rows, N_FI, kD, kD}; pg8::StaticOrder S; S.init(rows, N_FI, G, (int)blockIdx.x);
                EpiSwiglu E{(bf16*)(ws + WS_ACT)};
                for (int rep = 0; rep < REP_FFN1; ++rep) { pg8::gemm_phase<EpiSwiglu, pg8::StaticOrder, true, true>(lds, g, S, E, tid); __syncthreads(); }
            }
            SEAM(p0);
            if (EN(3) && IN(p0 + 1)) {
                const Args pa = phase_args(); PH_LANE(); unsigned char* ws = pa.ws;
                const int s = (j == 0) ? 0 : 2;
                const bf16* Wt = (const bf16*)(ws + WS_WFO) + (size_t)(l * 2 + j) * D * FF;
                const float* gate = (const float*)(ws + WS_MOD) + (size_t)l * 9 * 9216 + (s * 3 + 2) * 1024;
                const bool first = (l == 0 && j == 0);
#if REP_FFN2 > 1
                { pg8::Gemm g{(const bf16*)(ws + WS_ACT), Wt, ML, D, kFF, kFF}; pg8::StaticOrder S; S.init(ML, D, G, (int)blockIdx.x);
                  EpiDump E{(bf16*)(ws + WS_H)}; pg8::gemm_phase<EpiDump, pg8::StaticOrder, true, true>(lds, g, S, E, tid); __syncthreads(); }
#endif
                { pg8::Gemm g{(const bf16*)(ws + WS_ACT), Wt, ML, D, kFF, kFF}; pg8::StaticOrder S; S.init(ML, D, G, (int)blockIdx.x);
                  EpiResid E{first ? pa.in[I_X] : pa.out, nullptr, pa.out, nullptr, gate, 0.5f};
                  pg8::gemm_phase<EpiResid, pg8::StaticOrder, true, true>(lds, g, S, E, tid); }
                if (rows == M) { __syncthreads();
                  pg8::Gemm g{(const bf16*)(ws + WS_ACT) + (size_t)ML * FF, Wt, MC, D, k256, kFF}; pg8::SplitKOrder S; S.init(MC, D, FF / 256, G, (int)blockIdx.x);
                  EpiSlab E{(float*)(ws + WS_Y), gate, 0.5f};
                  pg8::gemm_phase<EpiSlab, pg8::SplitKOrder, true, true>(lds, g, S, E, tid); }
            }
            SEAM(p0 + 1);
            if (EN(4) && IN(p0 + 2)) {
                const Args pa = phase_args(); PH_LANE(); unsigned char* ws = pa.ws;
                const int s = (j == 0) ? 0 : 2;
                const float* MOD = (const float*)(ws + WS_MOD);
                const float* modn = nullptr;
                if (j == 0) modn = MOD + (size_t)l * 9 * 9216 + (1 * 3) * 1024; else if (l == 0) modn = MOD + (size_t)1 * 9 * 9216;
                ln_phase(pa.out, (float*)(ws + WS_XC), (const float*)(ws + WS_Y), (rows == M) ? FF / 256 : 0, pa.in[I_LNG] + (l * 3 + s) * D, pa.in[I_LNB] + (l * 3 + s) * D, modn, (bf16*)(ws + WS_H), rows, gw, NGW, lane);
            }
            if (!(l == 1 && j == 1)) SEAM(p0 + 2);
            if (j == 0) {
                if (IN(pb + 3)) {
                    if (EN(5) && l == 0) {
                        const Args pa = phase_args(); PH_LANE(); unsigned char* ws = pa.ws;
                        pg8::Gemm g{(const bf16*)(ws + WS_H), (const bf16*)(ws + WS_WAI), M, N_AI, kD, kD}; pg8::StaticOrder S; S.init(M, N_AI, G, (int)blockIdx.x);
                        EpiAttnIn E{ws};
                        pg8::gemm_phase<EpiAttnIn, pg8::StaticOrder, true, true>(lds, g, S, E, tid);
                    }
                    if (EN(6) && l == 1) {
                        const Args pa = phase_args(); PH_LANE(); unsigned char* ws = pa.ws;
                        pg8::Gemm g{(const bf16*)(ws + WS_H), (const bf16*)(ws + WS_WRI), M, N_RI, kD, kD}; pg8::StaticOrder S; S.init(M, N_RI, G, (int)blockIdx.x);
                        EpiRecIn E{ws, pa.in[I_MGB]};
                        pg8::gemm_phase<EpiRecIn, pg8::StaticOrder, true, true>(lds, g, S, E, tid);
                    }
                }
                SEAM(pb + 3);
                if (IN(pb + 4)) {
                    if (EN(7) && l == 0) { for (int rep = 0; rep < REP_ATT; ++rep) { const Args pa = phase_args(); PH_LANE(); attn_phase(pa, lds, G, vcu, tid, lane, wave, rep == 0 ? 0 : REP_ATT_ONLY); __syncthreads(); } }
                    if (EN(8) && l == 1) { for (int rep = 0; rep < REP_SCAN; ++rep) { const Args pa = phase_args(); PH_LANE(); scan_phase(pa, lds, G, vcu, tid, lane, wave); __syncthreads(); } }
                }
                SEAM(pb + 4);
                if (EN(9) && IN(pb + 5)) { if (l == 1) { const Args pa = phase_args(); PH_LANE(); rec_merge_phase(pa, gw, NGW, lane); } }
                SEAM(pb + 5);
                if (EN(10) && IN(pb + 6)) {
                    const Args pa = phase_args(); PH_LANE(); unsigned char* ws = pa.ws;
                    const bf16* Wt = (const bf16*)(ws + (l == 0 ? WS_WAO : WS_WRO));
                    const float* gate = (const float*)(ws + WS_MOD) + (size_t)l * 9 * 9216 + (1 * 3 + 2) * 1024;
                    { pg8::Gemm g{(const bf16*)(ws + WS_H), Wt, ML, D, kD, kD}; pg8::StaticOrder S; S.init(ML, D, G, (int)blockIdx.x);
                      EpiResid E{pa.out, nullptr, pa.out, nullptr, gate, 1.0f};
                      pg8::gemm_phase<EpiResid, pg8::StaticOrder, true, true>(lds, g, S, E, tid); }
                    if (rows_post == M) { __syncthreads();
                      pg8::Gemm g{(const bf16*)(ws + WS_H) + (size_t)ML * D, Wt, MC, D, k256, kD}; pg8::SplitKOrder S; S.init(MC, D, D / 256, G, (int)blockIdx.x);
                      EpiSlab E{(float*)(ws + WS_Y), gate, 1.0f};
                      pg8::gemm_phase<EpiSlab, pg8::SplitKOrder, true, true>(lds, g, S, E, tid); }
                }
                SEAM(pb + 6);
                if (EN(4) && IN(pb + 7)) {
                    const Args pa = phase_args(); PH_LANE(); unsigned char* ws = pa.ws;
                    ln_phase(pa.out, (float*)(ws + WS_XC), (const float*)(ws + WS_Y), (rows_post == M) ? D / 256 : 0, pa.in[I_LNG] + (l * 3 + 1) * D, pa.in[I_LNB] + (l * 3 + 1) * D, (const float*)(ws + WS_MOD) + (size_t)l * 9 * 9216 + (2 * 3) * 1024, (bf16*)(ws + WS_H), rows_post, gw, NGW, lane);
                }
                SEAM(pb + 7);
            }
        }
    }
#undef IN
#undef SEAM
}

#ifdef DBG_DUMP
__global__ void dbg_dump(const unsigned short* A, const unsigned short* B, const unsigned short* C, size_t n, float* out) {
    const size_t i = (size_t)blockIdx.x * 256 + threadIdx.x;
    float v = 0.f;
    if (i < n) { if (A) v += __uint_as_float(((unsigned)A[i]) << 16); if (B) v += 2.0f * __uint_as_float(((unsigned)B[i]) << 16); if (C) v += 4.0f * __uint_as_float(((unsigned)C[i]) << 16); }
    out[i] = v;
}
#endif
extern "C" void kernel_launch(void* const* d_in, const int* in_sizes, int n_in, void* d_out, int out_size, void* d_ws, size_t ws_size, hipStream_t stream) {
    static int grid = 0;
    if (grid == 0) {
        if (n_in != 22 || in_sizes[0] != ML * D || out_size != ML * D || ws_size < WS_END + 8 * MiB) { fprintf(stderr, "kernel_launch: unexpected shapes (n_in %d, in0 %d, out %d, ws %zu)\n", n_in, n_in > 0 ? in_sizes[0] : -1, out_size, ws_size); grid = -1; return; }
        int dev = 0, cus = 0, per_cu = 0;
        if (hipGetDevice(&dev) != hipSuccess || hipDeviceGetAttribute(&cus, hipDeviceAttributeMultiprocessorCount, dev) != hipSuccess) { grid = -1; return; }
        if (hipFuncSetAttribute((const void*)mk_fwd, hipFuncAttributeMaxDynamicSharedMemorySize, LDS_BYTES) != hipSuccess) { fprintf(stderr, "kernel_launch: hipFuncSetAttribute failed\n"); grid = -1; return; }
        if (hipOccupancyMaxActiveBlocksPerMultiprocessor(&per_cu, (const void*)mk_fwd, NWAVES * 64, LDS_BYTES) != hipSuccess || per_cu < 1) fprintf(stderr, "kernel_launch: occupancy query reports %d\n", per_cu);
        (void)hipGetLastError();
        grid = cus;
    }
    if (grid < 0) return;
    if (hipMemsetAsync((char*)d_ws + WS_CTL, 0, CTL_ZERO_BYTES, stream) != hipSuccess) return;
    Args a{};
    for (int i = 0; i < 22; ++i) a.in[i] = (const float*)d_in[i];
    a.out = (float*)d_out; a.ws = (unsigned char*)d_ws;
#if MK_PER_PHASE
    for (int p = 0; p < MK_STOP; ++p) { a.ph_lo = p; a.ph_hi = p + 1; hipLaunchKernelGGL(mk_fwd, dim3(grid), dim3(NWAVES * 64), LDS_BYTES, stream, a); }
#ifdef DBG_DUMP
    hipLaunchKernelGGL(dbg_dump, dim3(ML * D / 256), dim3(256), 0, stream, DBG_A ? (const unsigned short*)((char*)d_ws + DBG_A) : nullptr, DBG_B ? (const unsigned short*)((char*)d_ws + DBG_B) : nullptr, DBG_C ? (const unsigned short*)((char*)d_ws + DBG_C) : nullptr, (size_t)DBG_N, (float*)d_out);
#endif
#else
    a.ph_lo = 0; a.ph_hi = MK_STOP;
    hipLaunchKernelGGL(mk_fwd, dim3(grid), dim3(NWAVES * 64), LDS_BYTES, stream, a);
#endif
}
```
